# Optimizing an MI355X kernel written in HIP

```python
import jax, jax.numpy as jnp
from jax import lax
import numpy as np

D_MODEL = 1024
BATCH = 8
SEQ = 2048
DEPTH = 2

CHUNK = 64
HEAD_DIM = 64
EPS = 1e-6
NEG_INF = -1e30

A_HEADS = 8
A_KV_HEADS = 2
A_WINDOW = 128
A_PREV_CHUNKS = A_WINDOW // CHUNK
A_BAND_CHUNKS = A_PREV_CHUNKS + 1

B_HEADS = 8
B_BLOCK = 128
FORGET_BIAS_INIT = 3.0

C_HEADS = 8
C_PREV_CHUNKS = 8
C_BAND_CHUNKS = C_PREV_CHUNKS + 1
REL_CLIP = 128
N_REL = 2 * REL_CLIP + 1

N_BRANCH = 3
BRANCH_WIDTH = 8 * HEAD_DIM
FFN_HIDDEN = ((-(-8 * D_MODEL // 3)) + 255) // 256 * 256

IN_SPLIT_SIZES = (
    A_HEADS * HEAD_DIM, A_KV_HEADS * HEAD_DIM, A_KV_HEADS * HEAD_DIM,
    B_HEADS * HEAD_DIM, B_HEADS * HEAD_DIM, B_HEADS * HEAD_DIM, B_HEADS,
    C_HEADS * HEAD_DIM, C_HEADS * HEAD_DIM, C_HEADS * HEAD_DIM,
    N_BRANCH * D_MODEL,
)
N_IN_COLS = sum(IN_SPLIT_SIZES)

kernel_name = "chunk_causal_hybrid_swa_fox_relpos_adaln"


def rms_norm(x, g):
    xf = x.astype(jnp.float32)
    y = xf * lax.rsqrt(jnp.mean(xf * xf, axis=-1, keepdims=True) + EPS)
    return (y * g.astype(jnp.float32)).astype(x.dtype)


def modulate(h, shift, scale):
    return h * (1.0 + scale[:, None, :]) + shift[:, None, :]


def alibi_slopes(n_heads):
    return jnp.exp2(-8.0 * jnp.arange(1, n_heads + 1, dtype=jnp.float32) / n_heads)


def sliding_window_sink_attention(q, k, v, sinks):
    b, s, _, dh = q.shape
    nc = s // CHUNK
    g = A_HEADS // A_KV_HEADS
    band_len = A_BAND_CHUNKS * CHUNK
    qc = q.reshape(b, nc, CHUNK, A_KV_HEADS, g, dh)

    def band(t):
        tp = jnp.pad(t, ((0, 0), (A_PREV_CHUNKS * CHUNK, 0), (0, 0), (0, 0)))
        tp = tp.reshape(b, nc + A_PREV_CHUNKS, CHUNK, A_KV_HEADS, dh)
        return jnp.concatenate([tp[:, j:j + nc] for j in range(A_BAND_CHUNKS)], axis=2)

    kb, vb = band(k), band(v)
    scores = jnp.einsum('bnqkgd,bnskd->bnkgqs', qc, kb).astype(jnp.float32) * (dh ** -0.5)
    qi = jnp.arange(CHUNK)
    si = jnp.arange(band_len)
    dist = A_PREV_CHUNKS * CHUNK + qi[:, None] - si[None, :]
    alibi = -alibi_slopes(A_HEADS).reshape(A_KV_HEADS, g, 1, 1) * jnp.abs(dist).astype(jnp.float32)
    key_chunk = jnp.arange(nc)[:, None] - A_PREV_CHUNKS + si[None, :] // CHUNK
    valid = (key_chunk >= 0)[None, :, None, None, None, :]
    scores = jnp.where(valid, scores + alibi, NEG_INF)
    sink_col = jnp.broadcast_to(sinks.astype(jnp.float32).reshape(1, 1, A_KV_HEADS, g, 1, 1),
                                scores.shape[:-1] + (1,))
    probs = jax.nn.softmax(jnp.concatenate([scores, sink_col], axis=-1), axis=-1)[..., :-1]
    out = jnp.einsum('bnkgqs,bnskd->bnqkgd', probs.astype(v.dtype), vb)
    return out.reshape(b, s, A_HEADS * dh)


def forgetting_attention(q, k, v, f_logit):
    b, s, h, dh = q.shape
    log_f = jax.nn.log_sigmoid(f_logit.astype(jnp.float32))
    cum = lax.cumsum(log_f, axis=1).transpose(0, 2, 1)
    kpos = jnp.arange(s)
    scale = dh ** -0.5

    def block(i):
        start = i * B_BLOCK
        qb = lax.dynamic_slice_in_dim(q, start, B_BLOCK, axis=1)
        cq = lax.dynamic_slice_in_dim(cum, start, B_BLOCK, axis=2)
        sc = jnp.einsum('bqhd,bshd->bhqs', qb, k).astype(jnp.float32) * scale
        sc = sc + cq[..., :, None] - cum[:, :, None, :]
        qpos = start + jnp.arange(B_BLOCK)
        sc = jnp.where(kpos[None, :] <= qpos[:, None], sc, NEG_INF)
        p = jax.nn.softmax(sc, axis=-1)
        return jnp.einsum('bhqs,bshd->bqhd', p.astype(v.dtype), v)

    out = lax.map(block, jnp.arange(s // B_BLOCK))
    return out.transpose(1, 0, 2, 3, 4).reshape(b, s, h * dh)


def chunked_relpos_attention(q, k, v, rel_table):
    b, s, h, dh = q.shape
    nc = s // CHUNK
    band_len = C_BAND_CHUNKS * CHUNK
    pad = C_PREV_CHUNKS * CHUNK
    kp = jnp.pad(k, ((0, 0), (pad, 0), (0, 0), (0, 0)))
    vp = jnp.pad(v, ((0, 0), (pad, 0), (0, 0), (0, 0)))
    qi = jnp.arange(CHUNK)
    si = jnp.arange(band_len)
    dist = pad + qi[:, None] - si[None, :]
    rel_idx = jnp.clip(dist, -REL_CLIP, REL_CLIP) + REL_CLIP
    bias = rel_table[:, rel_idx].astype(jnp.float32)
    scale = dh ** -0.5

    def chunk(n):
        qc = lax.dynamic_slice_in_dim(q, n * CHUNK, CHUNK, axis=1)
        kc = lax.dynamic_slice_in_dim(kp, n * CHUNK, band_len, axis=1)
        vc = lax.dynamic_slice_in_dim(vp, n * CHUNK, band_len, axis=1)
        sc = jnp.einsum('bqhd,bshd->bhqs', qc, kc).astype(jnp.float32) * scale + bias
        valid = (n * CHUNK - pad + si) >= 0
        sc = jnp.where(valid[None, None, None, :], sc, NEG_INF)
        p = jax.nn.softmax(sc, axis=-1)
        return jnp.einsum('bhqs,bshd->bqhd', p.astype(vc.dtype), vc)

    out = lax.map(chunk, jnp.arange(nc))
    return out.transpose(1, 0, 2, 3, 4).reshape(b, s, h * dh)


def hybrid_mixer(h, w_in, b_forget, sinks, rel_table, w_branch, w_out):
    b, s, _ = h.shape
    proj = jnp.einsum('bsd,de->bse', h, w_in)
    split_points = [int(p) for p in np.cumsum(IN_SPLIT_SIZES)[:-1]]
    qa, ka, va, qb, kb, vb, fb, qc, kc, vc, gates = jnp.split(proj, split_points, axis=-1)
    heads = lambda t, n: t.reshape(b, s, n, HEAD_DIM)
    o_a = sliding_window_sink_attention(heads(qa, A_HEADS), heads(ka, A_KV_HEADS),
                                        heads(va, A_KV_HEADS), sinks)
    o_b = forgetting_attention(heads(qb, B_HEADS), heads(kb, B_HEADS), heads(vb, B_HEADS),
                               fb + b_forget)
    o_c = chunked_relpos_attention(heads(qc, C_HEADS), heads(kc, C_HEADS), heads(vc, C_HEADS),
                                   rel_table)
    branches = jnp.stack([o_a, o_b, o_c], axis=2)
    y = jnp.einsum('bskw,kwd->bskd', branches, w_branch)
    g = jax.nn.sigmoid(gates.reshape(b, s, N_BRANCH, D_MODEL))
    merged = jnp.sum(g * y, axis=2)
    return jnp.einsum('bsd,de->bse', merged, w_out)


def swiglu(h, w_ffn_in, w_ffn_out):
    u = jnp.einsum('bsd,df->bsf', h, w_ffn_in)
    gate, up = jnp.split(u, 2, axis=-1)
    return jnp.einsum('bsf,fd->bsd', jax.nn.silu(gate) * up, w_ffn_out)


def setup_inputs(seed: int = 0) -> dict:
    key = jax.random.key(seed)
    ks = jax.random.split(key, 16)
    f32 = jnp.float32
    nrm = lambda k, shape, sd: jax.random.normal(k, shape, f32) * sd
    return {
        "x": nrm(ks[0], (BATCH, SEQ, D_MODEL), 1.0),
        "c": nrm(ks[1], (BATCH, D_MODEL), 1.0),
        "norm_mix_g": 1.0 + nrm(ks[2], (DEPTH, D_MODEL), 0.02),
        "norm_ffn_g": 1.0 + nrm(ks[3], (DEPTH, D_MODEL), 0.02),
        "w_ada": nrm(ks[4], (DEPTH, D_MODEL, 6 * D_MODEL), 0.5 * D_MODEL ** -0.5),
        "b_ada": nrm(ks[5], (DEPTH, 6 * D_MODEL), 0.02),
        "w_in": nrm(ks[6], (DEPTH, D_MODEL, N_IN_COLS), D_MODEL ** -0.5),
        "b_forget": FORGET_BIAS_INIT + nrm(ks[7], (DEPTH, B_HEADS), 0.5),
        "sinks": nrm(ks[8], (DEPTH, A_HEADS), 0.5),
        "rel_bias": nrm(ks[9], (DEPTH, C_HEADS, N_REL), 0.1),
        "w_branch": nrm(ks[10], (DEPTH, N_BRANCH, BRANCH_WIDTH, D_MODEL), BRANCH_WIDTH ** -0.5),
        "w_out": nrm(ks[11], (DEPTH, D_MODEL, D_MODEL), D_MODEL ** -0.5),
        "w_ffn_in": nrm(ks[12], (DEPTH, D_MODEL, 2 * FFN_HIDDEN), D_MODEL ** -0.5),
        "w_ffn_out": nrm(ks[13], (DEPTH, FFN_HIDDEN, D_MODEL), FFN_HIDDEN ** -0.5),
        "final_norm_g": 1.0 + nrm(ks[14], (D_MODEL,), 0.02),
    }


def reference(x, c, norm_mix_g, norm_ffn_g, w_ada, b_ada, w_in, b_forget, sinks, rel_bias,
              w_branch, w_out, w_ffn_in, w_ffn_out, final_norm_g):
    cond = jax.nn.silu(c)
    for l in range(DEPTH):
        mod = jnp.einsum('bd,de->be', cond, w_ada[l]) + b_ada[l]
        sh_m, sc_m, g_m, sh_f, sc_f, g_f = jnp.split(mod, 6, axis=-1)
        h = modulate(rms_norm(x, norm_mix_g[l]), sh_m, sc_m)
        x = x + g_m[:, None, :] * hybrid_mixer(h, w_in[l], b_forget[l], sinks[l], rel_bias[l],
                                               w_branch[l], w_out[l])
        h = modulate(rms_norm(x, norm_ffn_g[l]), sh_f, sc_f)
        x = x + g_f[:, None, :] * swiglu(h, w_ffn_in[l], w_ffn_out[l])
    return rms_norm(x, final_norm_g)
```

```cpp
#include <hip/hip_runtime.h>
#include <hip/hip_cooperative_groups.h>
#include <cstdio>
#include <cstdint>
namespace cg = cooperative_groups;

#ifndef N_LAUNCH_MODE
#define N_LAUNCH_MODE 0
#endif

#define LAS __attribute__((address_space(3)))
typedef unsigned short bf16_t;
typedef short bf16x8 __attribute__((ext_vector_type(8)));
typedef short s16x4 __attribute__((ext_vector_type(4)));
typedef float f32x4 __attribute__((ext_vector_type(4)));
typedef float f32x16 __attribute__((ext_vector_type(16)));
typedef unsigned u32x4 __attribute__((ext_vector_type(4)));
typedef unsigned u32x2 __attribute__((ext_vector_type(2)));

constexpr int BATCH = 8, SEQ = 2048, D = 1024, M = BATCH * SEQ, DEPTH = 2;
constexpr int NIN = 6920, FFH = 2816, FF2 = 2 * FFH;
constexpr int PITCH = 4608;
constexpr int NQKV = 3840, NG = 3072;
constexpr int FB_SRC = 2304;
constexpr int G_SRC = 3848;
constexpr float EPS = 1e-6f;
constexpr float LOG2E = 1.4426950408889634f;

constexpr size_t MiB = 1u << 20;
constexpr size_t WS_MOD = 0;
constexpr size_t WS_FLOG = 512 * 1024;
constexpr size_t WS_CUM = 1024 * 1024;
constexpr size_t WS_W = 2 * MiB;
constexpr size_t W_QKV = 0, W_G = W_QKV + (size_t)NQKV * D * 2, W_BR = W_G + (size_t)NG * D * 2, W_OUT = W_BR + (size_t)3 * D * 512 * 2,
                 W_FI = W_OUT + (size_t)D * D * 2, W_FO = W_FI + (size_t)FF2 * D * 2, W_LAYER = W_FO + (size_t)D * FFH * 2;
static_assert(W_LAYER == 35 * MiB, "weights per layer");
constexpr size_t WS_H = WS_W + 2 * W_LAYER;
constexpr size_t WS_PROJ = WS_H + (size_t)M * D * 2;
constexpr size_t WS_END = WS_PROJ + (size_t)M * PITCH * 2;
static_assert(WS_END <= 256 * MiB, "workspace");

constexpr int QA = 0, KA = 512, VA = 640, QB_ = 768, KB_ = 1280, VB_ = 1792, QC_ = 2304, KC_ = 2816, VC_ = 3328;
__host__ __device__ __forceinline__ int gate_col(int j) {
    return j == 0 ? 512 : (j < 4 ? 3840 + 256 * (j - 1) : (j < 8 ? 1280 + 256 * (j - 4) : 2816 + 256 * (j - 8)));
}

__device__ __forceinline__ unsigned cvt_pk_bf16(float lo, float hi) { unsigned r; asm volatile("v_cvt_pk_bf16_f32 %0, %1, %2" : "=v"(r) : "v"(lo), "v"(hi)); return r; }
__device__ __forceinline__ float bf_lo(unsigned w) { return __uint_as_float(w << 16); }
__device__ __forceinline__ float bf_hi(unsigned w) { return __uint_as_float(w & 0xffff0000u); }
__device__ __forceinline__ float wave_sum(float v) {
#pragma unroll
    for (int o = 1; o < 64; o <<= 1) v += __shfl_xor(v, o);
    return v;
}
__device__ __forceinline__ int tid_opaque() { int t = threadIdx.x; asm volatile("" : "+v"(t)); return t; }
__device__ __forceinline__ float sigmoidf_(float x) { return 1.0f / (1.0f + __expf(-x)); }

namespace pg8 {
constexpr int BM = 256, BK = 64, HALF = 128, HTB = HALF * BK * 2, STAGE_BYTES = 8 * HTB, NXCD = 8, WGM = 8;
__host__ __device__ __forceinline__ int lds_byte(int r, int c) { const int st = (r >> 4) * 2 + (c >> 5), rr = r & 15, cc = c & 31, ob = rr * 64 + cc * 2; return st * 1024 + (ob ^ (((ob >> 9) & 1) << 5)); }
__host__ __device__ __forceinline__ void stage_rc(int b, int& R, int& C) { const int st = b / 1024, sb = b % 1024, swz = sb ^ (((sb >> 9) & 1) << 5); R = (st >> 1) * 16 + swz / 64; C = (st & 1) * 32 + (swz % 64) / 2; }
__host__ __device__ __forceinline__ int perm32(int rho) { const int n = rho >> 4, i = rho & 15; return 8 * (i >> 2) + 4 * n + (i & 3); }

struct Unit { int pm, pn, k; };
struct Gemm { const bf16_t* A; const bf16_t* Bt; int M, N, K, lda; };

struct StaticOrder {
    int nM, nN, nwg, G, c;
    __device__ void init(int M_, int N_, int G_, int c_) { nM = M_ / BM; nN = N_ / BM; nwg = nM * nN; G = G_; c = c_; }
    __device__ __forceinline__ bool tile(int i, int& pm, int& pn) const {
        const long L = (long)i * G + c; if (L >= nwg) return false;
        int wgid = (int)L; { const int q = nwg / NXCD, r = nwg % NXCD, xcd = wgid % NXCD, off = wgid / NXCD; wgid = (xcd < r ? xcd * (q + 1) : r * (q + 1) + (xcd - r) * q) + off; }
        const int nig = WGM * nN, gid = wgid / nig, fm = gid * WGM, gsz = (nM - fm) < WGM ? (nM - fm) : WGM;
        pm = fm + ((wgid % nig) % gsz); pn = (wgid % nig) / gsz; return true;
    }
    __device__ __forceinline__ bool next(int i, Unit& u) const { u.k = 0; return tile(i, u.pm, u.pn); }
    __device__ __forceinline__ size_t a_off(const Unit&) const { return 0; }
};
struct BranchOrder {
    StaticOrder so;
    __device__ __forceinline__ bool next(int i, Unit& u) const { int pm, cn; if (!so.tile(i / 3, pm, cn)) return false; u.k = i % 3; u.pm = pm; u.pn = 4 * u.k + cn; return true; }
    __device__ __forceinline__ size_t a_off(const Unit& u) const { return (size_t)(u.k == 0 ? QA : (u.k == 1 ? QB_ : QC_)) * 2; }
};

struct EpiQKV {
    static constexpr bool PERM = true;
    bf16_t* O;
    __device__ __forceinline__ bool keep(const Unit&) const { return false; }
    __device__ __forceinline__ void operator()(f32x4 (&acc)[2][2][4][2], const Unit& u, int wr, int wc, int fr, int fq) const {
        const int row0 = u.pm * BM + wr * 64 + fr, col0 = u.pn * BM + wc * 32 + 8 * fq;
#pragma unroll
        for (int ai = 0; ai < 2; ++ai)
#pragma unroll
            for (int m = 0; m < 4; ++m) { bf16_t* rowp = O + (size_t)(row0 + ai * HALF + m * 16) * PITCH + col0;
#pragma unroll
                for (int bj = 0; bj < 2; ++bj) { const f32x4 v0 = acc[ai][bj][m][0], v1 = acc[ai][bj][m][1];
                    u32x4 w; w.x = cvt_pk_bf16(v0[0], v0[1]); w.y = cvt_pk_bf16(v0[2], v0[3]); w.z = cvt_pk_bf16(v1[0], v1[1]); w.w = cvt_pk_bf16(v1[2], v1[3]);
                    *(u32x4*)(rowp + bj * HALF) = w; } }
    }
};
struct EpiGate {
    static constexpr bool PERM = true;
    bf16_t* O;
    __device__ __forceinline__ bool keep(const Unit&) const { return false; }
    __device__ __forceinline__ void operator()(f32x4 (&acc)[2][2][4][2], const Unit& u, int wr, int wc, int fr, int fq) const {
        const int row0 = u.pm * BM + wr * 64 + fr, col0 = gate_col(u.pn) + wc * 32 + 8 * fq;
#pragma unroll
        for (int ai = 0; ai < 2; ++ai)
#pragma unroll
            for (int m = 0; m < 4; ++m) { bf16_t* rowp = O + (size_t)(row0 + ai * HALF + m * 16) * PITCH + col0;
#pragma unroll
                for (int bj = 0; bj < 2; ++bj) { f32x4 v0 = acc[ai][bj][m][0], v1 = acc[ai][bj][m][1];
#pragma unroll
                    for (int i = 0; i < 4; ++i) { v0[i] = fmaxf(sigmoidf_(v0[i]), 1e-6f); v1[i] = fmaxf(sigmoidf_(v1[i]), 1e-6f); }
                    u32x4 w; w.x = cvt_pk_bf16(v0[0], v0[1]); w.y = cvt_pk_bf16(v0[2], v0[3]); w.z = cvt_pk_bf16(v1[0], v1[1]); w.w = cvt_pk_bf16(v1[2], v1[3]);
                    *(u32x4*)(rowp + bj * HALF) = w; } }
    }
};
struct EpiBranch {
    static constexpr bool PERM = true;
    const bf16_t* P; bf16_t* O;
    __device__ __forceinline__ bool keep(const Unit& u) const { return u.k < 2; }
    __device__ __forceinline__ void operator()(f32x4 (&acc)[2][2][4][2], const Unit& u, int wr, int wc, int fr, int fq) const {
        const int cn = u.pn & 3, k = u.k;
        const int row0 = u.pm * BM + wr * 64 + fr, cofs = wc * 32 + 8 * fq;
        const int gc0 = gate_col(4 * k + cn) + cofs, gc1 = gate_col(4 * (k < 2 ? k + 1 : 2) + cn) + cofs;
#pragma unroll
        for (int ai = 0; ai < 2; ++ai)
#pragma unroll
            for (int m = 0; m < 4; ++m) { const size_t ro = (size_t)(row0 + ai * HALF + m * 16);
#pragma unroll
                for (int bj = 0; bj < 2; ++bj) {
                    const u32x4 ga = *(const u32x4*)(P + ro * PITCH + gc0 + bj * HALF);
                    float s[8] = {bf_lo(ga.x), bf_hi(ga.x), bf_lo(ga.y), bf_hi(ga.y), bf_lo(ga.z), bf_hi(ga.z), bf_lo(ga.w), bf_hi(ga.w)};
                    if (k < 2) { const u32x4 gb = *(const u32x4*)(P + ro * PITCH + gc1 + bj * HALF);
                        const float t[8] = {bf_lo(gb.x), bf_hi(gb.x), bf_lo(gb.y), bf_hi(gb.y), bf_lo(gb.z), bf_hi(gb.z), bf_lo(gb.w), bf_hi(gb.w)};
#pragma unroll
                        for (int i = 0; i < 8; ++i) s[i] = s[i] * __builtin_amdgcn_rcpf(t[i]); }
                    f32x4 v0 = acc[ai][bj][m][0], v1 = acc[ai][bj][m][1];
#pragma unroll
                    for (int i = 0; i < 4; ++i) { v0[i] *= s[i]; v1[i] *= s[4 + i]; }
                    if (k < 2) { acc[ai][bj][m][0] = v0; acc[ai][bj][m][1] = v1; }
                    else { u32x4 w; w.x = cvt_pk_bf16(v0[0], v0[1]); w.y = cvt_pk_bf16(v0[2], v0[3]); w.z = cvt_pk_bf16(v1[0], v1[1]); w.w = cvt_pk_bf16(v1[2], v1[3]);
                        *(u32x4*)(O + ro * D + cn * BM + cofs + bj * HALF) = w; } } }
    }
};
struct EpiRes {
    static constexpr bool PERM = false;
    const float* base; float* out; const float* gmod;
    __device__ __forceinline__ bool keep(const Unit&) const { return false; }
    __device__ __forceinline__ void operator()(f32x4 (&acc)[2][2][4][2], const Unit& u, int wr, int wc, int fr, int fq) const {
        const int b = u.pm >> 3;
        const int col0 = u.pn * BM + wc * 32 + 4 * fq;
        const float* gv = gmod + (size_t)b * 6144 + col0;
        f32x4 gg[2][2];
#pragma unroll
        for (int bj = 0; bj < 2; ++bj)
#pragma unroll
            for (int n = 0; n < 2; ++n) gg[bj][n] = *(const f32x4*)(gv + bj * HALF + n * 16);
#pragma unroll
        for (int ai = 0; ai < 2; ++ai)
#pragma unroll
            for (int m = 0; m < 4; ++m) { const size_t off = (size_t)(u.pm * BM + ai * HALF + wr * 64 + m * 16 + fr) * D + col0;
#pragma unroll
                for (int bj = 0; bj < 2; ++bj)
#pragma unroll
                    for (int n = 0; n < 2; ++n) { const f32x4 bs = *(const f32x4*)(base + off + bj * HALF + n * 16);
                        *(f32x4*)(out + off + bj * HALF + n * 16) = bs + gg[bj][n] * acc[ai][bj][m][n]; } }
    }
};
struct EpiSwiglu {
    static constexpr bool PERM = true;
    bf16_t* O;
    __device__ __forceinline__ bool keep(const Unit&) const { return false; }
    __device__ __forceinline__ void operator()(f32x4 (&acc)[2][2][4][2], const Unit& u, int wr, int wc, int fr, int fq) const {
        const int row0 = u.pm * BM + wr * 64 + fr, col0 = u.pn * HALF + wc * 32 + 8 * fq;
#pragma unroll
        for (int ai = 0; ai < 2; ++ai)
#pragma unroll
            for (int m = 0; m < 4; ++m) { bf16_t* rowp = O + (size_t)(row0 + ai * HALF + m * 16) * FFH + col0;
                f32x4 r0, r1;
#pragma unroll
                for (int i = 0; i < 4; ++i) { const float g0 = acc[ai][0][m][0][i], g1 = acc[ai][0][m][1][i];
                    r0[i] = g0 * sigmoidf_(g0) * acc[ai][1][m][0][i]; r1[i] = g1 * sigmoidf_(g1) * acc[ai][1][m][1][i]; }
                u32x4 w; w.x = cvt_pk_bf16(r0[0], r0[1]); w.y = cvt_pk_bf16(r0[2], r0[3]); w.z = cvt_pk_bf16(r1[0], r1[1]); w.w = cvt_pk_bf16(r1[2], r1[3]);
                *(u32x4*)rowp = w; }
    }
};

template <class Epi, class Sched>
__device__ __forceinline__ void gemm_phase(LAS unsigned char* lds, const Gemm g, const Sched& S, const Epi& E) {
    const int tid = tid_opaque(), wid = __builtin_amdgcn_readfirstlane(tid >> 6), lane = tid & 63, wr = wid >> 2, wc = wid & 3, fr = lane & 15, fq = lane >> 4;
    const int K = g.K, nt = K / BK, lda = g.lda;
    unsigned voffA[2], voffB[2];
#pragma unroll
    for (int i = 0; i < 2; ++i) { int R, C; stage_rc(tid * 16 + i * 8192, R, C); const int Rb = Epi::PERM ? ((R & ~31) + perm32(R & 31)) : R;
        voffA[i] = (unsigned)(R * lda + C) * 2u; voffB[i] = (unsigned)(Rb * K + C) * 2u; }
    const size_t kstep = (size_t)(BK * 2);
    const size_t hstepA = (size_t)HALF * lda * 2, hstepB = (size_t)HALF * K * 2;
    const size_t tstepA = 2 * hstepA, tstepB = 2 * hstepB;
    const unsigned ldsw = (unsigned)wid * 1024u;
    const int aoff = lds_byte(wr * 64 + fr, fq * 8), boff = lds_byte(wc * 32 + fr, fq * 8);
#define PG8_SA(b, h) (((b) * 2 + (h)) * HTB)
#define PG8_SB(b, h) ((4 + (b) * 2 + (h)) * HTB)
#define PG8_STAGE(bufoff, gbase, voff) do { _Pragma("unroll") for (int _i = 0; _i < 2; ++_i) \
        __builtin_amdgcn_global_load_lds((const unsigned*)((const char*)(gbase) + (voff)[_i]), (LAS unsigned*)(lds + (bufoff) + ldsw + _i * 8192), 16, 0, 0); } while (0)
#define PG8_LDA(dst, b, h) do { _Pragma("unroll") for (int m = 0; m < 4; ++m) _Pragma("unroll") for (int k = 0; k < 2; ++k) dst[m][k] = *(const LAS bf16x8*)(lds + PG8_SA(b, h) + aoff + m * 2048 + k * 1024); } while (0)
#define PG8_LDB(dst, b, h) do { _Pragma("unroll") for (int n = 0; n < 2; ++n) _Pragma("unroll") for (int k = 0; k < 2; ++k) dst[n][k] = *(const LAS bf16x8*)(lds + PG8_SB(b, h) + boff + n * 2048 + k * 1024); } while (0)
#define PG8_MMA(ai, bj, At, Bt) do { __builtin_amdgcn_s_setprio(1); _Pragma("unroll") for (int m = 0; m < 4; ++m) _Pragma("unroll") for (int n = 0; n < 2; ++n) _Pragma("unroll") for (int k = 0; k < 2; ++k) \
        acc[ai][bj][m][n] = __builtin_amdgcn_mfma_f32_16x16x32_bf16(Bt[n][k], At[m][k], acc[ai][bj][m][n], 0, 0, 0); __builtin_amdgcn_s_setprio(0); } while (0)
#define PG8_WAIT_V(n) asm volatile("s_waitcnt vmcnt(" #n ")" ::: "memory")
#define PG8_WAIT_L(n) asm volatile("s_waitcnt lgkmcnt(" #n ")" ::: "memory")
#define PG8_BAR __builtin_amdgcn_s_barrier()
#define PG8_SCHED __builtin_amdgcn_sched_barrier(0)
    Unit cur, nxt; int ui = 0;
    if (!S.next(0, cur)) return;
    f32x4 acc[2][2][4][2];
#pragma unroll
    for (int a = 0; a < 2; ++a)
#pragma unroll
        for (int b = 0; b < 2; ++b)
#pragma unroll
            for (int m = 0; m < 4; ++m)
#pragma unroll
                for (int n = 0; n < 2; ++n) acc[a][b][m][n] = (f32x4){0.f, 0.f, 0.f, 0.f};
    bf16x8 At[4][2], B0[2][2], B1[2][2];
    const char* cA = (const char*)g.A + S.a_off(cur) + (size_t)cur.pm * tstepA; const char* cB = (const char*)g.Bt + (size_t)cur.pn * tstepB;
    PG8_STAGE(PG8_SB(0, 0), cB, voffB); PG8_STAGE(PG8_SB(0, 1), cB + hstepB, voffB); PG8_STAGE(PG8_SA(0, 0), cA, voffA); PG8_STAGE(PG8_SA(0, 1), cA + hstepA, voffA);
    if (wr == 1) PG8_BAR;
    PG8_WAIT_V(2); PG8_BAR;
    PG8_STAGE(PG8_SB(1, 0), cB + kstep, voffB); PG8_STAGE(PG8_SA(1, 0), cA + kstep, voffA); PG8_STAGE(PG8_SB(1, 1), cB + hstepB + kstep, voffB);
    PG8_WAIT_V(6); PG8_BAR;
    for (;;) {
        const bool has_next = S.next(ui + 1, nxt);
        const char* nA = has_next ? (const char*)g.A + S.a_off(nxt) + (size_t)nxt.pm * tstepA : cA; const char* nB = has_next ? (const char*)g.Bt + (size_t)nxt.pn * tstepB : cB;
        for (int t = 0; t < nt; t += 2) {
            const bool last = (t == nt - 2);
            const char* a1 = cA + (size_t)(t + 1) * kstep;
            const char* a2 = last ? nA : cA + (size_t)(t + 2) * kstep; const char* b2 = last ? nB : cB + (size_t)(t + 2) * kstep;
            const char* a3 = a2 + kstep; const char* b3 = b2 + kstep;
            PG8_LDB(B0, 0, 0); PG8_LDB(B1, 0, 1); PG8_SCHED; PG8_LDA(At, 0, 0); PG8_STAGE(PG8_SA(1, 1), a1 + hstepA, voffA);
            PG8_WAIT_V(8); PG8_WAIT_L(0); PG8_BAR; PG8_MMA(0, 0, At, B0); PG8_MMA(0, 1, At, B1); PG8_BAR; PG8_SCHED;
            PG8_LDA(At, 0, 1); PG8_STAGE(PG8_SB(0, 0), b2, voffB); PG8_STAGE(PG8_SB(0, 1), b2 + hstepB, voffB); PG8_STAGE(PG8_SA(0, 0), a2, voffA);
            PG8_WAIT_V(8); PG8_WAIT_L(0); PG8_BAR; PG8_MMA(1, 0, At, B0); PG8_MMA(1, 1, At, B1); PG8_BAR; PG8_SCHED;
            PG8_LDB(B0, 1, 0); PG8_LDB(B1, 1, 1); PG8_SCHED; PG8_LDA(At, 1, 0); PG8_STAGE(PG8_SA(0, 1), a2 + hstepA, voffA);
            PG8_WAIT_V(8); PG8_WAIT_L(0); PG8_BAR; PG8_MMA(0, 0, At, B0); PG8_MMA(0, 1, At, B1); PG8_BAR; PG8_SCHED;
            PG8_LDA(At, 1, 1); PG8_STAGE(PG8_SB(1, 0), b3, voffB); PG8_STAGE(PG8_SB(1, 1), b3 + hstepB, voffB); PG8_STAGE(PG8_SA(1, 0), a3, voffA);
            PG8_WAIT_V(8); PG8_WAIT_L(0); PG8_BAR; PG8_MMA(1, 0, At, B0); PG8_MMA(1, 1, At, B1); PG8_BAR; PG8_SCHED;
        }
        if (wr == 0) PG8_BAR;
        E(acc, cur, wr, wc, fr, fq);
        if (!has_next) break;
        if (!E.keep(cur)) {
#pragma unroll
            for (int a = 0; a < 2; ++a)
#pragma unroll
                for (int b = 0; b < 2; ++b)
#pragma unroll
                    for (int m = 0; m < 4; ++m)
#pragma unroll
                        for (int n = 0; n < 2; ++n) acc[a][b][m][n] = (f32x4){0.f, 0.f, 0.f, 0.f};
        }
        cur = nxt; cA = nA; cB = nB; ++ui;
        if (wr == 1) PG8_BAR;
    }
    PG8_WAIT_V(0);
    PG8_BAR;
#undef PG8_SA
#undef PG8_SB
#undef PG8_STAGE
#undef PG8_LDA
#undef PG8_LDB
#undef PG8_MMA
#undef PG8_WAIT_V
#undef PG8_WAIT_L
#undef PG8_BAR
#undef PG8_SCHED
}
}

namespace att {
typedef short v4i16_t __attribute__((ext_vector_type(4)));
__device__ __forceinline__ int crow(int r, int hi) { return (r & 3) + 8 * (r >> 2) + 4 * hi; }
__device__ __forceinline__ s16x4 vtr(LAS const unsigned char* p) { return __builtin_bit_cast(s16x4, __builtin_amdgcn_ds_read_tr16_b64_v4i16((LAS v4i16_t*)p)); }
constexpr float C2 = 0.125f * LOG2E;
constexpr float NEG = -1e30f;
constexpr int LDS_K = 0, LDS_V = 16384, LDS_REL = 32768;

template <int VAR>
__device__ __forceinline__ void unit(LAS unsigned char* lds, bf16_t* proj, const float* cumL, const float* sinks, const float* rel, int b, int h, int qb) {
    const int tid = tid_opaque(), lane = tid & 63, r32 = lane & 31, hi = lane >> 5; const int wid = __builtin_amdgcn_readfirstlane(tid >> 6);
    constexpr int QC = VAR == 0 ? QA : (VAR == 1 ? QB_ : QC_), KC = VAR == 0 ? KA : (VAR == 1 ? KB_ : KC_), VC = VAR == 0 ? VA : (VAR == 1 ? VB_ : VC_);
    const int kvh = VAR == 0 ? (h >> 2) : h;
    const size_t rowbase = (size_t)b * SEQ;
    bf16_t* Qw = proj + (rowbase + qb * 256 + wid * 32) * PITCH + QC + h * 64;
    const bf16_t* Kh = proj + rowbase * PITCH + KC + kvh * 64;
    const bf16_t* Vh = proj + rowbase * PITCH + VC + kvh * 64;
    const int c = 4 * qb + (wid >> 1);
    constexpr int BACK = VAR == 0 ? 2 : (VAR == 1 ? 1000 : 8);
    const int kt_lo = VAR == 1 ? 0 : (4 * qb - BACK > 0 ? 4 * qb - BACK : 0);
    const int kt_hi = 4 * qb + 3;
    LAS float* relL = (LAS float*)(lds + LDS_REL);
    if (VAR == 2) { for (int i = tid; i < 257; i += 512) relL[i] = rel[h * 257 + i] * LOG2E; }
    bf16x8 qr[4];
#pragma unroll
    for (int d0 = 0; d0 < 4; ++d0) qr[d0] = *(const bf16x8*)(Qw + (size_t)r32 * PITCH + d0 * 16 + hi * 8);
    const bf16_t* ksrc = Kh + (size_t)lane * PITCH + wid * 8;
    const bf16_t* vsrc = Vh + (size_t)(16 * (wid & 3) + (lane >> 2)) * PITCH + (wid >> 2) * 32 + (lane & 3) * 8;
    const int sdst = wid * 1024 + lane * 16;
    u32x4 kreg = *(const u32x4*)(ksrc + (size_t)kt_lo * 64 * PITCH), vreg = *(const u32x4*)(vsrc + (size_t)kt_lo * 64 * PITCH);
    *(LAS u32x4*)(lds + LDS_K + sdst) = kreg; *(LAS u32x4*)(lds + LDS_V + sdst) = vreg;
    __syncthreads();
    float mrow = NEG, lrow = 0.f;
    f32x16 o0, o1;
#pragma unroll
    for (int r = 0; r < 16; ++r) { o0[r] = 0.f; o1[r] = 0.f; }
    const float cq = VAR == 1 ? cumL[(size_t)(b * 8 + h) * SEQ + qb * 256 + wid * 32 + r32] : 0.f;
    const float slopeL = VAR == 0 ? exp2f(-(float)(h + 1)) * LOG2E : 0.f;
    const int qloc = 32 * (wid & 1) + r32;
    int cur = 0;
    for (int kt = kt_lo; kt <= kt_hi; ++kt) {
        const bool has_next = kt < kt_hi;
        if (has_next) { kreg = *(const u32x4*)(ksrc + (size_t)(kt + 1) * 64 * PITCH); vreg = *(const u32x4*)(vsrc + (size_t)(kt + 1) * 64 * PITCH); }
        const int dk = c - kt;
        if (dk >= 0 && dk <= BACK) {
            LAS const unsigned char* kp = lds + LDS_K + cur * 8192 + hi * 1024 + r32 * 16;
            f32x16 p0, p1;
#pragma unroll
            for (int r = 0; r < 16; ++r) { p0[r] = 0.f; p1[r] = 0.f; }
#pragma unroll
            for (int d0 = 0; d0 < 4; ++d0) {
                const bf16x8 k0 = *(LAS const bf16x8*)(kp + d0 * 2048), k1 = *(LAS const bf16x8*)(kp + d0 * 2048 + 512);
                p0 = __builtin_amdgcn_mfma_f32_32x32x16_bf16(k0, qr[d0], p0, 0, 0, 0);
                p1 = __builtin_amdgcn_mfma_f32_32x32x16_bf16(k1, qr[d0], p1, 0, 0, 0);
            }
            if (VAR == 0) {
                const int dq = 64 * dk + qloc;
#pragma unroll
                for (int r = 0; r < 16; ++r) { const int key = crow(r, hi);
                    p0[r] = p0[r] * C2 - slopeL * fabsf((float)(dq - key)); p1[r] = p1[r] * C2 - slopeL * fabsf((float)(dq - key - 32)); }
            } else if (VAR == 1) {
                const float* ckp = cumL + (size_t)(b * 8 + h) * SEQ + kt * 64 + 4 * hi;
#pragma unroll
                for (int g = 0; g < 4; ++g) { const f32x4 c0 = *(const f32x4*)(ckp + 8 * g), c1 = *(const f32x4*)(ckp + 32 + 8 * g);
#pragma unroll
                    for (int i = 0; i < 4; ++i) { p0[4 * g + i] = p0[4 * g + i] * C2 + (cq - c0[i]); p1[4 * g + i] = p1[4 * g + i] * C2 + (cq - c1[i]); } }
                if (dk == 0) {
#pragma unroll
                    for (int r = 0; r < 16; ++r) { const int key = crow(r, hi); if (key > qloc) p0[r] = NEG; if (key + 32 > qloc) p1[r] = NEG; }
                }
            } else {
                if (dk >= 3) { const float rf = relL[256];
#pragma unroll
                    for (int r = 0; r < 16; ++r) { p0[r] = p0[r] * C2 + rf; p1[r] = p1[r] * C2 + rf; }
                } else { const int dq = 64 * dk + qloc + 128;
#pragma unroll
                    for (int r = 0; r < 16; ++r) { const int key = crow(r, hi); int i0 = dq - key, i1 = dq - key - 32; i0 = i0 > 256 ? 256 : i0; i1 = i1 > 256 ? 256 : i1;
                        p0[r] = p0[r] * C2 + relL[i0]; p1[r] = p1[r] * C2 + relL[i1]; }
                }
            }
            float rm = fmaxf(p0[0], p1[0]);
#pragma unroll
            for (int r = 1; r < 16; ++r) rm = fmaxf(rm, fmaxf(p0[r], p1[r]));
            rm = fmaxf(rm, __shfl_xor(rm, 32));
            const float mnew = fmaxf(mrow, rm), alpha = exp2f(mrow - mnew);
            mrow = mnew;
            float ls = 0.f;
#pragma unroll
            for (int r = 0; r < 16; ++r) { p0[r] = exp2f(p0[r] - mnew); p1[r] = exp2f(p1[r] - mnew); ls += p0[r] + p1[r]; }
            lrow = lrow * alpha + ls;
#pragma unroll
            for (int r = 0; r < 16; ++r) { o0[r] *= alpha; o1[r] *= alpha; }
            u32x4 pw[4];
#pragma unroll
            for (int i = 0; i < 4; ++i) { pw[0][i] = cvt_pk_bf16(p0[2 * i], p0[2 * i + 1]); pw[1][i] = cvt_pk_bf16(p0[8 + 2 * i], p0[9 + 2 * i]);
                                          pw[2][i] = cvt_pk_bf16(p1[2 * i], p1[2 * i + 1]); pw[3][i] = cvt_pk_bf16(p1[8 + 2 * i], p1[9 + 2 * i]); }
            LAS const unsigned char* vp = lds + LDS_V + cur * 8192 + ((lane >> 4) & 1) * 32 + (lane & 3) * 8 + (4 * hi + ((lane & 15) >> 2)) * 64;
#pragma unroll
            for (int ks = 0; ks < 4; ++ks) {
                const bf16x8 pf = __builtin_bit_cast(bf16x8, pw[ks]);
                { const s16x4 lo = vtr(vp + ks * 1024), hh = vtr(vp + ks * 1024 + 512);
                  const bf16x8 vf = (bf16x8){lo[0], lo[1], lo[2], lo[3], hh[0], hh[1], hh[2], hh[3]};
                  o0 = __builtin_amdgcn_mfma_f32_32x32x16_bf16(vf, pf, o0, 0, 0, 0); }
                { const s16x4 lo = vtr(vp + 4096 + ks * 1024), hh = vtr(vp + 4096 + ks * 1024 + 512);
                  const bf16x8 vf = (bf16x8){lo[0], lo[1], lo[2], lo[3], hh[0], hh[1], hh[2], hh[3]};
                  o1 = __builtin_amdgcn_mfma_f32_32x32x16_bf16(vf, pf, o1, 0, 0, 0); }
            }
        }
        if (has_next) { *(LAS u32x4*)(lds + LDS_K + (cur ^ 1) * 8192 + sdst) = kreg; *(LAS u32x4*)(lds + LDS_V + (cur ^ 1) * 8192 + sdst) = vreg; }
        __syncthreads();
        cur ^= 1;
    }
    lrow += __shfl_xor(lrow, 32);
    if (VAR == 0) lrow += exp2f(sinks[h] * LOG2E - mrow);
    const float rl = 1.0f / lrow;
    bf16_t* orow = Qw + (size_t)r32 * PITCH + 4 * hi;
#pragma unroll
    for (int g = 0; g < 4; ++g) {
        u32x2 w0, w1;
        w0.x = cvt_pk_bf16(o0[4 * g] * rl, o0[4 * g + 1] * rl); w0.y = cvt_pk_bf16(o0[4 * g + 2] * rl, o0[4 * g + 3] * rl);
        w1.x = cvt_pk_bf16(o1[4 * g] * rl, o1[4 * g + 1] * rl); w1.y = cvt_pk_bf16(o1[4 * g + 2] * rl, o1[4 * g + 3] * rl);
        *(u32x2*)(orow + 8 * g) = w0; *(u32x2*)(orow + 32 + 8 * g) = w1;
    }
}
}

__device__ __forceinline__ void mod_phase(LAS unsigned char* lds, const float* cvec, const float* w_ada, const float* b_ada, float* mod) {
    const int tid = tid_opaque(), lane = tid & 63, wid = tid >> 6;
    LAS float* condL = (LAS float*)lds;
    LAS float* red = (LAS float*)(lds + 32768);
    for (int i = tid; i < BATCH * D; i += 512) { const float c = cvec[i]; condL[i] = c / (1.0f + __expf(-c)); }
    __syncthreads();
    for (int cb = blockIdx.x; cb < 192; cb += gridDim.x) {
        const int l = cb / 96, e0 = (cb % 96) * 64;
        float acc[8];
#pragma unroll
        for (int b = 0; b < 8; ++b) acc[b] = 0.f;
        const float* w = w_ada + ((size_t)l * D + wid * 128) * 6144 + e0 + lane;
#pragma unroll 4
        for (int d = 0; d < 128; ++d) { const float wv = w[(size_t)d * 6144];
#pragma unroll
            for (int b = 0; b < 8; ++b) acc[b] += condL[b * D + wid * 128 + d] * wv; }
#pragma unroll
        for (int b = 0; b < 8; ++b) red[(wid * 8 + b) * 64 + lane] = acc[b];
        __syncthreads();
        { const int b = tid >> 6; float s = b_ada[l * 6144 + e0 + lane];
#pragma unroll
          for (int w8 = 0; w8 < 8; ++w8) s += red[(w8 * 8 + b) * 64 + lane];
          mod[(size_t)(l * 8 + b) * 6144 + e0 + lane] = s; }
        __syncthreads();
    }
}
__device__ __forceinline__ void transpose_item(const float* W, int Nsrc, int nsrc, int k0, bf16_t* WT, int K, int ndst, LAS float* scr, int lane) {
#pragma unroll 8
    for (int i = 0; i < 32; ++i) { const int kk = 2 * i + (lane >> 5); scr[kk * 33 + (lane & 31)] = W[(size_t)(k0 + kk) * Nsrc + nsrc + (lane & 31)]; }
    asm volatile("s_waitcnt lgkmcnt(0)" ::: "memory");
    const int c = lane & 7;
#pragma unroll
    for (int j = 0; j < 4; ++j) { const int n = (lane >> 3) + 8 * j; const LAS float* s = scr + (8 * c) * 33 + n;
        u32x4 o; o.x = cvt_pk_bf16(s[0 * 33], s[1 * 33]); o.y = cvt_pk_bf16(s[2 * 33], s[3 * 33]); o.z = cvt_pk_bf16(s[4 * 33], s[5 * 33]); o.w = cvt_pk_bf16(s[6 * 33], s[7 * 33]);
        *(u32x4*)(WT + (size_t)(ndst + n) * K + k0 + 8 * c) = o; }
    asm volatile("s_waitcnt lgkmcnt(0)" ::: "memory");
}
struct Ptrs {
    const float *x, *c, *norm_mix_g, *norm_ffn_g, *w_ada, *b_ada, *w_in, *b_forget, *sinks, *rel_bias, *w_branch, *w_out, *w_ffn_in, *w_ffn_out, *final_norm_g;
};
__device__ __forceinline__ void convert_phase(LAS unsigned char* lds, const Ptrs& P, unsigned char* ws) {
    const int tid = tid_opaque(), lane = tid & 63, wid = tid >> 6;
    LAS float* scr = (LAS float*)(lds + 65536 + wid * 8448);
    const int gw = blockIdx.x * 8 + wid, NGW = gridDim.x * 8;
    constexpr int I_QKV = 16 * (NQKV / 32), I_G = 16 * (NG / 32), I_BR = 3 * 8 * 32, I_OUT = 16 * 32, I_FI = 16 * (FF2 / 32), I_FO = (FFH / 64) * 32;
    constexpr int I_LAYER = I_QKV + I_G + I_BR + I_OUT + I_FI + I_FO;
    for (int it = gw; it < 2 * I_LAYER; it += NGW) {
        const int l = it / I_LAYER; int r = it % I_LAYER;
        unsigned char* wl = ws + WS_W + (size_t)l * W_LAYER;
        if (r < I_QKV) { const int nb = r % (NQKV / 32), kb = r / (NQKV / 32), n0 = 32 * nb;
            transpose_item(P.w_in + (size_t)l * D * NIN, NIN, n0 < 2304 ? n0 : n0 + 8, 64 * kb, (bf16_t*)(wl + W_QKV), D, n0, scr, lane); continue; } r -= I_QKV;
        if (r < I_G) { const int nb = r % (NG / 32), kb = r / (NG / 32), n0 = 32 * nb;
            transpose_item(P.w_in + (size_t)l * D * NIN, NIN, G_SRC + n0, 64 * kb, (bf16_t*)(wl + W_G), D, n0, scr, lane); continue; } r -= I_G;
        if (r < I_BR) { const int k = r / 256, rr = r % 256, nb = rr % 32, kb = rr / 32;
            transpose_item(P.w_branch + ((size_t)l * 3 + k) * 512 * D, D, 32 * nb, 64 * kb, (bf16_t*)(wl + W_BR), 512, k * D + 32 * nb, scr, lane); continue; } r -= I_BR;
        if (r < I_OUT) { const int nb = r % 32, kb = r / 32;
            transpose_item(P.w_out + (size_t)l * D * D, D, 32 * nb, 64 * kb, (bf16_t*)(wl + W_OUT), D, 32 * nb, scr, lane); continue; } r -= I_OUT;
        if (r < I_FI) { const int nb = r % (FF2 / 32), kb = r / (FF2 / 32), n0 = 32 * nb, pn = n0 >> 8, w = n0 & 255;
            const int src = w < 128 ? 128 * pn + w : FFH + 128 * pn + (w - 128);
            transpose_item(P.w_ffn_in + (size_t)l * D * FF2, FF2, src, 64 * kb, (bf16_t*)(wl + W_FI), D, n0, scr, lane); continue; } r -= I_FI;
        { const int nb = r % 32, kb = r / 32;
            transpose_item(P.w_ffn_out + (size_t)l * FFH * D, D, 32 * nb, 64 * kb, (bf16_t*)(wl + W_FO), FFH, 32 * nb, scr, lane); }
    }
}
template <bool FB>
__device__ __forceinline__ void norm_phase(LAS unsigned char* lds, const float* xin, const float* g, const float* shift0, const float* scale0, bf16_t* hout,
                                           const float* w_in_l, const float* b_forget_l, float* flog) {
    const int tid = tid_opaque(), lane = tid & 63, wid = tid >> 6;
    LAS float* wfb = (LAS float*)lds;
    if (FB) { for (int i = tid; i < 8 * D; i += 512) { const int d = i >> 3, e = i & 7; wfb[e * D + d] = w_in_l[(size_t)d * NIN + FB_SRC + e]; } __syncthreads(); }
    const int gw = blockIdx.x * 8 + wid, NGW = gridDim.x * 8;
    for (int rc = gw; rc < M / 8; rc += NGW) {
        const int row0 = rc * 8, b = row0 / SEQ;
        f32x4 am[4], sh[4];
#pragma unroll
        for (int j = 0; j < 4; ++j) { const int d = 4 * lane + 256 * j; const f32x4 gv = *(const f32x4*)(g + d), sc = *(const f32x4*)(scale0 + (size_t)b * 6144 + d);
            am[j] = gv * (1.0f + sc); sh[j] = *(const f32x4*)(shift0 + (size_t)b * 6144 + d); }
        for (int r = 0; r < 8; ++r) {
            const size_t row = row0 + r;
            const f32x4* xr = (const f32x4*)(xin + row * D) + lane;
            f32x4 v[4]; float s = 0.f;
#pragma unroll
            for (int j = 0; j < 4; ++j) { v[j] = xr[64 * j]; s += (v[j].x * v[j].x + v[j].y * v[j].y) + (v[j].z * v[j].z + v[j].w * v[j].w); }
            const float rstd = 1.0f / sqrtf(wave_sum(s) * (1.0f / D) + EPS);
#pragma unroll
            for (int j = 0; j < 4; ++j) v[j] = v[j] * rstd * am[j] + sh[j];
            u32x2* o8 = (u32x2*)(hout + row * D) + lane;
#pragma unroll
            for (int j = 0; j < 4; ++j) { u32x2 w; w.x = cvt_pk_bf16(v[j].x, v[j].y); w.y = cvt_pk_bf16(v[j].z, v[j].w); o8[64 * j] = w; }
            if (FB) {
                float pe[8];
#pragma unroll
                for (int e = 0; e < 8; ++e) { float a = 0.f;
#pragma unroll
                    for (int j = 0; j < 4; ++j) { const f32x4 wv = *(LAS const f32x4*)(wfb + e * D + 4 * lane + 256 * j); a += (v[j].x * wv.x + v[j].y * wv.y) + (v[j].z * wv.z + v[j].w * wv.w); }
                    pe[e] = wave_sum(a); }
                if (lane == 0) {
                    f32x4 f0 = {pe[0] + b_forget_l[0], pe[1] + b_forget_l[1], pe[2] + b_forget_l[2], pe[3] + b_forget_l[3]};
                    f32x4 f1 = {pe[4] + b_forget_l[4], pe[5] + b_forget_l[5], pe[6] + b_forget_l[6], pe[7] + b_forget_l[7]};
                    *(f32x4*)(flog + row * 8) = f0; *(f32x4*)(flog + row * 8 + 4) = f1;
                }
            }
        }
    }
}
__device__ __forceinline__ void cumsum_phase(LAS unsigned char* lds, const float* flog, float* cumL) {
    const int tid = tid_opaque(), lane = tid & 63, wid = tid >> 6;
    LAS float* wt = (LAS float*)lds;
    for (int bh = blockIdx.x; bh < 64; bh += gridDim.x) {
        const int b = bh >> 3, h = bh & 7;
        float v[4]; float run = 0.f;
#pragma unroll
        for (int i = 0; i < 4; ++i) { const float f = flog[((size_t)b * SEQ + 4 * tid + i) * 8 + h];
            const float ls = fminf(f, 0.f) - log1pf(expf(-fabsf(f))); run += ls; v[i] = run; }
        float inc = run;
#pragma unroll
        for (int o = 1; o < 64; o <<= 1) { const float t = __shfl_up(inc, o); if (lane >= o) inc += t; }
        if (lane == 63) wt[wid] = inc;
        __syncthreads();
        float base = inc - run;
        for (int w8 = 0; w8 < wid; ++w8) base += wt[w8];
        f32x4 o4 = {(v[0] + base) * LOG2E, (v[1] + base) * LOG2E, (v[2] + base) * LOG2E, (v[3] + base) * LOG2E};
        *(f32x4*)(cumL + (size_t)bh * SEQ + 4 * tid) = o4;
        __syncthreads();
    }
}
__device__ __forceinline__ void final_norm_phase(float* x, const float* g) {
    const int tid = tid_opaque(), lane = tid & 63, wid = tid >> 6;
    const int gw = blockIdx.x * 8 + wid, NGW = gridDim.x * 8;
    f32x4 gv[4];
#pragma unroll
    for (int j = 0; j < 4; ++j) gv[j] = *(const f32x4*)(g + 4 * lane + 256 * j);
    for (int row = gw; row < M; row += NGW) {
        f32x4* xr = (f32x4*)(x + (size_t)row * D) + lane;
        f32x4 v[4]; float s = 0.f;
#pragma unroll
        for (int j = 0; j < 4; ++j) { v[j] = xr[64 * j]; s += (v[j].x * v[j].x + v[j].y * v[j].y) + (v[j].z * v[j].z + v[j].w * v[j].w); }
        const float rstd = 1.0f / sqrtf(wave_sum(s) * (1.0f / D) + EPS);
#pragma unroll
        for (int j = 0; j < 4; ++j) xr[64 * j] = v[j] * rstd * gv[j];
    }
}

constexpr int LDS_BYTES = 147456;
constexpr int N_PHASES = 20;
#ifndef PH_MASK
#define PH_MASK 0xFFFF
#endif
#define PHON(k) ((PH_MASK >> (k)) & 1)
struct Args { Ptrs p; float* out; unsigned char* ws; int ph_lo, ph_hi; };

__global__ void __launch_bounds__(512, 2) fwd_kernel(Args a) {
    extern __shared__ __attribute__((aligned(16))) unsigned char lds_raw[];
    LAS unsigned char* lds = (LAS unsigned char*)lds_raw;
    cg::grid_group grid = cg::this_grid();
    const Ptrs& P = a.p;
    for (int ph = a.ph_lo; ph < a.ph_hi; ++ph) {
        if (ph > a.ph_lo) grid.sync();
        unsigned char* ws = a.ws; float* outp = a.out; int G = gridDim.x, bx = blockIdx.x;
        asm volatile("" : "+s"(ws), "+s"(outp), "+s"(G), "+s"(bx));
        float* mod = (float*)(ws + WS_MOD); float* flog = (float*)(ws + WS_FLOG); float* cumL = (float*)(ws + WS_CUM);
        bf16_t* hbuf = (bf16_t*)(ws + WS_H); bf16_t* proj = (bf16_t*)(ws + WS_PROJ); bf16_t* act = (bf16_t*)(ws + WS_PROJ);
        if (ph == 0) { if (PHON(9)) mod_phase(lds, P.c, P.w_ada, P.b_ada, mod); if (PHON(10)) convert_phase(lds, P, ws); continue; }
        if (ph == N_PHASES - 1) { if (PHON(11)) final_norm_phase(outp, P.final_norm_g); continue; }
        const int l = (ph - 1) / 9, sp = (ph - 1) % 9;
        const unsigned char* wl = ws + WS_W + (size_t)l * W_LAYER;
        const float* modl = mod + (size_t)l * 8 * 6144;
        const float* xin = l == 0 ? P.x : outp;
        switch (sp) {
        case 0: if (PHON(0)) norm_phase<true>(lds, xin, P.norm_mix_g + l * D, modl + 0 * D, modl + 1 * D, hbuf, P.w_in + (size_t)l * D * NIN, P.b_forget + l * 8, flog); break;
        case 1: if (PHON(1)) { cumsum_phase(lds, flog, cumL);
            pg8::Gemm g{hbuf, (const bf16_t*)(wl + W_QKV), M, NQKV, D, D}; pg8::StaticOrder S; S.init(M, NQKV, G, bx);
            pg8::EpiQKV E{proj}; pg8::gemm_phase(lds, g, S, E); } break;
        case 2: if (PHON(2)) {
            for (int v = bx; v < 256; v += G) {
                const int bh = v >> 2, j = v & 3, b = bh >> 3, h = bh & 7;
                att::unit<1>(lds, proj, cumL, P.sinks + l * 8, P.rel_bias + l * 8 * 257, b, h, 7 - j);
                att::unit<1>(lds, proj, cumL, P.sinks + l * 8, P.rel_bias + l * 8 * 257, b, h, j);
                att::unit<2>(lds, proj, cumL, P.sinks + l * 8, P.rel_bias + l * 8 * 257, b, h, 2 * j);
                att::unit<2>(lds, proj, cumL, P.sinks + l * 8, P.rel_bias + l * 8 * 257, b, h, 2 * j + 1);
                att::unit<0>(lds, proj, cumL, P.sinks + l * 8, P.rel_bias + l * 8 * 257, b, h, 2 * j);
                att::unit<0>(lds, proj, cumL, P.sinks + l * 8, P.rel_bias + l * 8 * 257, b, h, 2 * j + 1);
            } } break;
        case 3: if (PHON(3)) { pg8::Gemm g{hbuf, (const bf16_t*)(wl + W_G), M, NG, D, D}; pg8::StaticOrder S; S.init(M, NG, G, bx);
            pg8::EpiGate E{proj}; pg8::gemm_phase(lds, g, S, E); } break;
        case 4: if (PHON(4)) { pg8::Gemm g{proj, (const bf16_t*)(wl + W_BR), M, 3 * D, 512, PITCH}; pg8::BranchOrder S; S.so.init(M, D, G, bx);
            pg8::EpiBranch E{proj, hbuf}; pg8::gemm_phase(lds, g, S, E); } break;
        case 5: if (PHON(5)) { pg8::Gemm g{hbuf, (const bf16_t*)(wl + W_OUT), M, D, D, D}; pg8::StaticOrder S; S.init(M, D, G, bx);
            pg8::EpiRes E{xin, outp, modl + 2 * D}; pg8::gemm_phase(lds, g, S, E); } break;
        case 6: if (PHON(6)) norm_phase<false>(lds, outp, P.norm_ffn_g + l * D, modl + 3 * D, modl + 4 * D, hbuf, nullptr, nullptr, nullptr); break;
        case 7: if (PHON(7)) { pg8::Gemm g{hbuf, (const bf16_t*)(wl + W_FI), M, FF2, D, D}; pg8::StaticOrder S; S.init(M, FF2, G, bx);
            pg8::EpiSwiglu E{act}; pg8::gemm_phase(lds, g, S, E); } break;
        case 8: if (PHON(8)) { pg8::Gemm g{act, (const bf16_t*)(wl + W_FO), M, D, FFH, FFH}; pg8::StaticOrder S; S.init(M, D, G, bx);
            pg8::EpiRes E{outp, outp, modl + 5 * D}; pg8::gemm_phase(lds, g, S, E); } break;
        }
    }
}

extern "C" void kernel_launch(void* const* d_in, const int* in_sizes, int n_in, void* d_out, int out_size, void* d_ws, size_t ws_size, hipStream_t stream) {
    static int grid = 0;
    if (grid == 0) {
        if (n_in != 15 || out_size != M * D || ws_size < WS_END) { fprintf(stderr, "kernel_launch: unexpected shapes (n_in %d out %d ws %zu)\n", n_in, out_size, ws_size); grid = -1; return; }
        int dev = 0, cus = 0, per_cu = 0;
        hipGetDevice(&dev); hipDeviceGetAttribute(&cus, hipDeviceAttributeMultiprocessorCount, dev);
        if (hipFuncSetAttribute((const void*)fwd_kernel, hipFuncAttributeMaxDynamicSharedMemorySize, LDS_BYTES) != hipSuccess) { fprintf(stderr, "kernel_launch: hipFuncSetAttribute failed\n"); grid = -1; return; }
        if (hipOccupancyMaxActiveBlocksPerMultiprocessor(&per_cu, (const void*)fwd_kernel, 512, LDS_BYTES) != hipSuccess || per_cu < 1) { fprintf(stderr, "kernel_launch: occupancy query gave %d\n", per_cu); per_cu = 1; }
        (void)hipGetLastError();
        grid = cus * (per_cu > 1 ? 1 : per_cu);
        if (grid > 256) grid = 256;
    }
    if (grid < 0) return;
    Args a{};
    const float** pp = (const float**)&a.p;
    for (int i = 0; i < 15; ++i) pp[i] = (const float*)d_in[i];
    a.out = (float*)d_out; a.ws = (unsigned char*)d_ws;
#if N_LAUNCH_MODE
    for (int ph = 0; ph < N_PHASES; ++ph) { a.ph_lo = ph; a.ph_hi = ph + 1; hipLaunchKernelGGL(fwd_kernel, dim3(grid), dim3(512), LDS_BYTES, stream, a); }
#else
    a.ph_lo = 0; a.ph_hi = N_PHASES;
    void* args[] = {&a};
    hipError_t e = hipLaunchCooperativeKernel((const void*)fwd_kernel, dim3(grid), dim3(512), args, LDS_BYTES, stream);
    if (e != hipSuccess) fprintf(stderr, "cooperative launch failed: %s (grid %d)\n", hipGetErrorString(e), grid);
#endif
}
```

```cpp
#include <hip/hip_runtime.h>
#include <hip/hip_cooperative_groups.h>
#include <cstdio>
#include <cstdint>
namespace cg = cooperative_groups;

#ifndef N_LAUNCH_MODE
#define N_LAUNCH_MODE 0
#endif

#define LAS __attribute__((address_space(3)))
typedef unsigned short bf16_t;
typedef short bf16x8 __attribute__((ext_vector_type(8)));
typedef short s16x4 __attribute__((ext_vector_type(4)));
typedef float f32x4 __attribute__((ext_vector_type(4)));
typedef float f32x16 __attribute__((ext_vector_type(16)));
typedef unsigned u32x4 __attribute__((ext_vector_type(4)));
typedef unsigned u32x2 __attribute__((ext_vector_type(2)));

constexpr int BATCH = 8, SEQ = 2048, D = 1024, M = BATCH * SEQ, DEPTH = 2;
constexpr int NIN = 6920, FFH = 2816, FF2 = 2 * FFH;
constexpr int PITCH = 4608;
constexpr int NQKV = 3840, NQKVF = 4096, NG = 3072;
constexpr int FB_SRC = 2304;
constexpr int G_SRC = 3848;
constexpr float EPS = 1e-6f;
constexpr float LOG2E = 1.4426950408889634f;

constexpr size_t MiB = 1u << 20;
constexpr size_t WS_MOD = 0;
constexpr size_t WS_FLOG = 512 * 1024;
constexpr size_t WS_BAR = 1536 * 1024;
constexpr size_t WS_CNT = WS_BAR + 16384;
constexpr size_t WS_ZERO_BYTES = 16384 + 4 * 16384;
constexpr size_t WS_SLOT = 1024 * 1024;
constexpr size_t WS_W = 2 * MiB;
constexpr size_t W_QKV = 0, W_G = W_QKV + (size_t)NQKVF * D * 2, W_BR = W_G + (size_t)NG * D * 2, W_OUT = W_BR + (size_t)3 * D * 512 * 2,
                 W_FI = W_OUT + (size_t)D * D * 2, W_FO = W_FI + (size_t)FF2 * D * 2, W_LAYER = W_FO + (size_t)D * FFH * 2;
static_assert(W_LAYER == 35 * MiB + 512 * 1024, "weights per layer");
constexpr size_t WS_H = WS_W + 2 * W_LAYER;
constexpr size_t WS_PROJ = WS_H + (size_t)M * D * 2;
constexpr size_t WS_END = WS_PROJ + (size_t)M * PITCH * 2;
static_assert(WS_END <= 256 * MiB, "workspace");

constexpr int QA = 0, KA = 512, VA = 640, QB_ = 768, KB_ = 1280, VB_ = 1792, QC_ = 2304, KC_ = 2816, VC_ = 3328;
__host__ __device__ __forceinline__ int gate_col(int j) {
    return j == 0 ? 512 : (j < 4 ? 3840 + 256 * (j - 1) : (j < 8 ? 1280 + 256 * (j - 4) : 2816 + 256 * (j - 8)));
}

__device__ __forceinline__ unsigned cvt_pk_bf16(float lo, float hi) { unsigned r; asm volatile("v_cvt_pk_bf16_f32 %0, %1, %2" : "=v"(r) : "v"(lo), "v"(hi)); return r; }
__device__ __forceinline__ float bf_lo(unsigned w) { return __uint_as_float(w << 16); }
__device__ __forceinline__ float bf_hi(unsigned w) { return __uint_as_float(w & 0xffff0000u); }
__device__ __forceinline__ float wave_sum(float v) {
#pragma unroll
    for (int o = 1; o < 64; o <<= 1) v += __shfl_xor(v, o);
    return v;
}
__device__ __forceinline__ int tid_opaque() { int t = threadIdx.x; asm volatile("" : "+v"(t)); return t; }
__device__ __forceinline__ float sigmoidf_(float x) { return __builtin_amdgcn_rcpf(1.0f + __builtin_amdgcn_exp2f(-LOG2E * x)); }

__device__ __forceinline__ float reduce8(const float (&a)[8], int lane);
namespace pg8 {
constexpr int BM = 256, BK = 64, HALF = 128, HTB = HALF * BK * 2, STAGE_BYTES = 8 * HTB, NXCD = 8, WGM = 8;
__host__ __device__ __forceinline__ int lds_byte(int r, int c) { const int st = (r >> 4) * 2 + (c >> 5), rr = r & 15, cc = c & 31, ob = rr * 64 + cc * 2; return st * 1024 + (ob ^ (((ob >> 9) & 1) << 5)); }
__host__ __device__ __forceinline__ void stage_rc(int b, int& R, int& C) { const int st = b / 1024, sb = b % 1024, swz = sb ^ (((sb >> 9) & 1) << 5); R = (st >> 1) * 16 + swz / 64; C = (st & 1) * 32 + (swz % 64) / 2; }
__host__ __device__ __forceinline__ int perm32(int rho) { const int n = rho >> 4, i = rho & 15; return 8 * (i >> 2) + 4 * n + (i & 3); }

struct Unit { int pm, pn, k; };
struct Gemm { const bf16_t* A; const bf16_t* Bt; int M, N, K, lda; };

struct StaticOrder {
    int nM, nN, nwg, G, c;
    __device__ void init(int M_, int N_, int G_, int c_) { nM = M_ / BM; nN = N_ / BM; nwg = nM * nN; G = G_; c = c_; }
    __device__ __forceinline__ bool tile(int i, int& pm, int& pn) const {
        const long L = (long)i * G + c; if (L >= nwg) return false;
        int wgid = (int)L; { const int q = nwg / NXCD, r = nwg % NXCD, xcd = wgid % NXCD, off = wgid / NXCD; wgid = (xcd < r ? xcd * (q + 1) : r * (q + 1) + (xcd - r) * q) + off; }
        const int nig = WGM * nN, gid = wgid / nig, fm = gid * WGM, gsz = (nM - fm) < WGM ? (nM - fm) : WGM;
        pm = fm + ((wgid % nig) % gsz); pn = (wgid % nig) / gsz; return true;
    }
    __device__ __forceinline__ bool next(int i, Unit& u) const { u.k = 0; return tile(i, u.pm, u.pn); }
    __device__ __forceinline__ size_t a_off(const Unit&) const { return 0; }
};
struct BranchOrder {
    StaticOrder so;
    __device__ __forceinline__ bool next(int i, Unit& u) const { int pm, cn; if (!so.tile(i / 3, pm, cn)) return false; u.k = i % 3; u.pm = pm; u.pn = 4 * u.k + cn; return true; }
    __device__ __forceinline__ size_t a_off(const Unit& u) const { return (size_t)(u.k == 0 ? QA : (u.k == 1 ? QB_ : QC_)) * 2; }
};

struct EpiQKV {
    static constexpr bool PERM = true, AFTER_DRAIN = false;
    bf16_t* O; float* flog; const float* bfg;
    __device__ __forceinline__ bool keep(const Unit&) const { return false; }
    __device__ __forceinline__ void operator()(f32x4 (&acc)[2][2][4][2], const Unit& u, int wr, int wc, int fr, int fq) const {
        if (u.pn == 15) {
            if (wc == 0 && fq == 0) {
                const f32x4 b0 = *(const f32x4*)(bfg), b1 = *(const f32x4*)(bfg + 4);
#pragma unroll
                for (int ai = 0; ai < 2; ++ai)
#pragma unroll
                    for (int m = 0; m < 4; ++m) { float* fp = flog + (size_t)(u.pm * BM + ai * HALF + wr * 64 + m * 16 + fr) * 8;
                        *(f32x4*)fp = acc[ai][0][m][0] + b0; *(f32x4*)(fp + 4) = acc[ai][0][m][1] + b1; }
            }
            return;
        }
        const int row0 = u.pm * BM + wr * 64 + fr, col0 = u.pn * BM + wc * 32 + 8 * fq;
        const bool isq = (u.pn < 2) || (u.pn == 3) || (u.pn == 4) || (u.pn == 9) || (u.pn == 10);
        const float qs = isq ? 0.125f * LOG2E : 1.0f;
#pragma unroll
        for (int ai = 0; ai < 2; ++ai)
#pragma unroll
            for (int m = 0; m < 4; ++m) { bf16_t* rowp = O + (size_t)(row0 + ai * HALF + m * 16) * PITCH + col0;
#pragma unroll
                for (int bj = 0; bj < 2; ++bj) { const f32x4 v0 = acc[ai][bj][m][0] * qs, v1 = acc[ai][bj][m][1] * qs;
                    u32x4 w; w.x = cvt_pk_bf16(v0[0], v0[1]); w.y = cvt_pk_bf16(v0[2], v0[3]); w.z = cvt_pk_bf16(v1[0], v1[1]); w.w = cvt_pk_bf16(v1[2], v1[3]);
                    *(u32x4*)(rowp + bj * HALF) = w; } }
    }
};
struct EpiGate {
    static constexpr bool PERM = true, AFTER_DRAIN = false;
    bf16_t* O;
    __device__ __forceinline__ bool keep(const Unit&) const { return false; }
    __device__ __forceinline__ void operator()(f32x4 (&acc)[2][2][4][2], const Unit& u, int wr, int wc, int fr, int fq) const {
        const int row0 = u.pm * BM + wr * 64 + fr, col0 = gate_col(u.pn) + wc * 32 + 8 * fq;
#pragma unroll
        for (int ai = 0; ai < 2; ++ai)
#pragma unroll
            for (int m = 0; m < 4; ++m) { bf16_t* rowp = O + (size_t)(row0 + ai * HALF + m * 16) * PITCH + col0;
#pragma unroll
                for (int bj = 0; bj < 2; ++bj) { f32x4 v0 = acc[ai][bj][m][0], v1 = acc[ai][bj][m][1];
#pragma unroll
                    for (int i = 0; i < 4; ++i) { v0[i] = fmaxf(sigmoidf_(v0[i]), 1e-6f); v1[i] = fmaxf(sigmoidf_(v1[i]), 1e-6f); }
                    u32x4 w; w.x = cvt_pk_bf16(v0[0], v0[1]); w.y = cvt_pk_bf16(v0[2], v0[3]); w.z = cvt_pk_bf16(v1[0], v1[1]); w.w = cvt_pk_bf16(v1[2], v1[3]);
                    *(u32x4*)(rowp + bj * HALF) = w; } }
    }
};
struct EpiBranch {
    static constexpr bool PERM = true, AFTER_DRAIN = false;
    const bf16_t* P; bf16_t* O;
    __device__ __forceinline__ bool keep(const Unit& u) const { return u.k < 2; }
    __device__ __forceinline__ void operator()(f32x4 (&acc)[2][2][4][2], const Unit& u, int wr, int wc, int fr, int fq) const {
        const int cn = u.pn & 3, k = u.k;
        const int row0 = u.pm * BM + wr * 64 + fr, cofs = wc * 32 + 8 * fq;
        const int gc0 = gate_col(4 * k + cn) + cofs, gc1 = gate_col(4 * (k < 2 ? k + 1 : 2) + cn) + cofs;
#pragma unroll
        for (int ai = 0; ai < 2; ++ai)
#pragma unroll
            for (int m = 0; m < 4; ++m) { const size_t ro = (size_t)(row0 + ai * HALF + m * 16);
#pragma unroll
                for (int bj = 0; bj < 2; ++bj) {
                    const u32x4 ga = *(const u32x4*)(P + ro * PITCH + gc0 + bj * HALF);
                    float s[8] = {bf_lo(ga.x), bf_hi(ga.x), bf_lo(ga.y), bf_hi(ga.y), bf_lo(ga.z), bf_hi(ga.z), bf_lo(ga.w), bf_hi(ga.w)};
                    if (k < 2) { const u32x4 gb = *(const u32x4*)(P + ro * PITCH + gc1 + bj * HALF);
                        const float t[8] = {bf_lo(gb.x), bf_hi(gb.x), bf_lo(gb.y), bf_hi(gb.y), bf_lo(gb.z), bf_hi(gb.z), bf_lo(gb.w), bf_hi(gb.w)};
#pragma unroll
                        for (int i = 0; i < 8; ++i) s[i] = s[i] * __builtin_amdgcn_rcpf(t[i]); }
                    f32x4 v0 = acc[ai][bj][m][0], v1 = acc[ai][bj][m][1];
#pragma unroll
                    for (int i = 0; i < 4; ++i) { v0[i] *= s[i]; v1[i] *= s[4 + i]; }
                    if (k < 2) { acc[ai][bj][m][0] = v0; acc[ai][bj][m][1] = v1; }
                    else { u32x4 w; w.x = cvt_pk_bf16(v0[0], v0[1]); w.y = cvt_pk_bf16(v0[2], v0[3]); w.z = cvt_pk_bf16(v1[0], v1[1]); w.w = cvt_pk_bf16(v1[2], v1[3]);
                        *(u32x4*)(O + ro * D + cn * BM + cofs + bj * HALF) = w; } } }
    }
};
struct EpiRes {
    static constexpr bool PERM = false, AFTER_DRAIN = true;
    __device__ __forceinline__ void fused(f32x4 (&acc)[2][2][4][2], const Unit& u, int wr, int wc, int fr, int fq, LAS unsigned char* lds, int wid, int lane) const {
        constexpr int TP = 260;
        LAS float* T = (LAS float*)lds;
        const int b = u.pm >> 3, colg = u.pn * BM + 4 * lane;
        const f32x4 gg = *(const f32x4*)(gmod + (size_t)b * 6144 + colg);
        f32x4 xk[32];
#pragma unroll
        for (int ai = 0; ai < 2; ++ai) {
#pragma unroll
            for (int m = 0; m < 4; ++m)
#pragma unroll
                for (int bj = 0; bj < 2; ++bj)
#pragma unroll
                    for (int n = 0; n < 2; ++n) *(LAS f32x4*)(T + (wr * 64 + m * 16 + fr) * TP + bj * HALF + wc * 32 + n * 16 + 4 * fq) = acc[ai][bj][m][n];
            asm volatile("s_waitcnt lgkmcnt(0)" ::: "memory"); __builtin_amdgcn_s_barrier(); asm volatile("" ::: "memory");
#pragma unroll
            for (int hb = 0; hb < 2; ++hb) { f32x4 bs[8]; float ss[8];
#pragma unroll
                for (int rr = 0; rr < 8; ++rr) { const int rl = wid + 8 * (hb * 8 + rr); bs[rr] = *(const f32x4*)(base + (size_t)(u.pm * BM + ai * HALF + rl) * D + colg); }
#pragma unroll
                for (int rr = 0; rr < 8; ++rr) { const int rl = wid + 8 * (hb * 8 + rr); const f32x4 v = *(LAS const f32x4*)(T + rl * TP + 4 * lane);
                    const f32x4 o = bs[rr] + gg * v; ss[rr] = (o.x * o.x + o.y * o.y) + (o.z * o.z + o.w * o.w);
                    xk[ai * 16 + hb * 8 + rr] = o;
                    if (mode != 2) *(f32x4*)(out + (size_t)(u.pm * BM + ai * HALF + rl) * D + colg) = o; }
                if (mode != 0) {
                    const float tot = reduce8(ss, lane);
                    if (lane < 8) { const int rl = wid + 8 * (hb * 8 + lane);
                        __hip_atomic_store(slots + (size_t)(u.pm * BM + ai * HALF + rl) * 4 + u.pn, tot, __ATOMIC_RELAXED, __HIP_MEMORY_SCOPE_AGENT); }
                } }
            asm volatile("s_waitcnt lgkmcnt(0)" ::: "memory"); __builtin_amdgcn_s_barrier(); asm volatile("" ::: "memory");
        }
        if (mode == 0) return;
        asm volatile("s_waitcnt vmcnt(0)" ::: "memory");
        unsigned* pc = cnt + 64 * u.pm;
        if (lane == 0) __hip_atomic_fetch_add(pc, 1u, __ATOMIC_RELAXED, __HIP_MEMORY_SCOPE_AGENT);
        if (wid == 0) {
            unsigned sp = 0;
            while ((unsigned)__builtin_amdgcn_readfirstlane(__hip_atomic_load(pc, __ATOMIC_RELAXED, __HIP_MEMORY_SCOPE_AGENT)) < 32u) { __builtin_amdgcn_s_sleep(2); if (++sp > (1u << 18)) break; }
            __builtin_amdgcn_fence(__ATOMIC_ACQUIRE, "agent");
        }
        asm volatile("s_waitcnt vmcnt(0) lgkmcnt(0)" ::: "memory"); __builtin_amdgcn_s_barrier(); asm volatile("" ::: "memory");
        float rs;
        { const int k = lane & 31, rl = wid + 8 * (k & 15); const float* sl = slots + (size_t)(u.pm * BM + (k >> 4) * HALF + rl) * 4;
          const float t = (__hip_atomic_load(sl + 0, __ATOMIC_RELAXED, __HIP_MEMORY_SCOPE_AGENT) + __hip_atomic_load(sl + 1, __ATOMIC_RELAXED, __HIP_MEMORY_SCOPE_AGENT))
                        + (__hip_atomic_load(sl + 2, __ATOMIC_RELAXED, __HIP_MEMORY_SCOPE_AGENT) + __hip_atomic_load(sl + 3, __ATOMIC_RELAXED, __HIP_MEMORY_SCOPE_AGENT));
          rs = 1.0f / sqrtf(t * (1.0f / D) + EPS); }
        f32x4 am, sh;
        { const f32x4 gv = *(const f32x4*)(ng + colg);
          if (mode == 1) { am = gv * (1.0f + *(const f32x4*)(nscale + (size_t)b * 6144 + colg)); sh = *(const f32x4*)(nshift + (size_t)b * 6144 + colg); }
          else { am = gv; sh = (f32x4){0.f, 0.f, 0.f, 0.f}; } }
#pragma unroll
        for (int kb = 0; kb < 4; ++kb) {
#pragma unroll
            for (int rr = 0; rr < 8; ++rr) { const int k = kb * 8 + rr, rl = wid + 8 * (k & 15); const size_t ro = (size_t)(u.pm * BM + (k >> 4) * HALF + rl);
                const float rstd = __uint_as_float(__builtin_amdgcn_readlane(__float_as_uint(rs), k));
                const f32x4 hv = xk[k] * rstd * am + sh;
                if (mode == 1) { u32x2 w; w.x = cvt_pk_bf16(hv.x, hv.y); w.y = cvt_pk_bf16(hv.z, hv.w); *(u32x2*)(hn + ro * D + colg) = w; }
                else *(f32x4*)(out + ro * D + colg) = hv; } }
    }
    const float* base; float* out; const float* gmod;
    int mode; float* slots; unsigned* cnt; const float* ng; const float* nshift; const float* nscale; bf16_t* hn;
    __device__ __forceinline__ bool keep(const Unit&) const { return false; }
    __device__ __forceinline__ void operator()(f32x4 (&acc)[2][2][4][2], const Unit& u, int wr, int wc, int fr, int fq) const {
        const int b = u.pm >> 3;
        const int col0 = u.pn * BM + wc * 32 + 4 * fq;
        const float* gv = gmod + (size_t)b * 6144 + col0;
        f32x4 gg[2][2];
#pragma unroll
        for (int bj = 0; bj < 2; ++bj)
#pragma unroll
            for (int n = 0; n < 2; ++n) gg[bj][n] = *(const f32x4*)(gv + bj * HALF + n * 16);
#pragma unroll
        for (int ai = 0; ai < 2; ++ai)
#pragma unroll
            for (int m = 0; m < 4; ++m) { const size_t off = (size_t)(u.pm * BM + ai * HALF + wr * 64 + m * 16 + fr) * D + col0;
#pragma unroll
                for (int bj = 0; bj < 2; ++bj)
#pragma unroll
                    for (int n = 0; n < 2; ++n) { const f32x4 bs = *(const f32x4*)(base + off + bj * HALF + n * 16);
                        *(f32x4*)(out + off + bj * HALF + n * 16) = bs + gg[bj][n] * acc[ai][bj][m][n]; } }
    }
};
struct EpiSwiglu {
    static constexpr bool PERM = true, AFTER_DRAIN = false;
    bf16_t* O;
    __device__ __forceinline__ bool keep(const Unit&) const { return false; }
    __device__ __forceinline__ void operator()(f32x4 (&acc)[2][2][4][2], const Unit& u, int wr, int wc, int fr, int fq) const {
        const int row0 = u.pm * BM + wr * 64 + fr, col0 = u.pn * HALF + wc * 32 + 8 * fq;
#pragma unroll
        for (int ai = 0; ai < 2; ++ai)
#pragma unroll
            for (int m = 0; m < 4; ++m) { bf16_t* rowp = O + (size_t)(row0 + ai * HALF + m * 16) * FFH + col0;
                f32x4 r0, r1;
#pragma unroll
                for (int i = 0; i < 4; ++i) { const float g0 = acc[ai][0][m][0][i], g1 = acc[ai][0][m][1][i];
                    r0[i] = g0 * sigmoidf_(g0) * acc[ai][1][m][0][i]; r1[i] = g1 * sigmoidf_(g1) * acc[ai][1][m][1][i]; }
                u32x4 w; w.x = cvt_pk_bf16(r0[0], r0[1]); w.y = cvt_pk_bf16(r0[2], r0[3]); w.z = cvt_pk_bf16(r1[0], r1[1]); w.w = cvt_pk_bf16(r1[2], r1[3]);
                *(u32x4*)rowp = w; }
    }
};

template <class Epi, class Sched>
__device__ __forceinline__ void gemm_phase(LAS unsigned char* lds, const Gemm g, const Sched& S, const Epi& E) {
    const int tid = tid_opaque(), wid = __builtin_amdgcn_readfirstlane(tid >> 6), lane = tid & 63, wr = wid >> 2, wc = wid & 3, fr = lane & 15, fq = lane >> 4;
    const int K = g.K, nt = K / BK, lda = g.lda;
    unsigned voffA[2], voffB[2];
#pragma unroll
    for (int i = 0; i < 2; ++i) { int R, C; stage_rc(tid * 16 + i * 8192, R, C); const int Rb = Epi::PERM ? ((R & ~31) + perm32(R & 31)) : R;
        voffA[i] = (unsigned)(R * lda + C) * 2u; voffB[i] = (unsigned)(Rb * K + C) * 2u; }
    const size_t kstep = (size_t)(BK * 2);
    const size_t hstepA = (size_t)HALF * lda * 2, hstepB = (size_t)HALF * K * 2;
    const size_t tstepA = 2 * hstepA, tstepB = 2 * hstepB;
    const unsigned ldsw = (unsigned)wid * 1024u;
    const int aoff = lds_byte(wr * 64 + fr, fq * 8), boff = lds_byte(wc * 32 + fr, fq * 8);
#define PG8_SA(b, h) (((b) * 2 + (h)) * HTB)
#define PG8_SB(b, h) ((4 + (b) * 2 + (h)) * HTB)
#define PG8_STAGE(bufoff, gbase, voff) do { _Pragma("unroll") for (int _i = 0; _i < 2; ++_i) \
        __builtin_amdgcn_global_load_lds((const unsigned*)((const char*)(gbase) + (voff)[_i]), (LAS unsigned*)(lds + (bufoff) + ldsw + _i * 8192), 16, 0, 0); } while (0)
#define PG8_LDA(dst, b, h) do { _Pragma("unroll") for (int m = 0; m < 4; ++m) _Pragma("unroll") for (int k = 0; k < 2; ++k) dst[m][k] = *(const LAS bf16x8*)(lds + PG8_SA(b, h) + aoff + m * 2048 + k * 1024); } while (0)
#define PG8_LDB(dst, b, h) do { _Pragma("unroll") for (int n = 0; n < 2; ++n) _Pragma("unroll") for (int k = 0; k < 2; ++k) dst[n][k] = *(const LAS bf16x8*)(lds + PG8_SB(b, h) + boff + n * 2048 + k * 1024); } while (0)
#define PG8_MMA(ai, bj, At, Bt) do { __builtin_amdgcn_s_setprio(1); _Pragma("unroll") for (int m = 0; m < 4; ++m) _Pragma("unroll") for (int n = 0; n < 2; ++n) _Pragma("unroll") for (int k = 0; k < 2; ++k) \
        acc[ai][bj][m][n] = __builtin_amdgcn_mfma_f32_16x16x32_bf16(Bt[n][k], At[m][k], acc[ai][bj][m][n], 0, 0, 0); __builtin_amdgcn_s_setprio(0); } while (0)
#define PG8_WAIT_V(n) asm volatile("s_waitcnt vmcnt(" #n ")" ::: "memory")
#define PG8_WAIT_L(n) asm volatile("s_waitcnt lgkmcnt(" #n ")" ::: "memory")
#define PG8_BAR __builtin_amdgcn_s_barrier()
#define PG8_SCHED __builtin_amdgcn_sched_barrier(0)
    Unit cur, nxt; int ui = 0;
    if (!S.next(0, cur)) return;
    f32x4 acc[2][2][4][2];
#pragma unroll
    for (int a = 0; a < 2; ++a)
#pragma unroll
        for (int b = 0; b < 2; ++b)
#pragma unroll
            for (int m = 0; m < 4; ++m)
#pragma unroll
                for (int n = 0; n < 2; ++n) acc[a][b][m][n] = (f32x4){0.f, 0.f, 0.f, 0.f};
    bf16x8 At[4][2], B0[2][2], B1[2][2];
    const char* cA = (const char*)g.A + S.a_off(cur) + (size_t)cur.pm * tstepA; const char* cB = (const char*)g.Bt + (size_t)cur.pn * tstepB;
    PG8_STAGE(PG8_SB(0, 0), cB, voffB); PG8_STAGE(PG8_SB(0, 1), cB + hstepB, voffB); PG8_STAGE(PG8_SA(0, 0), cA, voffA); PG8_STAGE(PG8_SA(0, 1), cA + hstepA, voffA);
    if (wr == 1) PG8_BAR;
    PG8_WAIT_V(2); PG8_BAR;
    PG8_STAGE(PG8_SB(1, 0), cB + kstep, voffB); PG8_STAGE(PG8_SA(1, 0), cA + kstep, voffA); PG8_STAGE(PG8_SB(1, 1), cB + hstepB + kstep, voffB);
    PG8_WAIT_V(6); PG8_BAR;
    for (;;) {
        const bool has_next = S.next(ui + 1, nxt);
        const char* nA = has_next ? (const char*)g.A + S.a_off(nxt) + (size_t)nxt.pm * tstepA : cA; const char* nB = has_next ? (const char*)g.Bt + (size_t)nxt.pn * tstepB : cB;
        for (int t = 0; t < nt; t += 2) {
            const bool last = (t == nt - 2);
            const char* a1 = cA + (size_t)(t + 1) * kstep;
            const char* a2 = last ? nA : cA + (size_t)(t + 2) * kstep; const char* b2 = last ? nB : cB + (size_t)(t + 2) * kstep;
            const char* a3 = a2 + kstep; const char* b3 = b2 + kstep;
            PG8_LDB(B0, 0, 0); PG8_LDB(B1, 0, 1); PG8_SCHED; PG8_LDA(At, 0, 0); PG8_STAGE(PG8_SA(1, 1), a1 + hstepA, voffA);
            PG8_WAIT_V(8); PG8_WAIT_L(0); PG8_BAR; PG8_MMA(0, 0, At, B0); PG8_MMA(0, 1, At, B1); PG8_BAR; PG8_SCHED;
            PG8_LDA(At, 0, 1); PG8_STAGE(PG8_SB(0, 0), b2, voffB); PG8_STAGE(PG8_SB(0, 1), b2 + hstepB, voffB); PG8_STAGE(PG8_SA(0, 0), a2, voffA);
            PG8_WAIT_V(8); PG8_WAIT_L(0); PG8_BAR; PG8_MMA(1, 0, At, B0); PG8_MMA(1, 1, At, B1); PG8_BAR; PG8_SCHED;
            PG8_LDB(B0, 1, 0); PG8_LDB(B1, 1, 1); PG8_SCHED; PG8_LDA(At, 1, 0); PG8_STAGE(PG8_SA(0, 1), a2 + hstepA, voffA);
            PG8_WAIT_V(8); PG8_WAIT_L(0); PG8_BAR; PG8_MMA(0, 0, At, B0); PG8_MMA(0, 1, At, B1); PG8_BAR; PG8_SCHED;
            PG8_LDA(At, 1, 1); PG8_STAGE(PG8_SB(1, 0), b3, voffB); PG8_STAGE(PG8_SB(1, 1), b3 + hstepB, voffB); PG8_STAGE(PG8_SA(1, 0), a3, voffA);
            PG8_WAIT_V(8); PG8_WAIT_L(0); PG8_BAR; PG8_MMA(1, 0, At, B0); PG8_MMA(1, 1, At, B1); PG8_BAR; PG8_SCHED;
        }
        if (wr == 0) PG8_BAR;
        if (!(Epi::AFTER_DRAIN && !has_next)) E(acc, cur, wr, wc, fr, fq);
        if (!has_next) break;
        if (!E.keep(cur)) {
#pragma unroll
            for (int a = 0; a < 2; ++a)
#pragma unroll
                for (int b = 0; b < 2; ++b)
#pragma unroll
                    for (int m = 0; m < 4; ++m)
#pragma unroll
                        for (int n = 0; n < 2; ++n) acc[a][b][m][n] = (f32x4){0.f, 0.f, 0.f, 0.f};
        }
        cur = nxt; cA = nA; cB = nB; ++ui;
        if (wr == 1) PG8_BAR;
    }
    PG8_WAIT_V(0);
    PG8_BAR;
    if constexpr (Epi::AFTER_DRAIN) E.fused(acc, cur, wr, wc, fr, fq, lds, wid, lane);
#undef PG8_SA
#undef PG8_SB
#undef PG8_STAGE
#undef PG8_LDA
#undef PG8_LDB
#undef PG8_MMA
#undef PG8_WAIT_V
#undef PG8_WAIT_L
#undef PG8_BAR
#undef PG8_SCHED
}
}

namespace att {
typedef short v4i16_t __attribute__((ext_vector_type(4)));
__device__ __forceinline__ int crow(int r, int hi) { return (r & 3) + 8 * (r >> 2) + 4 * hi; }
__device__ __forceinline__ s16x4 vtr(LAS const unsigned char* p) { return __builtin_bit_cast(s16x4, __builtin_amdgcn_ds_read_tr16_b64_v4i16((LAS v4i16_t*)p)); }
constexpr float C2 = 0.125f * LOG2E;
constexpr float NEG = -1e30f;
constexpr int LDS_K = 0, LDS_V = 32768, LDS_REL = 65536, LDS_CUM = 69632;

__device__ __forceinline__ float max3f(float a, float b, float c) { return __builtin_fmaxf(__builtin_fmaxf(a, b), c); }
constexpr float THR = 8.0f;
template <int VAR>
__device__ __forceinline__ void tile(LAS unsigned char* lds, int cur, int kt, int dk, const bf16x8 (&qr)[4], float& mref, float& lrow, f32x16& o0, f32x16& o1, f32x16& negm, bool& first,
                                     LAS float* relX, LAS float* ckL, float slopeL, const f32x16& kf0, const int (&koff)[4], int qloc, int hi, int r32, int lane) {
            LAS const unsigned char* kp = lds + LDS_K + cur * 8192 + r32 * 128;
            f32x16 p0, p1;
            __builtin_amdgcn_s_setprio(1);
#pragma unroll
            for (int d0 = 0; d0 < 4; ++d0) {
                const bf16x8 k0 = *(LAS const bf16x8*)(kp + koff[d0]), k1 = *(LAS const bf16x8*)(kp + 4096 + koff[d0]);
                if (d0 == 0) { p0 = __builtin_amdgcn_mfma_f32_32x32x16_bf16(k0, qr[0], negm, 0, 0, 0); p1 = __builtin_amdgcn_mfma_f32_32x32x16_bf16(k1, qr[0], negm, 0, 0, 0); }
                else { p0 = __builtin_amdgcn_mfma_f32_32x32x16_bf16(k0, qr[d0], p0, 0, 0, 0); p1 = __builtin_amdgcn_mfma_f32_32x32x16_bf16(k1, qr[d0], p1, 0, 0, 0); }
            }
            __builtin_amdgcn_s_setprio(0);
            if (VAR == 0) {
                const float dqf = (float)(64 * dk + qloc);
                const f32x16 d0v = dqf - kf0, d1v = d0v - 32.0f;
#pragma unroll
                for (int r = 0; r < 16; ++r) { p0[r] = __builtin_fmaf(-slopeL, __builtin_fabsf(d0v[r]), p0[r]); p1[r] = __builtin_fmaf(-slopeL, __builtin_fabsf(d1v[r]), p1[r]); }
            } else if (VAR == 1) {
                LAS const float* ckp = ckL + kt * 64 + 4 * hi;
                f32x16 c0v, c1v;
#pragma unroll
                for (int g = 0; g < 4; ++g) { const f32x4 c0 = *(LAS const f32x4*)(ckp + 8 * g), c1 = *(LAS const f32x4*)(ckp + 32 + 8 * g);
#pragma unroll
                    for (int i = 0; i < 4; ++i) { c0v[4 * g + i] = c0[i]; c1v[4 * g + i] = c1[i]; } }
                p0 = p0 - c0v; p1 = p1 - c1v;
                if (dk == 0) {
#pragma unroll
                    for (int r = 0; r < 16; ++r) { const int key = crow(r, hi); if (key > qloc) p0[r] = NEG; if (key + 32 > qloc) p1[r] = NEG; }
                }
            } else {
                if (dk >= 3) { const float rf = relX[64];
                    p0 = p0 + rf; p1 = p1 + rf;
                } else {
                    LAS const float* rb = relX + 64 + (128 - 64 * dk - qloc) + 4 * hi;
                    f32x16 b0v, b1v;
#pragma unroll
                    for (int r = 0; r < 16; ++r) { b0v[r] = rb[(r & 3) + 8 * (r >> 2)]; b1v[r] = rb[32 + (r & 3) + 8 * (r >> 2)]; }
                    p0 = p0 + b0v; p1 = p1 + b1v;
                }
            }
            float ra = max3f(p0[0], p0[1], p0[2]), rb2 = max3f(p1[0], p1[1], p1[2]);
#pragma unroll
            for (int r = 3; r < 15; r += 2) { ra = max3f(ra, p0[r], p0[r + 1]); rb2 = max3f(rb2, p1[r], p1[r + 1]); }
            float rm = max3f(ra, rb2, __builtin_fmaxf(p0[15], p1[15]));
            rm = __builtin_fmaxf(rm, __shfl_xor(rm, 32));
            if (first || __any(rm > THR)) {
                const float dl = first ? rm : __builtin_fmaxf(rm, 0.f);
                mref += dl;
                p0 = p0 - dl; p1 = p1 - dl;
                const float f = first ? 1.0f : __builtin_amdgcn_exp2f(-dl);
                lrow *= f; o0 = o0 * f; o1 = o1 * f;
#pragma unroll
                for (int r = 0; r < 16; ++r) negm[r] = -mref;
                first = false;
            }
#pragma unroll
            for (int r = 0; r < 16; ++r) { p0[r] = __builtin_amdgcn_exp2f(p0[r]); p1[r] = __builtin_amdgcn_exp2f(p1[r]); }
            { const f32x16 sv = p0 + p1;
              float ls = 0.f;
#pragma unroll
              for (int r = 0; r < 16; r += 4) ls += (sv[r] + sv[r + 1]) + (sv[r + 2] + sv[r + 3]);
              lrow += ls; }
            u32x4 pw[4];
#pragma unroll
            for (int i = 0; i < 4; ++i) { pw[0][i] = cvt_pk_bf16(p0[2 * i], p0[2 * i + 1]); pw[1][i] = cvt_pk_bf16(p0[8 + 2 * i], p0[9 + 2 * i]);
                                          pw[2][i] = cvt_pk_bf16(p1[2 * i], p1[2 * i + 1]); pw[3][i] = cvt_pk_bf16(p1[8 + 2 * i], p1[9 + 2 * i]); }
            const unsigned vb = (unsigned)(uintptr_t)(lds + LDS_V + cur * 8192 + ((lane >> 4) & 1) * 32 + (lane & 3) * 8 + (4 * hi + ((lane & 15) >> 2)) * 64);
#pragma unroll
            for (int d0 = 0; d0 < 2; ++d0) {
                s16x4 lo[4], hh[4];
#pragma unroll
                for (int ks = 0; ks < 4; ++ks) {
                    asm volatile("ds_read_b64_tr_b16 %0, %1 offset:%c2" : "=&v"(lo[ks]) : "v"(vb), "i"(d0 * 4096 + ks * 1024) : "memory");
                    asm volatile("ds_read_b64_tr_b16 %0, %1 offset:%c2" : "=&v"(hh[ks]) : "v"(vb), "i"(d0 * 4096 + ks * 1024 + 512) : "memory"); }
                asm volatile("s_waitcnt lgkmcnt(0)" ::: "memory"); __builtin_amdgcn_sched_barrier(0);
#pragma unroll
                for (int ks = 0; ks < 4; ++ks) {
                    const bf16x8 pf = __builtin_bit_cast(bf16x8, pw[ks]);
                    const bf16x8 vf = (bf16x8){lo[ks][0], lo[ks][1], lo[ks][2], lo[ks][3], hh[ks][0], hh[ks][1], hh[ks][2], hh[ks][3]};
                    if (d0 == 0) o0 = __builtin_amdgcn_mfma_f32_32x32x16_bf16(vf, pf, o0, 0, 0, 0);
                    else o1 = __builtin_amdgcn_mfma_f32_32x32x16_bf16(vf, pf, o1, 0, 0, 0);
                }
            }
}
struct Src { const bf16_t* k; const bf16_t* v; const bf16_t* q; int nt; };
__device__ __forceinline__ Src make_src(int var, const bf16_t* proj, int b, int h, int qb, int lane, int wid) {
    const int qc = var == 0 ? QA : (var == 1 ? QB_ : QC_), kc = var == 0 ? KA : (var == 1 ? KB_ : KC_), vc = var == 0 ? VA : (var == 1 ? VB_ : VC_);
    const int kvh = var == 0 ? (h >> 2) : h, back = var == 0 ? 2 : (var == 1 ? 1000 : 8);
    const int kt_lo = var == 1 ? 0 : (4 * qb - back > 0 ? 4 * qb - back : 0), kt_hi = 4 * qb + 3;
    const size_t row0 = (size_t)b * SEQ + (size_t)kt_lo * 64;
    const int kkey = wid * 8 + (lane >> 3), kchunk = (lane & 7) ^ ((kkey >> 1) & 7);
    Src s;
    s.k = proj + (row0 + kkey) * PITCH + kc + kvh * 64 + kchunk * 8;
    s.v = proj + (row0 + 16 * (wid & 3) + (lane >> 2)) * PITCH + vc + kvh * 64 + (wid >> 2) * 32 + (lane & 3) * 8;
    s.q = proj + ((size_t)b * SEQ + qb * 256 + wid * 32 + (lane & 31)) * PITCH + qc + h * 64 + (lane >> 5) * 8;
    s.nt = kt_hi - kt_lo + 1;
    return s;
}
template <int VAR>
__device__ __forceinline__ void unit(LAS unsigned char* lds, bf16_t* proj, const float* sinks, int b, int h, int qb, int& cur, bool prefetched, bool has_next, const Src& nx, bf16x8 (&qr)[4]) {
    const int tid = tid_opaque(), lane = tid & 63, r32 = lane & 31, hi = lane >> 5; const int wid = __builtin_amdgcn_readfirstlane(tid >> 6);
    const Src me = make_src(VAR, proj, b, h, qb, lane, wid);
    const int nt = me.nt, kt_hi = 4 * qb + 3, kt_lo = kt_hi - nt + 1;
    const int c = 4 * qb + (wid >> 1);
    constexpr int BACK = VAR == 0 ? 2 : (VAR == 1 ? 1000 : 8);
    LAS float* relX = (LAS float*)(lds + LDS_REL);
    LAS float* ckL = (LAS float*)(lds + LDS_CUM);
#define ATT_DMA2(kp_, vp_, slot) do { \
        __builtin_amdgcn_global_load_lds((const unsigned*)(kp_), (LAS unsigned*)(lds + LDS_K + (slot) * 8192 + wid * 1024), 16, 0, 0); \
        __builtin_amdgcn_global_load_lds((const unsigned*)(vp_), (LAS unsigned*)(lds + LDS_V + (slot) * 8192 + wid * 1024), 16, 0, 0); } while (0)
    if (!prefetched) {
        ATT_DMA2(me.k, me.v, cur); ATT_DMA2(me.k + (size_t)64 * PITCH, me.v + (size_t)64 * PITCH, (cur + 1) & 3); ATT_DMA2(me.k + (size_t)128 * PITCH, me.v + (size_t)128 * PITCH, (cur + 2) & 3);
#pragma unroll
        for (int d0 = 0; d0 < 4; ++d0) qr[d0] = *(const bf16x8*)(me.q + d0 * 16);
    }
    const float sinkL = VAR == 0 ? sinks[h] * LOG2E : 0.f;
    float mref = 0.f, lrow = 0.f; bool first = true;
    f32x16 negm;
#pragma unroll
    for (int r = 0; r < 16; ++r) negm[r] = 0.f;
    int koff[4];
#pragma unroll
    for (int d0 = 0; d0 < 4; ++d0) koff[d0] = ((2 * d0 + hi) ^ ((r32 >> 1) & 7)) << 4;
    f32x16 o0, o1;
#pragma unroll
    for (int r = 0; r < 16; ++r) { o0[r] = 0.f; o1[r] = 0.f; }
    const float slopeL = VAR == 0 ? exp2f(-(float)(h + 1)) * LOG2E : 0.f;
    const int qloc = 32 * (wid & 1) + r32;
    f32x16 kf0;
#pragma unroll
    for (int r = 0; r < 16; ++r) kf0[r] = (float)crow(r, hi);
    bf16x8 qn[4];
#pragma unroll
    for (int d0 = 0; d0 < 4; ++d0) qn[d0] = qr[d0];
    for (int i = 0; i < nt; ++i) {
        const int kt = kt_lo + i;
        if (prefetched && i == 0) asm volatile("s_waitcnt vmcnt(8) lgkmcnt(0)" ::: "memory");
        else asm volatile("s_waitcnt vmcnt(4) lgkmcnt(0)" ::: "memory");
        __builtin_amdgcn_s_barrier(); asm volatile("" ::: "memory");
        { const int i3 = i + 3; const bf16_t* kp; const bf16_t* vp;
          if (i3 < nt) { kp = me.k + (size_t)i3 * 64 * PITCH; vp = me.v + (size_t)i3 * 64 * PITCH; }
          else if (has_next) { kp = nx.k + (size_t)(i3 - nt) * 64 * PITCH; vp = nx.v + (size_t)(i3 - nt) * 64 * PITCH; }
          else { kp = me.k + (size_t)(nt - 1) * 64 * PITCH; vp = me.v + (size_t)(nt - 1) * 64 * PITCH; }
          ATT_DMA2(kp, vp, (cur + 3) & 3); }
        if (has_next && i == nt - 1) {
#pragma unroll
            for (int d0 = 0; d0 < 4; ++d0) qn[d0] = *(const bf16x8*)(nx.q + d0 * 16);
        }
        { const int dk = c - kt; if (dk >= 0 && dk <= BACK) tile<VAR>(lds, cur, kt, dk, qr, mref, lrow, o0, o1, negm, first, relX, ckL, slopeL, kf0, koff, qloc, hi, r32, lane); }
        cur = (cur + 1) & 3;
    }
    if (!has_next) {
        asm volatile("s_waitcnt vmcnt(0) lgkmcnt(0)" ::: "memory");
        __builtin_amdgcn_s_barrier(); asm volatile("" ::: "memory");
    }
#undef ATT_DMA2
    lrow += __shfl_xor(lrow, 32);
    if (VAR == 0) lrow += exp2f(sinkL - mref);
    const float rl = 1.0f / lrow;
    bf16_t* orow = const_cast<bf16_t*>(me.q) - hi * 8 + 4 * hi;
#pragma unroll
    for (int g = 0; g < 4; ++g) {
        u32x2 w0, w1;
        w0.x = cvt_pk_bf16(o0[4 * g] * rl, o0[4 * g + 1] * rl); w0.y = cvt_pk_bf16(o0[4 * g + 2] * rl, o0[4 * g + 3] * rl);
        w1.x = cvt_pk_bf16(o1[4 * g] * rl, o1[4 * g + 1] * rl); w1.y = cvt_pk_bf16(o1[4 * g + 2] * rl, o1[4 * g + 3] * rl);
        *(u32x2*)(orow + 8 * g) = w0; *(u32x2*)(orow + 32 + 8 * g) = w1;
    }
#pragma unroll
    for (int d0 = 0; d0 < 4; ++d0) qr[d0] = qn[d0];
}
}

__device__ __forceinline__ void mod_phase(LAS unsigned char* lds, const float* cvec, const float* w_ada, const float* b_ada, float* mod) {
    const int tid = tid_opaque(), lane = tid & 63, wid = tid >> 6;
    LAS float* condL = (LAS float*)lds;
    LAS float* red = (LAS float*)(lds + 32768);
    for (int i = tid; i < BATCH * D; i += 512) { const float c = cvec[i]; condL[i] = c / (1.0f + __expf(-c)); }
    __syncthreads();
    for (int cb = blockIdx.x; cb < 192; cb += gridDim.x) {
        const int l = cb / 96, e0 = (cb % 96) * 64;
        float acc[8];
#pragma unroll
        for (int b = 0; b < 8; ++b) acc[b] = 0.f;
        const float* w = w_ada + ((size_t)l * D + wid * 128) * 6144 + e0 + lane;
#pragma unroll 4
        for (int d = 0; d < 128; ++d) { const float wv = w[(size_t)d * 6144];
#pragma unroll
            for (int b = 0; b < 8; ++b) acc[b] += condL[b * D + wid * 128 + d] * wv; }
#pragma unroll
        for (int b = 0; b < 8; ++b) red[(wid * 8 + b) * 64 + lane] = acc[b];
        __syncthreads();
        { const int b = tid >> 6; float s = b_ada[l * 6144 + e0 + lane];
#pragma unroll
          for (int w8 = 0; w8 < 8; ++w8) s += red[(w8 * 8 + b) * 64 + lane];
          mod[(size_t)(l * 8 + b) * 6144 + e0 + lane] = s; }
        __syncthreads();
    }
}
__device__ __forceinline__ void transpose_item(const float* W, int Nsrc, int nsrc, int k0, bf16_t* WT, int K, int ndst, LAS float* scr, int lane) {
#pragma unroll 8
    for (int i = 0; i < 32; ++i) { const int kk = 2 * i + (lane >> 5); scr[kk * 33 + (lane & 31)] = W[(size_t)(k0 + kk) * Nsrc + nsrc + (lane & 31)]; }
    asm volatile("s_waitcnt lgkmcnt(0)" ::: "memory");
    const int c = lane & 7;
#pragma unroll
    for (int j = 0; j < 4; ++j) { const int n = (lane >> 3) + 8 * j; const LAS float* s = scr + (8 * c) * 33 + n;
        u32x4 o; o.x = cvt_pk_bf16(s[0 * 33], s[1 * 33]); o.y = cvt_pk_bf16(s[2 * 33], s[3 * 33]); o.z = cvt_pk_bf16(s[4 * 33], s[5 * 33]); o.w = cvt_pk_bf16(s[6 * 33], s[7 * 33]);
        *(u32x4*)(WT + (size_t)(ndst + n) * K + k0 + 8 * c) = o; }
    asm volatile("s_waitcnt lgkmcnt(0)" ::: "memory");
}
struct Ptrs {
    const float *x, *c, *norm_mix_g, *norm_ffn_g, *w_ada, *b_ada, *w_in, *b_forget, *sinks, *rel_bias, *w_branch, *w_out, *w_ffn_in, *w_ffn_out, *final_norm_g;
};
__device__ __forceinline__ void convert_phase(LAS unsigned char* lds, const Ptrs& P, unsigned char* ws) {
    const int tid = tid_opaque(), lane = tid & 63, wid = tid >> 6;
    LAS float* scr = (LAS float*)(lds + 65536 + wid * 8448);
    const int gw = blockIdx.x * 8 + wid, NGW = gridDim.x * 8;
    constexpr int I_QKV = 16 * (NQKV / 32), I_G = 16 * (NG / 32), I_BR = 3 * 8 * 32, I_OUT = 16 * 32, I_FI = 16 * (FF2 / 32), I_FO = (FFH / 64) * 32, I_FB = 64;
    constexpr int I_LAYER = I_QKV + I_G + I_BR + I_OUT + I_FI + I_FO + I_FB;
    for (int it = gw; it < 2 * I_LAYER; it += NGW) {
        const int l = it / I_LAYER; int r = it % I_LAYER;
        unsigned char* wl = ws + WS_W + (size_t)l * W_LAYER;
        if (r < I_QKV) { const int nb = r % (NQKV / 32), kb = r / (NQKV / 32), n0 = 32 * nb;
            transpose_item(P.w_in + (size_t)l * D * NIN, NIN, n0 < 2304 ? n0 : n0 + 8, 64 * kb, (bf16_t*)(wl + W_QKV), D, n0, scr, lane); continue; } r -= I_QKV;
        if (r < I_G) { const int nb = r % (NG / 32), kb = r / (NG / 32), n0 = 32 * nb;
            transpose_item(P.w_in + (size_t)l * D * NIN, NIN, G_SRC + n0, 64 * kb, (bf16_t*)(wl + W_G), D, n0, scr, lane); continue; } r -= I_G;
        if (r < I_BR) { const int k = r / 256, rr = r % 256, nb = rr % 32, kb = rr / 32;
            transpose_item(P.w_branch + ((size_t)l * 3 + k) * 512 * D, D, 32 * nb, 64 * kb, (bf16_t*)(wl + W_BR), 512, k * D + 32 * nb, scr, lane); continue; } r -= I_BR;
        if (r < I_OUT) { const int nb = r % 32, kb = r / 32;
            transpose_item(P.w_out + (size_t)l * D * D, D, 32 * nb, 64 * kb, (bf16_t*)(wl + W_OUT), D, 32 * nb, scr, lane); continue; } r -= I_OUT;
        if (r < I_FI) { const int nb = r % (FF2 / 32), kb = r / (FF2 / 32), n0 = 32 * nb, pn = n0 >> 8, w = n0 & 255;
            const int src = w < 128 ? 128 * pn + w : FFH + 128 * pn + (w - 128);
            transpose_item(P.w_ffn_in + (size_t)l * D * FF2, FF2, src, 64 * kb, (bf16_t*)(wl + W_FI), D, n0, scr, lane); continue; } r -= I_FI;
        if (r < I_FO) { const int nb = r % 32, kb = r / 32;
            transpose_item(P.w_ffn_out + (size_t)l * FFH * D, D, 32 * nb, 64 * kb, (bf16_t*)(wl + W_FO), FFH, 32 * nb, scr, lane); continue; } r -= I_FO;
        {
            const float* wsrc = P.w_in + (size_t)l * D * NIN + FB_SRC;
#pragma unroll
            for (int q = 0; q < 4; ++q) { const int n = 4 * r + q; u32x4 o0 = {0u, 0u, 0u, 0u}, o1 = {0u, 0u, 0u, 0u};
                if (n < 8) { float v[16];
#pragma unroll
                    for (int i = 0; i < 16; ++i) v[i] = wsrc[(size_t)(16 * lane + i) * NIN + n];
                    o0.x = cvt_pk_bf16(v[0], v[1]); o0.y = cvt_pk_bf16(v[2], v[3]); o0.z = cvt_pk_bf16(v[4], v[5]); o0.w = cvt_pk_bf16(v[6], v[7]);
                    o1.x = cvt_pk_bf16(v[8], v[9]); o1.y = cvt_pk_bf16(v[10], v[11]); o1.z = cvt_pk_bf16(v[12], v[13]); o1.w = cvt_pk_bf16(v[14], v[15]); }
                bf16_t* dst = (bf16_t*)(wl + W_QKV) + (size_t)(NQKV + n) * D + 16 * lane;
                *(u32x4*)dst = o0; *(u32x4*)(dst + 8) = o1; }
        }
    }
}
__device__ __forceinline__ float reduce8(const float (&a)[8], int lane) {
    float b[4], c[2];
    const bool b0 = lane & 1, b1 = lane & 2, b2 = lane & 4;
#pragma unroll
    for (int i = 0; i < 4; ++i) { const float keep = b0 ? a[2 * i + 1] : a[2 * i], send = b0 ? a[2 * i] : a[2 * i + 1]; b[i] = keep + __shfl_xor(send, 1); }
#pragma unroll
    for (int i = 0; i < 2; ++i) { const float keep = b1 ? b[2 * i + 1] : b[2 * i], send = b1 ? b[2 * i] : b[2 * i + 1]; c[i] = keep + __shfl_xor(send, 2); }
    float d = (b2 ? c[1] : c[0]) + __shfl_xor(b2 ? c[0] : c[1], 4);
    d += __shfl_xor(d, 8); d += __shfl_xor(d, 16); d += __shfl_xor(d, 32);
    return d;
}
template <bool FB>
__device__ __forceinline__ void norm_phase(LAS unsigned char* lds, const float* xin, const float* g, const float* shift0, const float* scale0, bf16_t* hout,
                                           const float* w_in_l, const float* b_forget_l, float* flog) {
    const int tid = tid_opaque(), lane = tid & 63, wid = tid >> 6;
    LAS float* wfb = (LAS float*)lds;
    if (FB) { for (int i = tid; i < 8 * D; i += 512) { const int d = i >> 3, e = i & 7; wfb[e * D + d] = w_in_l[(size_t)d * NIN + FB_SRC + e]; } __syncthreads(); }
    const int G_ = gridDim.x; const bool grp = (G_ == 256);
    const int gw = grp ? ((int)(blockIdx.x >> 3) * 8 + wid) : ((int)blockIdx.x * 8 + wid), NGW = grp ? 256 : G_ * 8;
    const int rc0 = grp ? (int)(blockIdx.x & 7) * (SEQ / 4) : 0, rc1 = grp ? rc0 + SEQ / 4 : M / 4;
    for (int rc = rc0 + gw; rc < rc1; rc += NGW) {
        const int row0 = rc * 4, b = row0 / SEQ;
        f32x4 v[4][4];
#pragma unroll
        for (int r = 0; r < 4; ++r) { const f32x4* xr = (const f32x4*)(xin + (size_t)(row0 + r) * D) + lane;
#pragma unroll
            for (int j = 0; j < 4; ++j) v[r][j] = xr[64 * j]; }
        f32x4 am[4], sh[4];
#pragma unroll
        for (int j = 0; j < 4; ++j) { const int d = 4 * lane + 256 * j; const f32x4 gv = *(const f32x4*)(g + d), sc = *(const f32x4*)(scale0 + (size_t)b * 6144 + d);
            am[j] = gv * (1.0f + sc); sh[j] = *(const f32x4*)(shift0 + (size_t)b * 6144 + d); }
        float ss[8];
#pragma unroll
        for (int r = 0; r < 4; ++r) { float s = 0.f;
#pragma unroll
            for (int j = 0; j < 4; ++j) s += (v[r][j].x * v[r][j].x + v[r][j].y * v[r][j].y) + (v[r][j].z * v[r][j].z + v[r][j].w * v[r][j].w);
            ss[r] = s; ss[r + 4] = 0.f; }
        const float tot = reduce8(ss, lane);
        const float rs = 1.0f / sqrtf(tot * (1.0f / D) + EPS);
#pragma unroll
        for (int r = 0; r < 4; ++r) { const float rstd = __uint_as_float(__builtin_amdgcn_readlane(__float_as_uint(rs), r));
            u32x2* o8 = (u32x2*)(hout + (size_t)(row0 + r) * D) + lane;
#pragma unroll
            for (int j = 0; j < 4; ++j) { v[r][j] = v[r][j] * rstd * am[j] + sh[j]; u32x2 w; w.x = cvt_pk_bf16(v[r][j].x, v[r][j].y); w.y = cvt_pk_bf16(v[r][j].z, v[r][j].w); o8[64 * j] = w; } }
        if (FB) {
            float pe[4][8];
#pragma unroll
            for (int e = 0; e < 8; ++e) { f32x4 wv[4];
#pragma unroll
                for (int j = 0; j < 4; ++j) wv[j] = *(LAS const f32x4*)(wfb + e * D + 4 * lane + 256 * j);
#pragma unroll
                for (int r = 0; r < 4; ++r) { float a = 0.f;
#pragma unroll
                    for (int j = 0; j < 4; ++j) a += (v[r][j].x * wv[j].x + v[r][j].y * wv[j].y) + (v[r][j].z * wv[j].z + v[r][j].w * wv[j].w);
                    pe[r][e] = a; } }
            const float bfv = b_forget_l[lane & 7];
#pragma unroll
            for (int r = 0; r < 4; ++r) { const float f = reduce8(pe[r], lane) + bfv; if (lane < 8) flog[(size_t)(row0 + r) * 8 + lane] = f; }
        }
    }
}
__device__ __forceinline__ void cumsum_lds(LAS unsigned char* lds, const float* flog, int b, int h) {
    const int tid = tid_opaque(), lane = tid & 63, wid = tid >> 6;
    LAS float* wt = (LAS float*)(lds + att::LDS_REL);
    LAS float* ckL = (LAS float*)(lds + att::LDS_CUM);
    float v[4]; float run = 0.f;
#pragma unroll
    for (int i = 0; i < 4; ++i) { const float f = flog[((size_t)b * SEQ + 4 * tid + i) * 8 + h];
        const float ls = fminf(f, 0.f) - log1pf(expf(-fabsf(f))); run += ls; v[i] = run; }
    float inc = run;
#pragma unroll
    for (int o = 1; o < 64; o <<= 1) { const float t = __shfl_up(inc, o); if (lane >= o) inc += t; }
    if (lane == 63) wt[wid] = inc;
    __syncthreads();
    float base = inc - run;
    for (int w8 = 0; w8 < wid; ++w8) base += wt[w8];
    f32x4 o4 = {(v[0] + base) * LOG2E, (v[1] + base) * LOG2E, (v[2] + base) * LOG2E, (v[3] + base) * LOG2E};
    *(LAS f32x4*)(ckL + 4 * tid) = o4;
    __syncthreads();
}
__device__ __forceinline__ void final_norm_phase(float* x, const float* g) {
    const int tid = tid_opaque(), lane = tid & 63, wid = tid >> 6;
    const int gw = blockIdx.x * 8 + wid, NGW = gridDim.x * 8;
    f32x4 gv[4];
#pragma unroll
    for (int j = 0; j < 4; ++j) gv[j] = *(const f32x4*)(g + 4 * lane + 256 * j);
    for (int row = gw; row < M; row += NGW) {
        f32x4* xr = (f32x4*)(x + (size_t)row * D) + lane;
        f32x4 v[4]; float s = 0.f;
#pragma unroll
        for (int j = 0; j < 4; ++j) { v[j] = xr[64 * j]; s += (v[j].x * v[j].x + v[j].y * v[j].y) + (v[j].z * v[j].z + v[j].w * v[j].w); }
        const float rstd = 1.0f / sqrtf(wave_sum(s) * (1.0f / D) + EPS);
#pragma unroll
        for (int j = 0; j < 4; ++j) xr[64 * j] = v[j] * rstd * gv[j];
    }
}


#define XB_TMO      128
#define XB_XCNT(j)  (256  + 64 * (j))
#define XB_XSUB(j)  (1280 + 64 * (j))
#define XB_XGEN(j)  (2304 + 64 * (j))
#define XB_TOP      3328
#define XB_TOPGEN   3392
#define XCD_BAR_WORDS 3456
#define XB_SPIN_CAP (1u << 18)
__device__ __forceinline__ unsigned xb_ld(unsigned* p)              { return __hip_atomic_load(p, __ATOMIC_RELAXED, __HIP_MEMORY_SCOPE_AGENT); }
__device__ __forceinline__ unsigned xb_add(unsigned* p, unsigned v) { return __hip_atomic_fetch_add(p, v, __ATOMIC_RELAXED, __HIP_MEMORY_SCOPE_AGENT); }
__device__ __forceinline__ unsigned xb_xcc_id() { return (unsigned)__builtin_amdgcn_s_getreg((3 << 11) | 20) & 0xFu; }
#define XB_SPIN(cond, bar) do { unsigned _sp = 0; while (cond) { __builtin_amdgcn_s_sleep(1); \
    if ((++_sp & 255u) == 0u) { if (xb_ld(&(bar)[XB_TMO])) break; if (_sp > XB_SPIN_CAP) { atomicAdd(&(bar)[XB_TMO], 1u); break; } } } } while (0)
__device__ __forceinline__ void xcd_barrier_complete(unsigned* bar, unsigned x, unsigned& nloc, unsigned& nx) {
    const unsigned G = gridDim.x * gridDim.y * gridDim.z;
    unsigned sum, cnt, mine, sp = 0u;
    for (;;) {
        sum = 0u; cnt = 0u; mine = 0u;
#pragma unroll
        for (unsigned j = 0; j < 16; ++j) { const unsigned c = xb_ld(&bar[XB_XCNT(j)]); sum += c; cnt += (c > 0u) ? 1u : 0u; mine = (j == x) ? c : mine; }
        if (sum == G) break;
        __builtin_amdgcn_s_sleep(1);
        if ((++sp & 255u) == 0u) { if (xb_ld(&bar[XB_TMO])) break; if (sp > XB_SPIN_CAP) { atomicAdd(&bar[XB_TMO], 1u); break; } }
    }
    nloc = mine > 0u ? mine : 1u; nx = cnt > 0u ? cnt : 1u;
}
__device__ __forceinline__ void xcd_barrier(unsigned* bar, volatile LAS unsigned* st) {
    asm volatile("s_waitcnt vmcnt(0)" ::: "memory");
    __syncthreads();
    if (threadIdx.x == 0) {
        const unsigned x = xb_xcc_id();
        __builtin_amdgcn_s_waitcnt(0);
        unsigned nloc = st[0], nx = st[1];
        if (nloc == 0u) { xcd_barrier_complete(bar, x, nloc, nx); st[0] = nloc; st[1] = nx; }
        const unsigned old = xb_add(&bar[XB_XSUB(x)], 1u);
        const unsigned gen = old / nloc;
        if (old + 1u == (gen + 1u) * nloc) {
            __builtin_amdgcn_fence(__ATOMIC_RELEASE, "agent");
            asm volatile("s_waitcnt vmcnt(0)" ::: "memory");
            const unsigned og = xb_add(&bar[XB_TOP], 1u);
            const unsigned tg = og / nx;
            if (og + 1u == (tg + 1u) * nx) xb_add(&bar[XB_TOPGEN], 1u);
            else XB_SPIN(xb_ld(&bar[XB_TOPGEN]) == tg, bar);
            __builtin_amdgcn_fence(__ATOMIC_ACQUIRE, "agent");
            xb_add(&bar[XB_XGEN(x)], 1u);
            asm volatile("s_waitcnt vmcnt(0)" ::: "memory");
        } else {
            XB_SPIN(xb_ld(&bar[XB_XGEN(x)]) == gen, bar);
            __builtin_amdgcn_fence(__ATOMIC_ACQUIRE, "agent");
            asm volatile("s_waitcnt vmcnt(0)" ::: "memory");
        }
    }
    __syncthreads();
}

constexpr int LDS_BYTES = 147456;
constexpr int N_PHASES = 20;
#ifndef PH_MASK
#define PH_MASK 0xFFFF
#endif
#define PHON(k) ((PH_MASK >> (k)) & 1)
struct Args { Ptrs p; float* out; unsigned char* ws; int ph_lo, ph_hi; };

__global__ void __launch_bounds__(512, 2) fwd_kernel(Args a) {
    extern __shared__ __attribute__((aligned(16))) unsigned char lds_raw[];
    LAS unsigned char* lds = (LAS unsigned char*)lds_raw;
    cg::grid_group grid = cg::this_grid();
    volatile LAS unsigned* bst = (volatile LAS unsigned*)(lds + LDS_BYTES - 128);
    if (threadIdx.x == 0) { bst[0] = 0u; bst[1] = 0u; }
    __syncthreads();
    const Ptrs& P = a.p;
#ifdef PROBE_MASK
    #define pst ((LAS unsigned long long*)(unsigned)(LDS_BYTES - 64))
    if (threadIdx.x == 0) { pst[0] = __builtin_amdgcn_s_memrealtime(); pst[1] = 0; pst[2] = 0; }
#define PROBE_KIND(p) ((p) == 0 ? 0 : ((p) == N_PHASES - 1 ? 10 : ((((p) - 1) % 9) == 0 ? 1 : ((((p) - 1) % 9) + 1))))
#define PROBE_STEP(p) do { if (threadIdx.x == 0) { const unsigned long long t_now = __builtin_amdgcn_s_memrealtime(); \
        if ((PROBE_MASK >> PROBE_KIND(p)) & 1) pst[1] += ((PROBE_MASK >> 16) & 1) ? (t_now - pst[2]) : (((PROBE_MASK >> 17) & 1) ? (pst[2] - pst[0]) : (t_now - pst[0])); pst[0] = t_now; } } while (0)
#endif
    if (a.ph_hi - a.ph_lo > 1) {
        if (blockIdx.x == 0) { unsigned* z = (unsigned*)(a.ws + WS_BAR); for (int i = threadIdx.x; i < (int)(WS_ZERO_BYTES / 4); i += 512) z[i] = 0u; }
        grid.sync();
        if (threadIdx.x == 0) xb_add(&((unsigned*)(a.ws + WS_BAR))[XB_XCNT(xb_xcc_id())], 1u);
    }
    const bool fuse_norm = (gridDim.x == 256) && (a.ph_hi - a.ph_lo > 1);
    for (int ph = a.ph_lo; ph < a.ph_hi; ++ph) {
        if (fuse_norm && (ph == N_PHASES - 1 || (ph >= 1 && (ph - 1) % 9 == 6) || ph == 10)) continue;
#ifdef PROBE_MASK
        if (ph > a.ph_lo && threadIdx.x == 0) pst[2] = __builtin_amdgcn_s_memrealtime();
#endif
        if (ph > a.ph_lo) xcd_barrier((unsigned*)(a.ws + WS_BAR), bst);
#ifdef PROBE_MASK
        if (ph > a.ph_lo) PROBE_STEP(ph - 1);
#endif
        unsigned char* ws = a.ws; float* outp = a.out; int G = gridDim.x, bx = blockIdx.x;
        asm volatile("" : "+s"(ws), "+s"(outp), "+s"(G), "+s"(bx));
        float* mod = (float*)(ws + WS_MOD); float* flog = (float*)(ws + WS_FLOG); const float* cumL = nullptr;
        bf16_t* hbuf = (bf16_t*)(ws + WS_H); bf16_t* proj = (bf16_t*)(ws + WS_PROJ); bf16_t* act = (bf16_t*)(ws + WS_PROJ);
        if (ph == 0) {
            if (PHON(9)) mod_phase(lds, P.c, P.w_ada, P.b_ada, mod); if (PHON(10)) convert_phase(lds, P, ws); continue; }
        if (ph == N_PHASES - 1) { if (PHON(11)) final_norm_phase(outp, P.final_norm_g); continue; }
        const int l = (ph - 1) / 9, sp = (ph - 1) % 9;
        const unsigned char* wl = ws + WS_W + (size_t)l * W_LAYER;
        const float* modl = mod + (size_t)l * 8 * 6144;
        const float* xin = l == 0 ? P.x : outp;
        switch (sp) {
        case 0: if (PHON(0)) norm_phase<false>(lds, xin, P.norm_mix_g + l * D, modl + 0 * D, modl + 1 * D, hbuf, nullptr, nullptr, nullptr); break;
        case 1: if (PHON(1)) {
            pg8::Gemm g{hbuf, (const bf16_t*)(wl + W_QKV), M, NQKVF, D, D}; pg8::StaticOrder S; S.init(M, NQKVF, G, bx);
            pg8::EpiQKV E{proj, flog, P.b_forget + l * 8}; pg8::gemm_phase(lds, g, S, E); } break;
        case 2: if (PHON(2)) {
            for (int v0 = bx; v0 < 256; v0 += G) {
                const int v = (G == 256) ? ((v0 & 7) * 32 + (v0 >> 3)) : v0;
                const int bh = v >> 2, j = v & 3, b = bh >> 3, h = bh & 7;
                cumsum_lds(lds, flog, b, h);
                {
                    LAS float* relX = (LAS float*)(lds + att::LDS_REL); const float* relh = P.rel_bias + l * 8 * 257 + h * 257;
                    for (int i = tid_opaque(); i < 321; i += 512) { const int jj = i - 64; relX[i] = relh[256 - (jj > 0 ? jj : 0)] * LOG2E; }
                    __syncthreads(); }
                const int tid_ = tid_opaque(), lane_ = tid_ & 63, wid_ = __builtin_amdgcn_readfirstlane(tid_ >> 6);
                const att::Src s1 = att::make_src(1, proj, b, h, j, lane_, wid_), s2 = att::make_src(2, proj, b, h, 2 * j, lane_, wid_), s3 = att::make_src(2, proj, b, h, 2 * j + 1, lane_, wid_),
                               s4 = att::make_src(0, proj, b, h, 2 * j, lane_, wid_), s5 = att::make_src(0, proj, b, h, 2 * j + 1, lane_, wid_);
                int cur = 0; bf16x8 qr[4];
                const float* sk = P.sinks + l * 8;
                att::unit<1>(lds, proj, sk, b, h, 7 - j, cur, false, true, s1, qr);
                att::unit<1>(lds, proj, sk, b, h, j, cur, true, true, s2, qr);
                att::unit<2>(lds, proj, sk, b, h, 2 * j, cur, true, true, s3, qr);
                att::unit<2>(lds, proj, sk, b, h, 2 * j + 1, cur, true, true, s4, qr);
                att::unit<0>(lds, proj, sk, b, h, 2 * j, cur, true, true, s5, qr);
                att::unit<0>(lds, proj, sk, b, h, 2 * j + 1, cur, true, false, s5, qr);
            } } break;
        case 3: if (PHON(3)) { pg8::Gemm g{hbuf, (const bf16_t*)(wl + W_G), M, NG, D, D}; pg8::StaticOrder S; S.init(M, NG, G, bx);
            pg8::EpiGate E{proj}; pg8::gemm_phase(lds, g, S, E); } break;
        case 4: if (PHON(4)) { pg8::Gemm g{proj, (const bf16_t*)(wl + W_BR), M, 3 * D, 512, PITCH}; pg8::BranchOrder S; S.so.init(M, D, G, bx);
            pg8::EpiBranch E{proj, hbuf}; pg8::gemm_phase(lds, g, S, E); } break;
        case 5: if (PHON(5)) { pg8::Gemm g{hbuf, (const bf16_t*)(wl + W_OUT), M, D, D, D}; pg8::StaticOrder S; S.init(M, D, G, bx);
            pg8::EpiRes E{xin, outp, modl + 2 * D, fuse_norm ? 1 : 0, (float*)(ws + WS_SLOT), (unsigned*)(ws + WS_CNT) + l * 4096, P.norm_ffn_g + l * D, modl + 3 * D, modl + 4 * D, hbuf};
            pg8::gemm_phase(lds, g, S, E); } break;
        case 6: if (PHON(6)) norm_phase<false>(lds, outp, P.norm_ffn_g + l * D, modl + 3 * D, modl + 4 * D, hbuf, nullptr, nullptr, nullptr); break;
        case 7: if (PHON(7)) { pg8::Gemm g{hbuf, (const bf16_t*)(wl + W_FI), M, FF2, D, D}; pg8::StaticOrder S; S.init(M, FF2, G, bx);
            pg8::EpiSwiglu E{act}; pg8::gemm_phase(lds, g, S, E); } break;
        case 8: if (PHON(8)) { pg8::Gemm g{act, (const bf16_t*)(wl + W_FO), M, D, FFH, FFH}; pg8::StaticOrder S; S.init(M, D, G, bx);
            const float* modn = mod + (size_t)(l + 1 < DEPTH ? l + 1 : l) * 8 * 6144;
            pg8::EpiRes E{outp, outp, modl + 5 * D, fuse_norm ? (l == DEPTH - 1 ? 2 : 1) : 0, (float*)(ws + WS_SLOT) + (size_t)M * 4, (unsigned*)(ws + WS_CNT) + (2 + l) * 4096,
                          l == DEPTH - 1 ? P.final_norm_g : P.norm_mix_g + (l + 1) * D, modn + 0 * D, modn + 1 * D, hbuf};
            pg8::gemm_phase(lds, g, S, E); } break;
        }
    }
#ifdef PROBE_MASK
    if (threadIdx.x == 0) pst[2] = __builtin_amdgcn_s_memrealtime();
    grid.sync();
    PROBE_STEP(N_PHASES - 1);
    __syncthreads();
    if (blockIdx.x == 0) { const int n = (int)((float)(unsigned)pst[1] * 0.15f); for (int i = threadIdx.x; i < n; i += 512) a.out[i] += 0.1f; }
#endif
}

extern "C" void kernel_launch(void* const* d_in, const int* in_sizes, int n_in, void* d_out, int out_size, void* d_ws, size_t ws_size, hipStream_t stream) {
    static int grid = 0;
    if (grid == 0) {
        if (n_in != 15 || out_size != M * D || ws_size < WS_END) { fprintf(stderr, "kernel_launch: unexpected shapes (n_in %d out %d ws %zu)\n", n_in, out_size, ws_size); grid = -1; return; }
        int dev = 0, cus = 0, per_cu = 0;
        hipGetDevice(&dev); hipDeviceGetAttribute(&cus, hipDeviceAttributeMultiprocessorCount, dev);
        if (hipFuncSetAttribute((const void*)fwd_kernel, hipFuncAttributeMaxDynamicSharedMemorySize, LDS_BYTES) != hipSuccess) { fprintf(stderr, "kernel_launch: hipFuncSetAttribute failed\n"); grid = -1; return; }
        if (hipOccupancyMaxActiveBlocksPerMultiprocessor(&per_cu, (const void*)fwd_kernel, 512, LDS_BYTES) != hipSuccess || per_cu < 1) { fprintf(stderr, "kernel_launch: occupancy query gave %d\n", per_cu); per_cu = 1; }
        (void)hipGetLastError();
        grid = cus * (per_cu > 1 ? 1 : per_cu);
        if (grid > 256) grid = 256;
    }
    if (grid < 0) return;
    Args a{};
    const float** pp = (const float**)&a.p;
    for (int i = 0; i < 15; ++i) pp[i] = (const float*)d_in[i];
    a.out = (float*)d_out; a.ws = (unsigned char*)d_ws;
#if N_LAUNCH_MODE
    for (int ph = 0; ph < N_PHASES; ++ph) { a.ph_lo = ph; a.ph_hi = ph + 1; hipLaunchKernelGGL(fwd_kernel, dim3(grid), dim3(512), LDS_BYTES, stream, a); }
#else
    a.ph_lo = 0; a.ph_hi = N_PHASES;
    void* args[] = {&a};
    hipError_t e = hipLaunchCooperativeKernel((const void*)fwd_kernel, dim3(grid), dim3(512), args, LDS_BYTES, stream);
    if (e != hipSuccess) fprintf(stderr, "cooperative launch failed: %s (grid %d)\n", hipGetErrorString(e), grid);
#endif
}
```

```cpp
#include <hip/hip_runtime.h>
#include <hip/hip_cooperative_groups.h>
#include <cstdio>
#include <cstdint>
namespace cg = cooperative_groups;

#ifndef N_LAUNCH_MODE
#define N_LAUNCH_MODE 0
#endif

#define LAS __attribute__((address_space(3)))
typedef unsigned short bf16_t;
typedef short bf16x8 __attribute__((ext_vector_type(8)));
typedef short s16x4 __attribute__((ext_vector_type(4)));
typedef float f32x4 __attribute__((ext_vector_type(4)));
typedef float f32x16 __attribute__((ext_vector_type(16)));
typedef unsigned u32x4 __attribute__((ext_vector_type(4)));
typedef unsigned u32x2 __attribute__((ext_vector_type(2)));

constexpr int BATCH = 8, SEQ = 2048, D = 1024, M = BATCH * SEQ, DEPTH = 2;
constexpr int NIN = 6920, FFH = 2816, FF2 = 2 * FFH;
constexpr int PITCH = 4608;
constexpr int NQKV = 3840, NQKVF = 4096, NG = 3072;
constexpr int FB_SRC = 2304;
constexpr int G_SRC = 3848;
constexpr float EPS = 1e-6f;
constexpr float LOG2E = 1.4426950408889634f;

constexpr size_t MiB = 1u << 20;
constexpr size_t WS_MOD = 0;
constexpr size_t WS_FLOG = 512 * 1024;
constexpr size_t WS_BAR = 1536 * 1024;
constexpr size_t WS_CNT = WS_BAR + 16384;
constexpr size_t WS_ZERO_BYTES = 16384 + 4 * 16384;
constexpr size_t WS_SLOT = 1024 * 1024;
constexpr size_t WS_W = 2 * MiB;
constexpr size_t W_QKV = 0, W_G = W_QKV + (size_t)NQKVF * D * 2, W_BR = W_G + (size_t)NG * D * 2, W_OUT = W_BR + (size_t)3 * D * 512 * 2,
                 W_FI = W_OUT + (size_t)D * D * 2, W_FO = W_FI + (size_t)FF2 * D * 2, W_LAYER = W_FO + (size_t)D * FFH * 2;
static_assert(W_LAYER == 35 * MiB + 512 * 1024, "weights per layer");
constexpr size_t WS_H = WS_W + 2 * W_LAYER;
constexpr size_t WS_PROJ = WS_H + (size_t)M * D * 2;
constexpr size_t WS_END = WS_PROJ + (size_t)M * PITCH * 2;
static_assert(WS_END <= 256 * MiB, "workspace");

constexpr int QA = 0, KA = 512, VA = 640, QB_ = 768, KB_ = 1280, VB_ = 1792, QC_ = 2304, KC_ = 2816, VC_ = 3328;
__host__ __device__ __forceinline__ int gate_col(int j) {
    return j == 0 ? 512 : (j < 4 ? 3840 + 256 * (j - 1) : (j < 8 ? 1280 + 256 * (j - 4) : 2816 + 256 * (j - 8)));
}

__device__ __forceinline__ unsigned cvt_pk_bf16(float lo, float hi) { unsigned r; asm volatile("v_cvt_pk_bf16_f32 %0, %1, %2" : "=v"(r) : "v"(lo), "v"(hi)); return r; }
__device__ __forceinline__ float bf_lo(unsigned w) { return __uint_as_float(w << 16); }
__device__ __forceinline__ float bf_hi(unsigned w) { return __uint_as_float(w & 0xffff0000u); }
__device__ __forceinline__ float wave_sum(float v) {
#pragma unroll
    for (int o = 1; o < 64; o <<= 1) v += __shfl_xor(v, o);
    return v;
}
__device__ __forceinline__ int tid_opaque() { int t = threadIdx.x; asm volatile("" : "+v"(t)); return t; }
__device__ __forceinline__ float sigmoidf_(float x) { return __builtin_amdgcn_rcpf(1.0f + __builtin_amdgcn_exp2f(-LOG2E * x)); }

__device__ __forceinline__ float reduce8(const float (&a)[8], int lane);
namespace pg8 {
constexpr int BM = 256, BK = 64, HALF = 128, HTB = HALF * BK * 2, STAGE_BYTES = 8 * HTB, NXCD = 8, WGM = 8;
__host__ __device__ __forceinline__ int lds_byte(int r, int c) { const int st = (r >> 4) * 2 + (c >> 5), rr = r & 15, cc = c & 31, ob = rr * 64 + cc * 2; return st * 1024 + (ob ^ (((ob >> 9) & 1) << 5)); }
__host__ __device__ __forceinline__ void stage_rc(int b, int& R, int& C) { const int st = b / 1024, sb = b % 1024, swz = sb ^ (((sb >> 9) & 1) << 5); R = (st >> 1) * 16 + swz / 64; C = (st & 1) * 32 + (swz % 64) / 2; }
__host__ __device__ __forceinline__ int perm32(int rho) { const int n = rho >> 4, i = rho & 15; return 8 * (i >> 2) + 4 * n + (i & 3); }

struct Unit { int pm, pn, k; };
struct Gemm { const bf16_t* A; const bf16_t* Bt; int M, N, K, lda; };

struct StaticOrder {
    int nM, nN, nwg, G, c;
    __device__ void init(int M_, int N_, int G_, int c_) { nM = M_ / BM; nN = N_ / BM; nwg = nM * nN; G = G_; c = c_; }
    __device__ __forceinline__ bool tile(int i, int& pm, int& pn) const {
        const long L = (long)i * G + c; if (L >= nwg) return false;
        int wgid = (int)L; { const int q = nwg / NXCD, r = nwg % NXCD, xcd = wgid % NXCD, off = wgid / NXCD; wgid = (xcd < r ? xcd * (q + 1) : r * (q + 1) + (xcd - r) * q) + off; }
        const int nig = WGM * nN, gid = wgid / nig, fm = gid * WGM, gsz = (nM - fm) < WGM ? (nM - fm) : WGM;
        pm = fm + ((wgid % nig) % gsz); pn = (wgid % nig) / gsz; return true;
    }
    __device__ __forceinline__ bool next(int i, Unit& u) const { u.k = 0; return tile(i, u.pm, u.pn); }
    __device__ __forceinline__ size_t a_off(const Unit&) const { return 0; }
};
struct BranchOrder {
    StaticOrder so;
    __device__ __forceinline__ bool next(int i, Unit& u) const { int pm, cn; if (!so.tile(i / 3, pm, cn)) return false; u.k = i % 3; u.pm = pm; u.pn = 4 * u.k + cn; return true; }
    __device__ __forceinline__ size_t a_off(const Unit& u) const { return (size_t)(u.k == 0 ? QA : (u.k == 1 ? QB_ : QC_)) * 2; }
};

struct EpiQKV {
    static constexpr bool PERM = true, AFTER_DRAIN = false;
    bf16_t* O; float* flog; const float* bfg;
    __device__ __forceinline__ bool keep(const Unit&) const { return false; }
    __device__ __forceinline__ void operator()(f32x4 (&acc)[2][2][4][2], const Unit& u, int wr, int wc, int fr, int fq) const {
        if (u.pn == 15) {
            if (wc == 0 && fq == 0) {
                const f32x4 b0 = *(const f32x4*)(bfg), b1 = *(const f32x4*)(bfg + 4);
#pragma unroll
                for (int ai = 0; ai < 2; ++ai)
#pragma unroll
                    for (int m = 0; m < 4; ++m) { float* fp = flog + (size_t)(u.pm * BM + ai * HALF + wr * 64 + m * 16 + fr) * 8;
                        *(f32x4*)fp = acc[ai][0][m][0] + b0; *(f32x4*)(fp + 4) = acc[ai][0][m][1] + b1; }
            }
            return;
        }
        const int row0 = u.pm * BM + wr * 64 + fr, col0 = u.pn * BM + wc * 32 + 8 * fq;
        const bool isq = (u.pn < 2) || (u.pn == 3) || (u.pn == 4) || (u.pn == 9) || (u.pn == 10);
        const float qs = isq ? 0.125f * LOG2E : 1.0f;
#pragma unroll
        for (int ai = 0; ai < 2; ++ai)
#pragma unroll
            for (int m = 0; m < 4; ++m) { bf16_t* rowp = O + (size_t)(row0 + ai * HALF + m * 16) * PITCH + col0;
#pragma unroll
                for (int bj = 0; bj < 2; ++bj) { const f32x4 v0 = acc[ai][bj][m][0] * qs, v1 = acc[ai][bj][m][1] * qs;
                    u32x4 w; w.x = cvt_pk_bf16(v0[0], v0[1]); w.y = cvt_pk_bf16(v0[2], v0[3]); w.z = cvt_pk_bf16(v1[0], v1[1]); w.w = cvt_pk_bf16(v1[2], v1[3]);
                    *(u32x4*)(rowp + bj * HALF) = w; } }
    }
};
struct EpiGate {
    static constexpr bool PERM = true, AFTER_DRAIN = false;
    bf16_t* O;
    __device__ __forceinline__ bool keep(const Unit&) const { return false; }
    __device__ __forceinline__ void operator()(f32x4 (&acc)[2][2][4][2], const Unit& u, int wr, int wc, int fr, int fq) const {
        const int row0 = u.pm * BM + wr * 64 + fr, col0 = gate_col(u.pn) + wc * 32 + 8 * fq;
#pragma unroll
        for (int ai = 0; ai < 2; ++ai)
#pragma unroll
            for (int m = 0; m < 4; ++m) { bf16_t* rowp = O + (size_t)(row0 + ai * HALF + m * 16) * PITCH + col0;
#pragma unroll
                for (int bj = 0; bj < 2; ++bj) { f32x4 v0 = acc[ai][bj][m][0], v1 = acc[ai][bj][m][1];
#pragma unroll
                    for (int i = 0; i < 4; ++i) { v0[i] = fmaxf(sigmoidf_(v0[i]), 1e-6f); v1[i] = fmaxf(sigmoidf_(v1[i]), 1e-6f); }
                    u32x4 w; w.x = cvt_pk_bf16(v0[0], v0[1]); w.y = cvt_pk_bf16(v0[2], v0[3]); w.z = cvt_pk_bf16(v1[0], v1[1]); w.w = cvt_pk_bf16(v1[2], v1[3]);
                    *(u32x4*)(rowp + bj * HALF) = w; } }
    }
};
struct EpiBranch {
    static constexpr bool PERM = true, AFTER_DRAIN = false;
    const bf16_t* P; bf16_t* O;
    __device__ __forceinline__ bool keep(const Unit& u) const { return u.k < 2; }
    __device__ __forceinline__ void operator()(f32x4 (&acc)[2][2][4][2], const Unit& u, int wr, int wc, int fr, int fq) const {
        const int cn = u.pn & 3, k = u.k;
        const int row0 = u.pm * BM + wr * 64 + fr, cofs = wc * 32 + 8 * fq;
        const int gc0 = gate_col(4 * k + cn) + cofs, gc1 = gate_col(4 * (k < 2 ? k + 1 : 2) + cn) + cofs;
#pragma unroll
        for (int ai = 0; ai < 2; ++ai)
#pragma unroll
            for (int m = 0; m < 4; ++m) { const size_t ro = (size_t)(row0 + ai * HALF + m * 16);
#pragma unroll
                for (int bj = 0; bj < 2; ++bj) {
                    const u32x4 ga = *(const u32x4*)(P + ro * PITCH + gc0 + bj * HALF);
                    float s[8] = {bf_lo(ga.x), bf_hi(ga.x), bf_lo(ga.y), bf_hi(ga.y), bf_lo(ga.z), bf_hi(ga.z), bf_lo(ga.w), bf_hi(ga.w)};
                    if (k < 2) { const u32x4 gb = *(const u32x4*)(P + ro * PITCH + gc1 + bj * HALF);
                        const float t[8] = {bf_lo(gb.x), bf_hi(gb.x), bf_lo(gb.y), bf_hi(gb.y), bf_lo(gb.z), bf_hi(gb.z), bf_lo(gb.w), bf_hi(gb.w)};
#pragma unroll
                        for (int i = 0; i < 8; ++i) s[i] = s[i] * __builtin_amdgcn_rcpf(t[i]); }
                    f32x4 v0 = acc[ai][bj][m][0], v1 = acc[ai][bj][m][1];
#pragma unroll
                    for (int i = 0; i < 4; ++i) { v0[i] *= s[i]; v1[i] *= s[4 + i]; }
                    if (k < 2) { acc[ai][bj][m][0] = v0; acc[ai][bj][m][1] = v1; }
                    else { u32x4 w; w.x = cvt_pk_bf16(v0[0], v0[1]); w.y = cvt_pk_bf16(v0[2], v0[3]); w.z = cvt_pk_bf16(v1[0], v1[1]); w.w = cvt_pk_bf16(v1[2], v1[3]);
                        *(u32x4*)(O + ro * D + cn * BM + cofs + bj * HALF) = w; } } }
    }
};
struct EpiRes {
    static constexpr bool PERM = false, AFTER_DRAIN = true;
    __device__ __forceinline__ void fused(f32x4 (&acc)[2][2][4][2], const Unit& u, int wr, int wc, int fr, int fq, LAS unsigned char* lds, int wid, int lane) const {
        constexpr int TP = 260;
        LAS float* T = (LAS float*)lds;
        const int b = u.pm >> 3, colg = u.pn * BM + 4 * lane;
        const f32x4 gg = *(const f32x4*)(gmod + (size_t)b * 6144 + colg);
        f32x4 xk[32];
#pragma unroll
        for (int ai = 0; ai < 2; ++ai) {
#pragma unroll
            for (int m = 0; m < 4; ++m)
#pragma unroll
                for (int bj = 0; bj < 2; ++bj)
#pragma unroll
                    for (int n = 0; n < 2; ++n) *(LAS f32x4*)(T + (wr * 64 + m * 16 + fr) * TP + bj * HALF + wc * 32 + n * 16 + 4 * fq) = acc[ai][bj][m][n];
            asm volatile("s_waitcnt lgkmcnt(0)" ::: "memory"); __builtin_amdgcn_s_barrier(); asm volatile("" ::: "memory");
#pragma unroll
            for (int hb = 0; hb < 2; ++hb) { f32x4 bs[8]; float ss[8];
#pragma unroll
                for (int rr = 0; rr < 8; ++rr) { const int rl = wid + 8 * (hb * 8 + rr); bs[rr] = *(const f32x4*)(base + (size_t)(u.pm * BM + ai * HALF + rl) * D + colg); }
#pragma unroll
                for (int rr = 0; rr < 8; ++rr) { const int rl = wid + 8 * (hb * 8 + rr); const f32x4 v = *(LAS const f32x4*)(T + rl * TP + 4 * lane);
                    const f32x4 o = bs[rr] + gg * v; ss[rr] = (o.x * o.x + o.y * o.y) + (o.z * o.z + o.w * o.w);
                    xk[ai * 16 + hb * 8 + rr] = o;
                    if (mode != 2) *(f32x4*)(out + (size_t)(u.pm * BM + ai * HALF + rl) * D + colg) = o; }
                if (mode != 0) {
                    const float tot = reduce8(ss, lane);
                    if (lane < 8) { const int rl = wid + 8 * (hb * 8 + lane);
                        __hip_atomic_store(slots + (size_t)(u.pm * BM + ai * HALF + rl) * 4 + u.pn, tot, __ATOMIC_RELAXED, __HIP_MEMORY_SCOPE_AGENT); }
                } }
            asm volatile("s_waitcnt lgkmcnt(0)" ::: "memory"); __builtin_amdgcn_s_barrier(); asm volatile("" ::: "memory");
        }
        if (mode == 0) return;
        asm volatile("s_waitcnt vmcnt(0)" ::: "memory");
        unsigned* pc = cnt + 64 * u.pm;
        if (lane == 0) __hip_atomic_fetch_add(pc, 1u, __ATOMIC_RELAXED, __HIP_MEMORY_SCOPE_AGENT);
        if (wid == 0) {
            unsigned sp = 0;
            while ((unsigned)__builtin_amdgcn_readfirstlane(__hip_atomic_load(pc, __ATOMIC_RELAXED, __HIP_MEMORY_SCOPE_AGENT)) < 32u) { __builtin_amdgcn_s_sleep(2); if (++sp > (1u << 18)) break; }
            __builtin_amdgcn_fence(__ATOMIC_ACQUIRE, "agent");
        }
        asm volatile("s_waitcnt vmcnt(0) lgkmcnt(0)" ::: "memory"); __builtin_amdgcn_s_barrier(); asm volatile("" ::: "memory");
        float rs;
        { const int k = lane & 31, rl = wid + 8 * (k & 15); const float* sl = slots + (size_t)(u.pm * BM + (k >> 4) * HALF + rl) * 4;
          const float t = (__hip_atomic_load(sl + 0, __ATOMIC_RELAXED, __HIP_MEMORY_SCOPE_AGENT) + __hip_atomic_load(sl + 1, __ATOMIC_RELAXED, __HIP_MEMORY_SCOPE_AGENT))
                        + (__hip_atomic_load(sl + 2, __ATOMIC_RELAXED, __HIP_MEMORY_SCOPE_AGENT) + __hip_atomic_load(sl + 3, __ATOMIC_RELAXED, __HIP_MEMORY_SCOPE_AGENT));
          rs = 1.0f / sqrtf(t * (1.0f / D) + EPS); }
        f32x4 am, sh;
        { const f32x4 gv = *(const f32x4*)(ng + colg);
          if (mode == 1) { am = gv * (1.0f + *(const f32x4*)(nscale + (size_t)b * 6144 + colg)); sh = *(const f32x4*)(nshift + (size_t)b * 6144 + colg); }
          else { am = gv; sh = (f32x4){0.f, 0.f, 0.f, 0.f}; } }
#pragma unroll
        for (int kb = 0; kb < 4; ++kb) {
#pragma unroll
            for (int rr = 0; rr < 8; ++rr) { const int k = kb * 8 + rr, rl = wid + 8 * (k & 15); const size_t ro = (size_t)(u.pm * BM + (k >> 4) * HALF + rl);
                const float rstd = __uint_as_float(__builtin_amdgcn_readlane(__float_as_uint(rs), k));
                const f32x4 hv = xk[k] * rstd * am + sh;
                if (mode == 1) { u32x2 w; w.x = cvt_pk_bf16(hv.x, hv.y); w.y = cvt_pk_bf16(hv.z, hv.w); *(u32x2*)(hn + ro * D + colg) = w; }
                else *(f32x4*)(out + ro * D + colg) = hv; } }
    }
    const float* base; float* out; const float* gmod;
    int mode; float* slots; unsigned* cnt; const float* ng; const float* nshift; const float* nscale; bf16_t* hn;
    __device__ __forceinline__ bool keep(const Unit&) const { return false; }
    __device__ __forceinline__ void operator()(f32x4 (&acc)[2][2][4][2], const Unit& u, int wr, int wc, int fr, int fq) const {
        const int b = u.pm >> 3;
        const int col0 = u.pn * BM + wc * 32 + 4 * fq;
        const float* gv = gmod + (size_t)b * 6144 + col0;
        f32x4 gg[2][2];
#pragma unroll
        for (int bj = 0; bj < 2; ++bj)
#pragma unroll
            for (int n = 0; n < 2; ++n) gg[bj][n] = *(const f32x4*)(gv + bj * HALF + n * 16);
#pragma unroll
        for (int ai = 0; ai < 2; ++ai)
#pragma unroll
            for (int m = 0; m < 4; ++m) { const size_t off = (size_t)(u.pm * BM + ai * HALF + wr * 64 + m * 16 + fr) * D + col0;
#pragma unroll
                for (int bj = 0; bj < 2; ++bj)
#pragma unroll
                    for (int n = 0; n < 2; ++n) { const f32x4 bs = *(const f32x4*)(base + off + bj * HALF + n * 16);
                        *(f32x4*)(out + off + bj * HALF + n * 16) = bs + gg[bj][n] * acc[ai][bj][m][n]; } }
    }
};
struct EpiSwiglu {
    static constexpr bool PERM = true, AFTER_DRAIN = false;
    bf16_t* O;
    __device__ __forceinline__ bool keep(const Unit&) const { return false; }
    __device__ __forceinline__ void operator()(f32x4 (&acc)[2][2][4][2], const Unit& u, int wr, int wc, int fr, int fq) const {
        const int row0 = u.pm * BM + wr * 64 + fr, col0 = u.pn * HALF + wc * 32 + 8 * fq;
#pragma unroll
        for (int ai = 0; ai < 2; ++ai)
#pragma unroll
            for (int m = 0; m < 4; ++m) { bf16_t* rowp = O + (size_t)(row0 + ai * HALF + m * 16) * FFH + col0;
                f32x4 r0, r1;
#pragma unroll
                for (int i = 0; i < 4; ++i) { const float g0 = acc[ai][0][m][0][i], g1 = acc[ai][0][m][1][i];
                    r0[i] = g0 * sigmoidf_(g0) * acc[ai][1][m][0][i]; r1[i] = g1 * sigmoidf_(g1) * acc[ai][1][m][1][i]; }
                u32x4 w; w.x = cvt_pk_bf16(r0[0], r0[1]); w.y = cvt_pk_bf16(r0[2], r0[3]); w.z = cvt_pk_bf16(r1[0], r1[1]); w.w = cvt_pk_bf16(r1[2], r1[3]);
                *(u32x4*)rowp = w; }
    }
};

template <class Epi, class Sched>
__device__ __forceinline__ void gemm_phase(LAS unsigned char* lds, const Gemm g, const Sched& S, const Epi& E) {
    const int tid = tid_opaque(), wid = __builtin_amdgcn_readfirstlane(tid >> 6), lane = tid & 63, wr = wid >> 2, wc = wid & 3, fr = lane & 15, fq = lane >> 4;
    const int K = g.K, nt = K / BK, lda = g.lda;
    unsigned voffA[2], voffB[2];
#pragma unroll
    for (int i = 0; i < 2; ++i) { int R, C; stage_rc(tid * 16 + i * 8192, R, C); const int Rb = Epi::PERM ? ((R & ~31) + perm32(R & 31)) : R;
        voffA[i] = (unsigned)(R * lda + C) * 2u; voffB[i] = (unsigned)(Rb * K + C) * 2u; }
    const size_t kstep = (size_t)(BK * 2);
    const size_t hstepA = (size_t)HALF * lda * 2, hstepB = (size_t)HALF * K * 2;
    const size_t tstepA = 2 * hstepA, tstepB = 2 * hstepB;
    const unsigned ldsw = (unsigned)wid * 1024u;
    const int aoff = lds_byte(wr * 64 + fr, fq * 8), boff = lds_byte(wc * 32 + fr, fq * 8);
#define PG8_SA(b, h) (((b) * 2 + (h)) * HTB)
#define PG8_SB(b, h) ((4 + (b) * 2 + (h)) * HTB)
#define PG8_STAGE(bufoff, gbase, voff) do { _Pragma("unroll") for (int _i = 0; _i < 2; ++_i) \
        __builtin_amdgcn_global_load_lds((const unsigned*)((const char*)(gbase) + (voff)[_i]), (LAS unsigned*)(lds + (bufoff) + ldsw + _i * 8192), 16, 0, 0); } while (0)
#define PG8_LDA(dst, b, h) do { _Pragma("unroll") for (int m = 0; m < 4; ++m) _Pragma("unroll") for (int k = 0; k < 2; ++k) dst[m][k] = *(const LAS bf16x8*)(lds + PG8_SA(b, h) + aoff + m * 2048 + k * 1024); } while (0)
#define PG8_LDB(dst, b, h) do { _Pragma("unroll") for (int n = 0; n < 2; ++n) _Pragma("unroll") for (int k = 0; k < 2; ++k) dst[n][k] = *(const LAS bf16x8*)(lds + PG8_SB(b, h) + boff + n * 2048 + k * 1024); } while (0)
#define PG8_MMA(ai, bj, At, Bt) do { __builtin_amdgcn_s_setprio(1); _Pragma("unroll") for (int m = 0; m < 4; ++m) _Pragma("unroll") for (int n = 0; n < 2; ++n) _Pragma("unroll") for (int k = 0; k < 2; ++k) \
        acc[ai][bj][m][n] = __builtin_amdgcn_mfma_f32_16x16x32_bf16(Bt[n][k], At[m][k], acc[ai][bj][m][n], 0, 0, 0); __builtin_amdgcn_s_setprio(0); } while (0)
#define PG8_WAIT_V(n) asm volatile("s_waitcnt vmcnt(" #n ")" ::: "memory")
#define PG8_WAIT_L(n) asm volatile("s_waitcnt lgkmcnt(" #n ")" ::: "memory")
#define PG8_BAR __builtin_amdgcn_s_barrier()
#define PG8_SCHED __builtin_amdgcn_sched_barrier(0)
    Unit cur, nxt; int ui = 0;
    if (!S.next(0, cur)) return;
    f32x4 acc[2][2][4][2];
#pragma unroll
    for (int a = 0; a < 2; ++a)
#pragma unroll
        for (int b = 0; b < 2; ++b)
#pragma unroll
            for (int m = 0; m < 4; ++m)
#pragma unroll
                for (int n = 0; n < 2; ++n) acc[a][b][m][n] = (f32x4){0.f, 0.f, 0.f, 0.f};
    bf16x8 At[4][2], B0[2][2], B1[2][2];
    const char* cA = (const char*)g.A + S.a_off(cur) + (size_t)cur.pm * tstepA; const char* cB = (const char*)g.Bt + (size_t)cur.pn * tstepB;
    PG8_STAGE(PG8_SB(0, 0), cB, voffB); PG8_STAGE(PG8_SB(0, 1), cB + hstepB, voffB); PG8_STAGE(PG8_SA(0, 0), cA, voffA); PG8_STAGE(PG8_SA(0, 1), cA + hstepA, voffA);
    if (wr == 1) PG8_BAR;
    PG8_WAIT_V(2); PG8_BAR;
    PG8_STAGE(PG8_SB(1, 0), cB + kstep, voffB); PG8_STAGE(PG8_SA(1, 0), cA + kstep, voffA); PG8_STAGE(PG8_SB(1, 1), cB + hstepB + kstep, voffB);
    PG8_WAIT_V(6); PG8_BAR;
    for (;;) {
        const bool has_next = S.next(ui + 1, nxt);
        const char* nA = has_next ? (const char*)g.A + S.a_off(nxt) + (size_t)nxt.pm * tstepA : cA; const char* nB = has_next ? (const char*)g.Bt + (size_t)nxt.pn * tstepB : cB;
        for (int t = 0; t < nt; t += 2) {
            const bool last = (t == nt - 2);
            const char* a1 = cA + (size_t)(t + 1) * kstep;
            const char* a2 = last ? nA : cA + (size_t)(t + 2) * kstep; const char* b2 = last ? nB : cB + (size_t)(t + 2) * kstep;
            const char* a3 = a2 + kstep; const char* b3 = b2 + kstep;
            PG8_LDB(B0, 0, 0); PG8_LDB(B1, 0, 1); PG8_SCHED; PG8_LDA(At, 0, 0); PG8_STAGE(PG8_SA(1, 1), a1 + hstepA, voffA);
            PG8_WAIT_V(8); PG8_WAIT_L(0); PG8_BAR; PG8_MMA(0, 0, At, B0); PG8_MMA(0, 1, At, B1); PG8_BAR; PG8_SCHED;
            PG8_LDA(At, 0, 1); PG8_STAGE(PG8_SB(0, 0), b2, voffB); PG8_STAGE(PG8_SB(0, 1), b2 + hstepB, voffB); PG8_STAGE(PG8_SA(0, 0), a2, voffA);
            PG8_WAIT_V(8); PG8_WAIT_L(0); PG8_BAR; PG8_MMA(1, 0, At, B0); PG8_MMA(1, 1, At, B1); PG8_BAR; PG8_SCHED;
            PG8_LDB(B0, 1, 0); PG8_LDB(B1, 1, 1); PG8_SCHED; PG8_LDA(At, 1, 0); PG8_STAGE(PG8_SA(0, 1), a2 + hstepA, voffA);
            PG8_WAIT_V(8); PG8_WAIT_L(0); PG8_BAR; PG8_MMA(0, 0, At, B0); PG8_MMA(0, 1, At, B1); PG8_BAR; PG8_SCHED;
            PG8_LDA(At, 1, 1); PG8_STAGE(PG8_SB(1, 0), b3, voffB); PG8_STAGE(PG8_SB(1, 1), b3 + hstepB, voffB); PG8_STAGE(PG8_SA(1, 0), a3, voffA);
            PG8_WAIT_V(8); PG8_WAIT_L(0); PG8_BAR; PG8_MMA(1, 0, At, B0); PG8_MMA(1, 1, At, B1); PG8_BAR; PG8_SCHED;
        }
        if (wr == 0) PG8_BAR;
        if (!(Epi::AFTER_DRAIN && !has_next)) E(acc, cur, wr, wc, fr, fq);
        if (!has_next) break;
        if (!E.keep(cur)) {
#pragma unroll
            for (int a = 0; a < 2; ++a)
#pragma unroll
                for (int b = 0; b < 2; ++b)
#pragma unroll
                    for (int m = 0; m < 4; ++m)
#pragma unroll
                        for (int n = 0; n < 2; ++n) acc[a][b][m][n] = (f32x4){0.f, 0.f, 0.f, 0.f};
        }
        cur = nxt; cA = nA; cB = nB; ++ui;
        if (wr == 1) PG8_BAR;
    }
    PG8_WAIT_V(0);
    PG8_BAR;
    if constexpr (Epi::AFTER_DRAIN) E.fused(acc, cur, wr, wc, fr, fq, lds, wid, lane);
#undef PG8_SA
#undef PG8_SB
#undef PG8_STAGE
#undef PG8_LDA
#undef PG8_LDB
#undef PG8_MMA
#undef PG8_WAIT_V
#undef PG8_WAIT_L
#undef PG8_BAR
#undef PG8_SCHED
}
}

namespace att {
typedef short v4i16_t __attribute__((ext_vector_type(4)));
__device__ __forceinline__ int crow(int r, int hi) { return (r & 3) + 8 * (r >> 2) + 4 * hi; }
__device__ __forceinline__ s16x4 vtr(LAS const unsigned char* p) { return __builtin_bit_cast(s16x4, __builtin_amdgcn_ds_read_tr16_b64_v4i16((LAS v4i16_t*)p)); }
constexpr float C2 = 0.125f * LOG2E;
constexpr float NEG = -1e30f;
constexpr int LDS_K = 0, LDS_V = 32768, LDS_REL = 65536, LDS_CUM = 69632;

__device__ __forceinline__ float max3f(float a, float b, float c) { return __builtin_fmaxf(__builtin_fmaxf(a, b), c); }
constexpr float THR = 8.0f;
template <int VAR>
__device__ __forceinline__ void tile(LAS unsigned char* lds, int cur, int kt, int dk, const bf16x8 (&qr)[4], float& mref, float& lrow, f32x16& o0, f32x16& o1, f32x16& negm, bool& first,
                                     LAS float* relX, LAS float* ckL, float slopeL, const f32x16& kf0, const int (&koff)[4], int qloc, int hi, int r32, int lane) {
            LAS const unsigned char* kp = lds + LDS_K + cur * 8192 + r32 * 128;
            f32x16 p0, p1;
            __builtin_amdgcn_s_setprio(1);
#pragma unroll
            for (int d0 = 0; d0 < 4; ++d0) {
                const bf16x8 k0 = *(LAS const bf16x8*)(kp + koff[d0]), k1 = *(LAS const bf16x8*)(kp + 4096 + koff[d0]);
                if (d0 == 0) { p0 = __builtin_amdgcn_mfma_f32_32x32x16_bf16(k0, qr[0], negm, 0, 0, 0); p1 = __builtin_amdgcn_mfma_f32_32x32x16_bf16(k1, qr[0], negm, 0, 0, 0); }
                else { p0 = __builtin_amdgcn_mfma_f32_32x32x16_bf16(k0, qr[d0], p0, 0, 0, 0); p1 = __builtin_amdgcn_mfma_f32_32x32x16_bf16(k1, qr[d0], p1, 0, 0, 0); }
            }
            __builtin_amdgcn_s_setprio(0);
            if (VAR == 0) {
                const float dqf = (float)(64 * dk + qloc);
                const f32x16 d0v = dqf - kf0, d1v = d0v - 32.0f;
#pragma unroll
                for (int r = 0; r < 16; ++r) { p0[r] = __builtin_fmaf(-slopeL, __builtin_fabsf(d0v[r]), p0[r]); p1[r] = __builtin_fmaf(-slopeL, __builtin_fabsf(d1v[r]), p1[r]); }
            } else if (VAR == 1) {
                LAS const float* ckp = ckL + kt * 64 + 4 * hi;
                f32x16 c0v, c1v;
#pragma unroll
                for (int g = 0; g < 4; ++g) { const f32x4 c0 = *(LAS const f32x4*)(ckp + 8 * g), c1 = *(LAS const f32x4*)(ckp + 32 + 8 * g);
#pragma unroll
                    for (int i = 0; i < 4; ++i) { c0v[4 * g + i] = c0[i]; c1v[4 * g + i] = c1[i]; } }
                p0 = p0 - c0v; p1 = p1 - c1v;
                if (dk == 0) {
#pragma unroll
                    for (int r = 0; r < 16; ++r) { const int key = crow(r, hi); if (key > qloc) p0[r] = NEG; if (key + 32 > qloc) p1[r] = NEG; }
                }
            } else {
                if (dk >= 3) { const float rf = relX[64];
                    p0 = p0 + rf; p1 = p1 + rf;
                } else {
                    LAS const float* rb = relX + 64 + (128 - 64 * dk - qloc) + 4 * hi;
                    f32x16 b0v, b1v;
#pragma unroll
                    for (int r = 0; r < 16; ++r) { b0v[r] = rb[(r & 3) + 8 * (r >> 2)]; b1v[r] = rb[32 + (r & 3) + 8 * (r >> 2)]; }
                    p0 = p0 + b0v; p1 = p1 + b1v;
                }
            }
            float ra = max3f(p0[0], p0[1], p0[2]), rb2 = max3f(p1[0], p1[1], p1[2]);
#pragma unroll
            for (int r = 3; r < 15; r += 2) { ra = max3f(ra, p0[r], p0[r + 1]); rb2 = max3f(rb2, p1[r], p1[r + 1]); }
            float rm = max3f(ra, rb2, __builtin_fmaxf(p0[15], p1[15]));
            rm = __builtin_fmaxf(rm, __shfl_xor(rm, 32));
            if (first || __any(rm > THR)) {
                const float dl = first ? rm : __builtin_fmaxf(rm, 0.f);
                mref += dl;
                p0 = p0 - dl; p1 = p1 - dl;
                const float f = first ? 1.0f : __builtin_amdgcn_exp2f(-dl);
                lrow *= f; o0 = o0 * f; o1 = o1 * f;
#pragma unroll
                for (int r = 0; r < 16; ++r) negm[r] = -mref;
                first = false;
            }
#pragma unroll
            for (int r = 0; r < 16; ++r) { p0[r] = __builtin_amdgcn_exp2f(p0[r]); p1[r] = __builtin_amdgcn_exp2f(p1[r]); }
            { const f32x16 sv = p0 + p1;
              float ls = 0.f;
#pragma unroll
              for (int r = 0; r < 16; r += 4) ls += (sv[r] + sv[r + 1]) + (sv[r + 2] + sv[r + 3]);
              lrow += ls; }
            u32x4 pw[4];
#pragma unroll
            for (int i = 0; i < 4; ++i) { pw[0][i] = cvt_pk_bf16(p0[2 * i], p0[2 * i + 1]); pw[1][i] = cvt_pk_bf16(p0[8 + 2 * i], p0[9 + 2 * i]);
                                          pw[2][i] = cvt_pk_bf16(p1[2 * i], p1[2 * i + 1]); pw[3][i] = cvt_pk_bf16(p1[8 + 2 * i], p1[9 + 2 * i]); }
            const unsigned vb = (unsigned)(uintptr_t)(lds + LDS_V + cur * 8192 + ((lane >> 4) & 1) * 32 + (lane & 3) * 8 + (4 * hi + ((lane & 15) >> 2)) * 64);
#pragma unroll
            for (int d0 = 0; d0 < 2; ++d0) {
                s16x4 lo[4], hh[4];
#pragma unroll
                for (int ks = 0; ks < 4; ++ks) {
                    asm volatile("ds_read_b64_tr_b16 %0, %1 offset:%c2" : "=&v"(lo[ks]) : "v"(vb), "i"(d0 * 4096 + ks * 1024) : "memory");
                    asm volatile("ds_read_b64_tr_b16 %0, %1 offset:%c2" : "=&v"(hh[ks]) : "v"(vb), "i"(d0 * 4096 + ks * 1024 + 512) : "memory"); }
                asm volatile("s_waitcnt lgkmcnt(0)" ::: "memory"); __builtin_amdgcn_sched_barrier(0);
#pragma unroll
                for (int ks = 0; ks < 4; ++ks) {
                    const bf16x8 pf = __builtin_bit_cast(bf16x8, pw[ks]);
                    const bf16x8 vf = (bf16x8){lo[ks][0], lo[ks][1], lo[ks][2], lo[ks][3], hh[ks][0], hh[ks][1], hh[ks][2], hh[ks][3]};
                    if (d0 == 0) o0 = __builtin_amdgcn_mfma_f32_32x32x16_bf16(vf, pf, o0, 0, 0, 0);
                    else o1 = __builtin_amdgcn_mfma_f32_32x32x16_bf16(vf, pf, o1, 0, 0, 0);
                }
            }
}
struct Src { const bf16_t* k; const bf16_t* v; const bf16_t* q; int nt; };
__device__ __forceinline__ Src make_src(int var, const bf16_t* proj, int b, int h, int qb, int lane, int wid) {
    const int qc = var == 0 ? QA : (var == 1 ? QB_ : QC_), kc = var == 0 ? KA : (var == 1 ? KB_ : KC_), vc = var == 0 ? VA : (var == 1 ? VB_ : VC_);
    const int kvh = var == 0 ? (h >> 2) : h, back = var == 0 ? 2 : (var == 1 ? 1000 : 8);
    const int kt_lo = var == 1 ? 0 : (4 * qb - back > 0 ? 4 * qb - back : 0), kt_hi = 4 * qb + 3;
    const size_t row0 = (size_t)b * SEQ + (size_t)kt_lo * 64;
    const int kkey = wid * 8 + (lane >> 3), kchunk = (lane & 7) ^ ((kkey >> 1) & 7);
    Src s;
    s.k = proj + (row0 + kkey) * PITCH + kc + kvh * 64 + kchunk * 8;
    s.v = proj + (row0 + 16 * (wid & 3) + (lane >> 2)) * PITCH + vc + kvh * 64 + (wid >> 2) * 32 + (lane & 3) * 8;
    s.q = proj + ((size_t)b * SEQ + qb * 256 + wid * 32 + (lane & 31)) * PITCH + qc + h * 64 + (lane >> 5) * 8;
    s.nt = kt_hi - kt_lo + 1;
    return s;
}
template <int VAR>
__device__ __forceinline__ void unit(LAS unsigned char* lds, bf16_t* proj, const float* sinks, int b, int h, int qb, int& cur, bool prefetched, bool has_next, const Src& nx, bf16x8 (&qr)[4]) {
    const int tid = tid_opaque(), lane = tid & 63, r32 = lane & 31, hi = lane >> 5; const int wid = __builtin_amdgcn_readfirstlane(tid >> 6);
    const Src me = make_src(VAR, proj, b, h, qb, lane, wid);
    const int nt = me.nt, kt_hi = 4 * qb + 3, kt_lo = kt_hi - nt + 1;
    const int c = 4 * qb + (wid >> 1);
    constexpr int BACK = VAR == 0 ? 2 : (VAR == 1 ? 1000 : 8);
    LAS float* relX = (LAS float*)(lds + LDS_REL);
    LAS float* ckL = (LAS float*)(lds + LDS_CUM);
#define ATT_DMA2(kp_, vp_, slot) do { \
        __builtin_amdgcn_global_load_lds((const unsigned*)(kp_), (LAS unsigned*)(lds + LDS_K + (slot) * 8192 + wid * 1024), 16, 0, 0); \
        __builtin_amdgcn_global_load_lds((const unsigned*)(vp_), (LAS unsigned*)(lds + LDS_V + (slot) * 8192 + wid * 1024), 16, 0, 0); } while (0)
    if (!prefetched) {
        ATT_DMA2(me.k, me.v, cur); ATT_DMA2(me.k + (size_t)64 * PITCH, me.v + (size_t)64 * PITCH, (cur + 1) & 3); ATT_DMA2(me.k + (size_t)128 * PITCH, me.v + (size_t)128 * PITCH, (cur + 2) & 3);
#pragma unroll
        for (int d0 = 0; d0 < 4; ++d0) qr[d0] = *(const bf16x8*)(me.q + d0 * 16);
    }
    const float sinkL = VAR == 0 ? sinks[h] * LOG2E : 0.f;
    float mref = 0.f, lrow = 0.f; bool first = true;
    f32x16 negm;
#pragma unroll
    for (int r = 0; r < 16; ++r) negm[r] = 0.f;
    int koff[4];
#pragma unroll
    for (int d0 = 0; d0 < 4; ++d0) koff[d0] = ((2 * d0 + hi) ^ ((r32 >> 1) & 7)) << 4;
    f32x16 o0, o1;
#pragma unroll
    for (int r = 0; r < 16; ++r) { o0[r] = 0.f; o1[r] = 0.f; }
    const float slopeL = VAR == 0 ? exp2f(-(float)(h + 1)) * LOG2E : 0.f;
    const int qloc = 32 * (wid & 1) + r32;
    f32x16 kf0;
#pragma unroll
    for (int r = 0; r < 16; ++r) kf0[r] = (float)crow(r, hi);
    bf16x8 qn[4];
#pragma unroll
    for (int d0 = 0; d0 < 4; ++d0) qn[d0] = qr[d0];
    for (int i = 0; i < nt; ++i) {
        const int kt = kt_lo + i;
        if (prefetched && i == 0) asm volatile("s_waitcnt vmcnt(8) lgkmcnt(0)" ::: "memory");
        else asm volatile("s_waitcnt vmcnt(4) lgkmcnt(0)" ::: "memory");
        __builtin_amdgcn_s_barrier(); asm volatile("" ::: "memory");
        { const int i3 = i + 3; const bf16_t* kp; const bf16_t* vp;
          if (i3 < nt) { kp = me.k + (size_t)i3 * 64 * PITCH; vp = me.v + (size_t)i3 * 64 * PITCH; }
          else if (has_next) { kp = nx.k + (size_t)(i3 - nt) * 64 * PITCH; vp = nx.v + (size_t)(i3 - nt) * 64 * PITCH; }
          else { kp = me.k + (size_t)(nt - 1) * 64 * PITCH; vp = me.v + (size_t)(nt - 1) * 64 * PITCH; }
          ATT_DMA2(kp, vp, (cur + 3) & 3); }
        if (has_next && i == nt - 1) {
#pragma unroll
            for (int d0 = 0; d0 < 4; ++d0) qn[d0] = *(const bf16x8*)(nx.q + d0 * 16);
        }
        { const int dk = c - kt; if (dk >= 0 && dk <= BACK) tile<VAR>(lds, cur, kt, dk, qr, mref, lrow, o0, o1, negm, first, relX, ckL, slopeL, kf0, koff, qloc, hi, r32, lane); }
        cur = (cur + 1) & 3;
    }
    if (!has_next) {
        asm volatile("s_waitcnt vmcnt(0) lgkmcnt(0)" ::: "memory");
        __builtin_amdgcn_s_barrier(); asm volatile("" ::: "memory");
    }
#undef ATT_DMA2
    lrow += __shfl_xor(lrow, 32);
    if (VAR == 0) lrow += exp2f(sinkL - mref);
    const float rl = 1.0f / lrow;
    bf16_t* orow = const_cast<bf16_t*>(me.q) - hi * 8 + 4 * hi;
#pragma unroll
    for (int g = 0; g < 4; ++g) {
        u32x2 w0, w1;
        w0.x = cvt_pk_bf16(o0[4 * g] * rl, o0[4 * g + 1] * rl); w0.y = cvt_pk_bf16(o0[4 * g + 2] * rl, o0[4 * g + 3] * rl);
        w1.x = cvt_pk_bf16(o1[4 * g] * rl, o1[4 * g + 1] * rl); w1.y = cvt_pk_bf16(o1[4 * g + 2] * rl, o1[4 * g + 3] * rl);
        *(u32x2*)(orow + 8 * g) = w0; *(u32x2*)(orow + 32 + 8 * g) = w1;
    }
#pragma unroll
    for (int d0 = 0; d0 < 4; ++d0) qr[d0] = qn[d0];
}
}

__device__ __forceinline__ void mod_phase(LAS unsigned char* lds, const float* cvec, const float* w_ada, const float* b_ada, float* mod) {
    const int tid = tid_opaque(), lane = tid & 63, wid = tid >> 6;
    LAS float* condL = (LAS float*)lds;
    LAS float* red = (LAS float*)(lds + 32768);
    for (int i = tid; i < BATCH * D; i += 512) { const float c = cvec[i]; condL[i] = c / (1.0f + __expf(-c)); }
    __syncthreads();
    for (int cb = blockIdx.x; cb < 192; cb += gridDim.x) {
        const int l = cb / 96, e0 = (cb % 96) * 64;
        float acc[8];
#pragma unroll
        for (int b = 0; b < 8; ++b) acc[b] = 0.f;
        const float* w = w_ada + ((size_t)l * D + wid * 128) * 6144 + e0 + lane;
#pragma unroll 4
        for (int d = 0; d < 128; ++d) { const float wv = __builtin_nontemporal_load(&w[(size_t)d * 6144]);
#pragma unroll
            for (int b = 0; b < 8; ++b) acc[b] += condL[b * D + wid * 128 + d] * wv; }
#pragma unroll
        for (int b = 0; b < 8; ++b) red[(wid * 8 + b) * 64 + lane] = acc[b];
        __syncthreads();
        { const int b = tid >> 6; float s = b_ada[l * 6144 + e0 + lane];
#pragma unroll
          for (int w8 = 0; w8 < 8; ++w8) s += red[(w8 * 8 + b) * 64 + lane];
          mod[(size_t)(l * 8 + b) * 6144 + e0 + lane] = s; }
        __syncthreads();
    }
}
__device__ __forceinline__ void transpose_item(const float* W, int Nsrc, int nsrc, int k0, bf16_t* WT, int K, int ndst, LAS float* scr, int lane) {
#pragma unroll 8
    for (int i = 0; i < 32; ++i) { const int kk = 2 * i + (lane >> 5); scr[kk * 33 + (lane & 31)] = __builtin_nontemporal_load(&W[(size_t)(k0 + kk) * Nsrc + nsrc + (lane & 31)]); }
    asm volatile("s_waitcnt lgkmcnt(0)" ::: "memory");
    const int c = lane & 7;
#pragma unroll
    for (int j = 0; j < 4; ++j) { const int n = (lane >> 3) + 8 * j; const LAS float* s = scr + (8 * c) * 33 + n;
        u32x4 o; o.x = cvt_pk_bf16(s[0 * 33], s[1 * 33]); o.y = cvt_pk_bf16(s[2 * 33], s[3 * 33]); o.z = cvt_pk_bf16(s[4 * 33], s[5 * 33]); o.w = cvt_pk_bf16(s[6 * 33], s[7 * 33]);
        *(u32x4*)(WT + (size_t)(ndst + n) * K + k0 + 8 * c) = o; }
    asm volatile("s_waitcnt lgkmcnt(0)" ::: "memory");
}
struct Ptrs {
    const float *x, *c, *norm_mix_g, *norm_ffn_g, *w_ada, *b_ada, *w_in, *b_forget, *sinks, *rel_bias, *w_branch, *w_out, *w_ffn_in, *w_ffn_out, *final_norm_g;
};
__device__ __forceinline__ void convert_phase(LAS unsigned char* lds, const Ptrs& P, unsigned char* ws) {
    const int tid = tid_opaque(), lane = tid & 63, wid = tid >> 6;
    LAS float* scr = (LAS float*)(lds + 65536 + wid * 8448);
    const int gw = blockIdx.x * 8 + wid, NGW = gridDim.x * 8;
    constexpr int I_QKV = 16 * (NQKV / 32), I_G = 16 * (NG / 32), I_BR = 3 * 8 * 32, I_OUT = 16 * 32, I_FI = 16 * (FF2 / 32), I_FO = (FFH / 64) * 32, I_FB = 64;
    constexpr int I_LAYER = I_QKV + I_G + I_BR + I_OUT + I_FI + I_FO + I_FB;
    for (int it = gw; it < 2 * I_LAYER; it += NGW) {
        const int l = it / I_LAYER; int r = it % I_LAYER;
        unsigned char* wl = ws + WS_W + (size_t)l * W_LAYER;
        if (r < I_QKV) { const int nb = r % (NQKV / 32), kb = r / (NQKV / 32), n0 = 32 * nb;
            transpose_item(P.w_in + (size_t)l * D * NIN, NIN, n0 < 2304 ? n0 : n0 + 8, 64 * kb, (bf16_t*)(wl + W_QKV), D, n0, scr, lane); continue; } r -= I_QKV;
        if (r < I_G) { const int nb = r % (NG / 32), kb = r / (NG / 32), n0 = 32 * nb;
            transpose_item(P.w_in + (size_t)l * D * NIN, NIN, G_SRC + n0, 64 * kb, (bf16_t*)(wl + W_G), D, n0, scr, lane); continue; } r -= I_G;
        if (r < I_BR) { const int k = r / 256, rr = r % 256, nb = rr % 32, kb = rr / 32;
            transpose_item(P.w_branch + ((size_t)l * 3 + k) * 512 * D, D, 32 * nb, 64 * kb, (bf16_t*)(wl + W_BR), 512, k * D + 32 * nb, scr, lane); continue; } r -= I_BR;
        if (r < I_OUT) { const int nb = r % 32, kb = r / 32;
            transpose_item(P.w_out + (size_t)l * D * D, D, 32 * nb, 64 * kb, (bf16_t*)(wl + W_OUT), D, 32 * nb, scr, lane); continue; } r -= I_OUT;
        if (r < I_FI) { const int nb = r % (FF2 / 32), kb = r / (FF2 / 32), n0 = 32 * nb, pn = n0 >> 8, w = n0 & 255;
            const int src = w < 128 ? 128 * pn + w : FFH + 128 * pn + (w - 128);
            transpose_item(P.w_ffn_in + (size_t)l * D * FF2, FF2, src, 64 * kb, (bf16_t*)(wl + W_FI), D, n0, scr, lane); continue; } r -= I_FI;
        if (r < I_FO) { const int nb = r % 32, kb = r / 32;
            transpose_item(P.w_ffn_out + (size_t)l * FFH * D, D, 32 * nb, 64 * kb, (bf16_t*)(wl + W_FO), FFH, 32 * nb, scr, lane); continue; } r -= I_FO;
        {
            const float* wsrc = P.w_in + (size_t)l * D * NIN + FB_SRC;
#pragma unroll
            for (int q = 0; q < 4; ++q) { const int n = 4 * r + q; u32x4 o0 = {0u, 0u, 0u, 0u}, o1 = {0u, 0u, 0u, 0u};
                if (n < 8) { float v[16];
#pragma unroll
                    for (int i = 0; i < 16; ++i) v[i] = wsrc[(size_t)(16 * lane + i) * NIN + n];
                    o0.x = cvt_pk_bf16(v[0], v[1]); o0.y = cvt_pk_bf16(v[2], v[3]); o0.z = cvt_pk_bf16(v[4], v[5]); o0.w = cvt_pk_bf16(v[6], v[7]);
                    o1.x = cvt_pk_bf16(v[8], v[9]); o1.y = cvt_pk_bf16(v[10], v[11]); o1.z = cvt_pk_bf16(v[12], v[13]); o1.w = cvt_pk_bf16(v[14], v[15]); }
                bf16_t* dst = (bf16_t*)(wl + W_QKV) + (size_t)(NQKV + n) * D + 16 * lane;
                *(u32x4*)dst = o0; *(u32x4*)(dst + 8) = o1; }
        }
    }
}
__device__ __forceinline__ float reduce8(const float (&a)[8], int lane) {
    float b[4], c[2];
    const bool b0 = lane & 1, b1 = lane & 2, b2 = lane & 4;
#pragma unroll
    for (int i = 0; i < 4; ++i) { const float keep = b0 ? a[2 * i + 1] : a[2 * i], send = b0 ? a[2 * i] : a[2 * i + 1]; b[i] = keep + __shfl_xor(send, 1); }
#pragma unroll
    for (int i = 0; i < 2; ++i) { const float keep = b1 ? b[2 * i + 1] : b[2 * i], send = b1 ? b[2 * i] : b[2 * i + 1]; c[i] = keep + __shfl_xor(send, 2); }
    float d = (b2 ? c[1] : c[0]) + __shfl_xor(b2 ? c[0] : c[1], 4);
    d += __shfl_xor(d, 8); d += __shfl_xor(d, 16); d += __shfl_xor(d, 32);
    return d;
}
template <bool FB>
__device__ __forceinline__ void norm_phase(LAS unsigned char* lds, const float* xin, const float* g, const float* shift0, const float* scale0, bf16_t* hout,
                                           const float* w_in_l, const float* b_forget_l, float* flog) {
    const int tid = tid_opaque(), lane = tid & 63, wid = tid >> 6;
    LAS float* wfb = (LAS float*)lds;
    if (FB) { for (int i = tid; i < 8 * D; i += 512) { const int d = i >> 3, e = i & 7; wfb[e * D + d] = w_in_l[(size_t)d * NIN + FB_SRC + e]; } __syncthreads(); }
    const int gw = blockIdx.x * 8 + wid, NGW = gridDim.x * 8;
    for (int rc = gw; rc < M / 4; rc += NGW) {
        const int row0 = rc * 4, b = row0 / SEQ;
        f32x4 v[4][4];
#pragma unroll
        for (int r = 0; r < 4; ++r) { const f32x4* xr = (const f32x4*)(xin + (size_t)(row0 + r) * D) + lane;
#pragma unroll
            for (int j = 0; j < 4; ++j) v[r][j] = xr[64 * j]; }
        f32x4 am[4], sh[4];
#pragma unroll
        for (int j = 0; j < 4; ++j) { const int d = 4 * lane + 256 * j; const f32x4 gv = *(const f32x4*)(g + d), sc = *(const f32x4*)(scale0 + (size_t)b * 6144 + d);
            am[j] = gv * (1.0f + sc); sh[j] = *(const f32x4*)(shift0 + (size_t)b * 6144 + d); }
        float ss[8];
#pragma unroll
        for (int r = 0; r < 4; ++r) { float s = 0.f;
#pragma unroll
            for (int j = 0; j < 4; ++j) s += (v[r][j].x * v[r][j].x + v[r][j].y * v[r][j].y) + (v[r][j].z * v[r][j].z + v[r][j].w * v[r][j].w);
            ss[r] = s; ss[r + 4] = 0.f; }
        const float tot = reduce8(ss, lane);
        const float rs = 1.0f / sqrtf(tot * (1.0f / D) + EPS);
#pragma unroll
        for (int r = 0; r < 4; ++r) { const float rstd = __uint_as_float(__builtin_amdgcn_readlane(__float_as_uint(rs), r));
            u32x2* o8 = (u32x2*)(hout + (size_t)(row0 + r) * D) + lane;
#pragma unroll
            for (int j = 0; j < 4; ++j) { v[r][j] = v[r][j] * rstd * am[j] + sh[j]; u32x2 w; w.x = cvt_pk_bf16(v[r][j].x, v[r][j].y); w.y = cvt_pk_bf16(v[r][j].z, v[r][j].w); o8[64 * j] = w; } }
        if (FB) {
            float pe[4][8];
#pragma unroll
            for (int e = 0; e < 8; ++e) { f32x4 wv[4];
#pragma unroll
                for (int j = 0; j < 4; ++j) wv[j] = *(LAS const f32x4*)(wfb + e * D + 4 * lane + 256 * j);
#pragma unroll
                for (int r = 0; r < 4; ++r) { float a = 0.f;
#pragma unroll
                    for (int j = 0; j < 4; ++j) a += (v[r][j].x * wv[j].x + v[r][j].y * wv[j].y) + (v[r][j].z * wv[j].z + v[r][j].w * wv[j].w);
                    pe[r][e] = a; } }
            const float bfv = b_forget_l[lane & 7];
#pragma unroll
            for (int r = 0; r < 4; ++r) { const float f = reduce8(pe[r], lane) + bfv; if (lane < 8) flog[(size_t)(row0 + r) * 8 + lane] = f; }
        }
    }
}
__device__ __forceinline__ void cumsum_lds(LAS unsigned char* lds, const float* flog, int b, int h) {
    const int tid = tid_opaque(), lane = tid & 63, wid = tid >> 6;
    LAS float* wt = (LAS float*)(lds + att::LDS_REL);
    LAS float* ckL = (LAS float*)(lds + att::LDS_CUM);
    float v[4]; float run = 0.f;
#pragma unroll
    for (int i = 0; i < 4; ++i) { const float f = flog[((size_t)b * SEQ + 4 * tid + i) * 8 + h];
        const float ls = fminf(f, 0.f) - log1pf(expf(-fabsf(f))); run += ls; v[i] = run; }
    float inc = run;
#pragma unroll
    for (int o = 1; o < 64; o <<= 1) { const float t = __shfl_up(inc, o); if (lane >= o) inc += t; }
    if (lane == 63) wt[wid] = inc;
    __syncthreads();
    float base = inc - run;
    for (int w8 = 0; w8 < wid; ++w8) base += wt[w8];
    f32x4 o4 = {(v[0] + base) * LOG2E, (v[1] + base) * LOG2E, (v[2] + base) * LOG2E, (v[3] + base) * LOG2E};
    *(LAS f32x4*)(ckL + 4 * tid) = o4;
    __syncthreads();
}
__device__ __forceinline__ void final_norm_phase(float* x, const float* g) {
    const int tid = tid_opaque(), lane = tid & 63, wid = tid >> 6;
    const int gw = blockIdx.x * 8 + wid, NGW = gridDim.x * 8;
    f32x4 gv[4];
#pragma unroll
    for (int j = 0; j < 4; ++j) gv[j] = *(const f32x4*)(g + 4 * lane + 256 * j);
    for (int row = gw; row < M; row += NGW) {
        f32x4* xr = (f32x4*)(x + (size_t)row * D) + lane;
        f32x4 v[4]; float s = 0.f;
#pragma unroll
        for (int j = 0; j < 4; ++j) { v[j] = xr[64 * j]; s += (v[j].x * v[j].x + v[j].y * v[j].y) + (v[j].z * v[j].z + v[j].w * v[j].w); }
        const float rstd = 1.0f / sqrtf(wave_sum(s) * (1.0f / D) + EPS);
#pragma unroll
        for (int j = 0; j < 4; ++j) xr[64 * j] = v[j] * rstd * gv[j];
    }
}


#define XB_TMO      128
#define XB_XCNT(j)  (256  + 64 * (j))
#define XB_XSUB(j)  (1280 + 64 * (j))
#define XB_XGEN(j)  (2304 + 64 * (j))
#define XB_TOP      3328
#define XB_TOPGEN   3392
#define XCD_BAR_WORDS 3456
#define XB_SPIN_CAP (1u << 18)
__device__ __forceinline__ unsigned xb_ld(unsigned* p)              { return __hip_atomic_load(p, __ATOMIC_RELAXED, __HIP_MEMORY_SCOPE_AGENT); }
__device__ __forceinline__ unsigned xb_add(unsigned* p, unsigned v) { return __hip_atomic_fetch_add(p, v, __ATOMIC_RELAXED, __HIP_MEMORY_SCOPE_AGENT); }
__device__ __forceinline__ unsigned xb_xcc_id() { return (unsigned)__builtin_amdgcn_s_getreg((3 << 11) | 20) & 0xFu; }
#define XB_SPIN(cond, bar) do { unsigned _sp = 0; while (cond) { __builtin_amdgcn_s_sleep(1); \
    if ((++_sp & 255u) == 0u) { if (xb_ld(&(bar)[XB_TMO])) break; if (_sp > XB_SPIN_CAP) { atomicAdd(&(bar)[XB_TMO], 1u); break; } } } } while (0)
__device__ __forceinline__ void xcd_barrier_complete(unsigned* bar, unsigned x, unsigned& nloc, unsigned& nx) {
    const unsigned G = gridDim.x * gridDim.y * gridDim.z;
    unsigned sum, cnt, mine, sp = 0u;
    for (;;) {
        sum = 0u; cnt = 0u; mine = 0u;
#pragma unroll
        for (unsigned j = 0; j < 16; ++j) { const unsigned c = xb_ld(&bar[XB_XCNT(j)]); sum += c; cnt += (c > 0u) ? 1u : 0u; mine = (j == x) ? c : mine; }
        if (sum == G) break;
        __builtin_amdgcn_s_sleep(1);
        if ((++sp & 255u) == 0u) { if (xb_ld(&bar[XB_TMO])) break; if (sp > XB_SPIN_CAP) { atomicAdd(&bar[XB_TMO], 1u); break; } }
    }
    nloc = mine > 0u ? mine : 1u; nx = cnt > 0u ? cnt : 1u;
}
__device__ __forceinline__ void xcd_barrier(unsigned* bar, volatile LAS unsigned* st) {
    asm volatile("s_waitcnt vmcnt(0)" ::: "memory");
    __syncthreads();
    if (threadIdx.x == 0) {
        const unsigned x = xb_xcc_id();
        __builtin_amdgcn_s_waitcnt(0);
        unsigned nloc = st[0], nx = st[1];
        if (nloc == 0u) { xcd_barrier_complete(bar, x, nloc, nx); st[0] = nloc; st[1] = nx; }
        const unsigned old = xb_add(&bar[XB_XSUB(x)], 1u);
        const unsigned gen = old / nloc;
        if (old + 1u == (gen + 1u) * nloc) {
            __builtin_amdgcn_fence(__ATOMIC_RELEASE, "agent");
            asm volatile("s_waitcnt vmcnt(0)" ::: "memory");
            const unsigned og = xb_add(&bar[XB_TOP], 1u);
            const unsigned tg = og / nx;
            if (og + 1u == (tg + 1u) * nx) xb_add(&bar[XB_TOPGEN], 1u);
            else XB_SPIN(xb_ld(&bar[XB_TOPGEN]) == tg, bar);
            __builtin_amdgcn_fence(__ATOMIC_ACQUIRE, "agent");
            xb_add(&bar[XB_XGEN(x)], 1u);
            asm volatile("s_waitcnt vmcnt(0)" ::: "memory");
        } else {
            XB_SPIN(xb_ld(&bar[XB_XGEN(x)]) == gen, bar);
            __builtin_amdgcn_fence(__ATOMIC_ACQUIRE, "agent");
            asm volatile("s_waitcnt vmcnt(0)" ::: "memory");
        }
    }
    __syncthreads();
}

constexpr int LDS_BYTES = 147456;
constexpr int N_PHASES = 20;
#ifndef PH_MASK
#define PH_MASK 0xFFFF
#endif
#define PHON(k) ((PH_MASK >> (k)) & 1)
struct Args { Ptrs p; float* out; unsigned char* ws; int ph_lo, ph_hi; };

__global__ void __launch_bounds__(512, 2) fwd_kernel(Args a) {
    extern __shared__ __attribute__((aligned(16))) unsigned char lds_raw[];
    LAS unsigned char* lds = (LAS unsigned char*)lds_raw;
    cg::grid_group grid = cg::this_grid();
    volatile LAS unsigned* bst = (volatile LAS unsigned*)(lds + LDS_BYTES - 128);
    if (threadIdx.x == 0) { bst[0] = 0u; bst[1] = 0u; }
    __syncthreads();
    const Ptrs& P = a.p;
#ifdef PROBE_MASK
    #define pst ((LAS unsigned long long*)(unsigned)(LDS_BYTES - 64))
    if (threadIdx.x == 0) { pst[0] = __builtin_amdgcn_s_memrealtime(); pst[1] = 0; pst[2] = 0; }
#define PROBE_KIND(p) ((p) == 0 ? 0 : ((p) == N_PHASES - 1 ? 10 : ((((p) - 1) % 9) == 0 ? 1 : ((((p) - 1) % 9) + 1))))
#define PROBE_STEP(p) do { if (threadIdx.x == 0) { const unsigned long long t_now = __builtin_amdgcn_s_memrealtime(); \
        if ((PROBE_MASK >> PROBE_KIND(p)) & 1) pst[1] += ((PROBE_MASK >> 16) & 1) ? (t_now - pst[2]) : (((PROBE_MASK >> 17) & 1) ? (pst[2] - pst[0]) : (t_now - pst[0])); pst[0] = t_now; } } while (0)
#endif
    if (a.ph_hi - a.ph_lo > 1) {
        if (blockIdx.x == 0) { unsigned* z = (unsigned*)(a.ws + WS_BAR); for (int i = threadIdx.x; i < (int)(WS_ZERO_BYTES / 4); i += 512) z[i] = 0u; }
        grid.sync();
        if (threadIdx.x == 0) xb_add(&((unsigned*)(a.ws + WS_BAR))[XB_XCNT(xb_xcc_id())], 1u);
    }
    const bool fuse_norm = (gridDim.x == 256) && (a.ph_hi - a.ph_lo > 1);
    for (int ph = a.ph_lo; ph < a.ph_hi; ++ph) {
        if (fuse_norm && (ph == N_PHASES - 1 || (ph >= 1 && (ph - 1) % 9 == 6) || ph == 10)) continue;
#ifdef PROBE_MASK
        if (ph > a.ph_lo && threadIdx.x == 0) pst[2] = __builtin_amdgcn_s_memrealtime();
#endif
        if (ph > a.ph_lo) xcd_barrier((unsigned*)(a.ws + WS_BAR), bst);
#ifdef PROBE_MASK
        if (ph > a.ph_lo) PROBE_STEP(ph - 1);
#endif
        unsigned char* ws = a.ws; float* outp = a.out; int G = gridDim.x, bx = blockIdx.x;
        asm volatile("" : "+s"(ws), "+s"(outp), "+s"(G), "+s"(bx));
        float* mod = (float*)(ws + WS_MOD); float* flog = (float*)(ws + WS_FLOG); const float* cumL = nullptr;
        bf16_t* hbuf = (bf16_t*)(ws + WS_H); bf16_t* proj = (bf16_t*)(ws + WS_PROJ); bf16_t* act = (bf16_t*)(ws + WS_PROJ);
        if (ph == 0) {
            if (PHON(9)) mod_phase(lds, P.c, P.w_ada, P.b_ada, mod); if (PHON(10)) convert_phase(lds, P, ws); continue; }
        if (ph == N_PHASES - 1) { if (PHON(11)) final_norm_phase(outp, P.final_norm_g); continue; }
        const int l = (ph - 1) / 9, sp = (ph - 1) % 9;
        const unsigned char* wl = ws + WS_W + (size_t)l * W_LAYER;
        const float* modl = mod + (size_t)l * 8 * 6144;
        const float* xin = l == 0 ? P.x : outp;
        switch (sp) {
        case 0: if (PHON(0)) norm_phase<false>(lds, xin, P.norm_mix_g + l * D, modl + 0 * D, modl + 1 * D, hbuf, nullptr, nullptr, nullptr); break;
        case 1: if (PHON(1)) {
            pg8::Gemm g{hbuf, (const bf16_t*)(wl + W_QKV), M, NQKVF, D, D}; pg8::StaticOrder S; S.init(M, NQKVF, G, bx);
            pg8::EpiQKV E{proj, flog, P.b_forget + l * 8}; pg8::gemm_phase(lds, g, S, E); } break;
        case 2: if (PHON(2)) {
            for (int v0 = bx; v0 < 256; v0 += G) {
                const int v = (G == 256) ? ((v0 & 7) * 32 + (v0 >> 3)) : v0;
                const int bh = v >> 2, j = v & 3, b = bh >> 3, h = bh & 7;
                cumsum_lds(lds, flog, b, h);
                {
                    LAS float* relX = (LAS float*)(lds + att::LDS_REL); const float* relh = P.rel_bias + l * 8 * 257 + h * 257;
                    for (int i = tid_opaque(); i < 321; i += 512) { const int jj = i - 64; relX[i] = relh[256 - (jj > 0 ? jj : 0)] * LOG2E; }
                    __syncthreads(); }
                const int tid_ = tid_opaque(), lane_ = tid_ & 63, wid_ = __builtin_amdgcn_readfirstlane(tid_ >> 6);
                const att::Src s1 = att::make_src(1, proj, b, h, j, lane_, wid_), s2 = att::make_src(2, proj, b, h, 2 * j, lane_, wid_), s3 = att::make_src(2, proj, b, h, 2 * j + 1, lane_, wid_),
                               s4 = att::make_src(0, proj, b, h, 2 * j, lane_, wid_), s5 = att::make_src(0, proj, b, h, 2 * j + 1, lane_, wid_);
                int cur = 0; bf16x8 qr[4];
                const float* sk = P.sinks + l * 8;
                att::unit<1>(lds, proj, sk, b, h, 7 - j, cur, false, true, s1, qr);
                att::unit<1>(lds, proj, sk, b, h, j, cur, true, true, s2, qr);
                att::unit<2>(lds, proj, sk, b, h, 2 * j, cur, true, true, s3, qr);
                att::unit<2>(lds, proj, sk, b, h, 2 * j + 1, cur, true, true, s4, qr);
                att::unit<0>(lds, proj, sk, b, h, 2 * j, cur, true, true, s5, qr);
                att::unit<0>(lds, proj, sk, b, h, 2 * j + 1, cur, true, false, s5, qr);
            } } break;
        case 3: if (PHON(3)) { pg8::Gemm g{hbuf, (const bf16_t*)(wl + W_G), M, NG, D, D}; pg8::StaticOrder S; S.init(M, NG, G, bx);
            pg8::EpiGate E{proj}; pg8::gemm_phase(lds, g, S, E); } break;
        case 4: if (PHON(4)) { pg8::Gemm g{proj, (const bf16_t*)(wl + W_BR), M, 3 * D, 512, PITCH}; pg8::BranchOrder S; S.so.init(M, D, G, bx);
            pg8::EpiBranch E{proj, hbuf}; pg8::gemm_phase(lds, g, S, E); } break;
        case 5: if (PHON(5)) { pg8::Gemm g{hbuf, (const bf16_t*)(wl + W_OUT), M, D, D, D}; pg8::StaticOrder S; S.init(M, D, G, bx);
            pg8::EpiRes E{xin, outp, modl + 2 * D, fuse_norm ? 1 : 0, (float*)(ws + WS_SLOT), (unsigned*)(ws + WS_CNT) + l * 4096, P.norm_ffn_g + l * D, modl + 3 * D, modl + 4 * D, hbuf};
            pg8::gemm_phase(lds, g, S, E); } break;
        case 6: if (PHON(6)) norm_phase<false>(lds, outp, P.norm_ffn_g + l * D, modl + 3 * D, modl + 4 * D, hbuf, nullptr, nullptr, nullptr); break;
        case 7: if (PHON(7)) { pg8::Gemm g{hbuf, (const bf16_t*)(wl + W_FI), M, FF2, D, D}; pg8::StaticOrder S; S.init(M, FF2, G, bx);
            pg8::EpiSwiglu E{act}; pg8::gemm_phase(lds, g, S, E); } break;
        case 8: if (PHON(8)) { pg8::Gemm g{act, (const bf16_t*)(wl + W_FO), M, D, FFH, FFH}; pg8::StaticOrder S; S.init(M, D, G, bx);
            const float* modn = mod + (size_t)(l + 1 < DEPTH ? l + 1 : l) * 8 * 6144;
            pg8::EpiRes E{outp, outp, modl + 5 * D, fuse_norm ? (l == DEPTH - 1 ? 2 : 1) : 0, (float*)(ws + WS_SLOT) + (size_t)M * 4, (unsigned*)(ws + WS_CNT) + (2 + l) * 4096,
                          l == DEPTH - 1 ? P.final_norm_g : P.norm_mix_g + (l + 1) * D, modn + 0 * D, modn + 1 * D, hbuf};
            pg8::gemm_phase(lds, g, S, E); } break;
        }
    }
#ifdef PROBE_MASK
    if (threadIdx.x == 0) pst[2] = __builtin_amdgcn_s_memrealtime();
    grid.sync();
    PROBE_STEP(N_PHASES - 1);
    __syncthreads();
    if (blockIdx.x == 0) { const int n = (int)((float)(unsigned)pst[1] * 0.15f); for (int i = threadIdx.x; i < n; i += 512) a.out[i] += 0.1f; }
#endif
}

extern "C" void kernel_launch(void* const* d_in, const int* in_sizes, int n_in, void* d_out, int out_size, void* d_ws, size_t ws_size, hipStream_t stream) {
    static int grid = 0;
    if (grid == 0) {
        if (n_in != 15 || out_size != M * D || ws_size < WS_END) { fprintf(stderr, "kernel_launch: unexpected shapes (n_in %d out %d ws %zu)\n", n_in, out_size, ws_size); grid = -1; return; }
        int dev = 0, cus = 0, per_cu = 0;
        hipGetDevice(&dev); hipDeviceGetAttribute(&cus, hipDeviceAttributeMultiprocessorCount, dev);
        if (hipFuncSetAttribute((const void*)fwd_kernel, hipFuncAttributeMaxDynamicSharedMemorySize, LDS_BYTES) != hipSuccess) { fprintf(stderr, "kernel_launch: hipFuncSetAttribute failed\n"); grid = -1; return; }
        if (hipOccupancyMaxActiveBlocksPerMultiprocessor(&per_cu, (const void*)fwd_kernel, 512, LDS_BYTES) != hipSuccess || per_cu < 1) { fprintf(stderr, "kernel_launch: occupancy query gave %d\n", per_cu); per_cu = 1; }
        (void)hipGetLastError();
        grid = cus * (per_cu > 1 ? 1 : per_cu);
        if (grid > 256) grid = 256;
    }
    if (grid < 0) return;
    Args a{};
    const float** pp = (const float**)&a.p;
    for (int i = 0; i < 15; ++i) pp[i] = (const float*)d_in[i];
    a.out = (float*)d_out; a.ws = (unsigned char*)d_ws;
#if N_LAUNCH_MODE
    for (int ph = 0; ph < N_PHASES; ++ph) { a.ph_lo = ph; a.ph_hi = ph + 1; hipLaunchKernelGGL(fwd_kernel, dim3(grid), dim3(512), LDS_BYTES, stream, a); }
#else
    a.ph_lo = 0; a.ph_hi = N_PHASES;
    void* args[] = {&a};
    hipError_t e = hipLaunchCooperativeKernel((const void*)fwd_kernel, dim3(grid), dim3(512), args, LDS_BYTES, stream);
    if (e != hipSuccess) fprintf(stderr, "cooperative launch failed: %s (grid %d)\n", hipGetErrorString(e), grid);
#endif
}
```

```cpp
#include <hip/hip_runtime.h>
#include <hip/hip_cooperative_groups.h>
#include <cstdio>
#include <cstdint>
namespace cg = cooperative_groups;

#ifndef N_LAUNCH_MODE
#define N_LAUNCH_MODE 0
#endif

#define LAS __attribute__((address_space(3)))
typedef unsigned short bf16_t;
typedef short bf16x8 __attribute__((ext_vector_type(8)));
typedef short s16x4 __attribute__((ext_vector_type(4)));
typedef float f32x4 __attribute__((ext_vector_type(4)));
typedef float f32x16 __attribute__((ext_vector_type(16)));
typedef unsigned u32x4 __attribute__((ext_vector_type(4)));
typedef unsigned u32x2 __attribute__((ext_vector_type(2)));

constexpr int BATCH = 8, SEQ = 2048, D = 1024, M = BATCH * SEQ, DEPTH = 2;
constexpr int NIN = 6920, FFH = 2816, FF2 = 2 * FFH;
constexpr int PITCH = 4608;
constexpr int NQKV = 3840, NQKVF = 4096, NG = 3072;
constexpr int FB_SRC = 2304;
constexpr int G_SRC = 3848;
constexpr float EPS = 1e-6f;
constexpr float LOG2E = 1.4426950408889634f;

constexpr size_t MiB = 1u << 20;
constexpr size_t WS_MOD = 0;
constexpr size_t WS_FLOG = 512 * 1024;
constexpr size_t WS_BAR = 1536 * 1024;
constexpr size_t WS_CNT = WS_BAR + 16384;
constexpr size_t WS_ZERO_BYTES = 16384 + 4 * 16384;
constexpr size_t WS_SLOT = 1024 * 1024;
constexpr size_t WS_W = 2 * MiB;
constexpr size_t W_QKV = 0, W_G = W_QKV + (size_t)NQKVF * D * 2, W_BR = W_G + (size_t)NG * D * 2, W_OUT = W_BR + (size_t)3 * D * 512 * 2,
                 W_FI = W_OUT + (size_t)D * D * 2, W_FO = W_FI + (size_t)FF2 * D * 2, W_LAYER = W_FO + (size_t)D * FFH * 2;
static_assert(W_LAYER == 35 * MiB + 512 * 1024, "weights per layer");
constexpr size_t WS_H = WS_W + 2 * W_LAYER;
constexpr size_t WS_PROJ = WS_H + (size_t)M * D * 2;
constexpr size_t WS_END = WS_PROJ + (size_t)M * PITCH * 2;
static_assert(WS_END <= 256 * MiB, "workspace");

constexpr int QA = 0, KA = 512, VA = 640, QB_ = 768, KB_ = 1280, VB_ = 1792, QC_ = 2304, KC_ = 2816, VC_ = 3328;
__host__ __device__ __forceinline__ int gate_col(int j) {
    return j == 0 ? 512 : (j < 4 ? 3840 + 256 * (j - 1) : (j < 8 ? 1280 + 256 * (j - 4) : 2816 + 256 * (j - 8)));
}

__device__ __forceinline__ unsigned cvt_pk_bf16(float lo, float hi) { unsigned r; asm volatile("v_cvt_pk_bf16_f32 %0, %1, %2" : "=v"(r) : "v"(lo), "v"(hi)); return r; }
__device__ __forceinline__ float bf_lo(unsigned w) { return __uint_as_float(w << 16); }
__device__ __forceinline__ float bf_hi(unsigned w) { return __uint_as_float(w & 0xffff0000u); }
__device__ __forceinline__ float wave_sum(float v) {
#pragma unroll
    for (int o = 1; o < 64; o <<= 1) v += __shfl_xor(v, o);
    return v;
}
__device__ __forceinline__ int tid_opaque() { int t = threadIdx.x; asm volatile("" : "+v"(t)); return t; }
__device__ __forceinline__ float sigmoidf_(float x) { return __builtin_amdgcn_rcpf(1.0f + __builtin_amdgcn_exp2f(-LOG2E * x)); }

__device__ __forceinline__ float reduce8(const float (&a)[8], int lane);
namespace pg8 {
constexpr int BM = 256, BK = 64, HALF = 128, HTB = HALF * BK * 2, STAGE_BYTES = 8 * HTB, NXCD = 8, WGM = 8;
__host__ __device__ __forceinline__ int lds_byte(int r, int c) { const int st = (r >> 4) * 2 + (c >> 5), rr = r & 15, cc = c & 31, ob = rr * 64 + cc * 2; return st * 1024 + (ob ^ (((ob >> 9) & 1) << 5)); }
__host__ __device__ __forceinline__ void stage_rc(int b, int& R, int& C) { const int st = b / 1024, sb = b % 1024, swz = sb ^ (((sb >> 9) & 1) << 5); R = (st >> 1) * 16 + swz / 64; C = (st & 1) * 32 + (swz % 64) / 2; }
__host__ __device__ __forceinline__ int perm32(int rho) { const int n = rho >> 4, i = rho & 15; return 8 * (i >> 2) + 4 * n + (i & 3); }

struct Unit { int pm, pn, k; };
struct Gemm { const bf16_t* A; const bf16_t* Bt; int M, N, K, lda; };

struct StaticOrder {
    int nM, nN, nwg, G, c;
    __device__ void init(int M_, int N_, int G_, int c_) { nM = M_ / BM; nN = N_ / BM; nwg = nM * nN; G = G_; c = c_; }
    __device__ __forceinline__ bool tile(int i, int& pm, int& pn) const {
        const long L = (long)i * G + c; if (L >= nwg) return false;
        int wgid = (int)L; { const int q = nwg / NXCD, r = nwg % NXCD, xcd = wgid % NXCD, off = wgid / NXCD; wgid = (xcd < r ? xcd * (q + 1) : r * (q + 1) + (xcd - r) * q) + off; }
        const int nig = WGM * nN, gid = wgid / nig, fm = gid * WGM, gsz = (nM - fm) < WGM ? (nM - fm) : WGM;
        pm = fm + ((wgid % nig) % gsz); pn = (wgid % nig) / gsz; return true;
    }
    __device__ __forceinline__ bool next(int i, Unit& u) const { u.k = 0; return tile(i, u.pm, u.pn); }
    __device__ __forceinline__ size_t a_off(const Unit&) const { return 0; }
};
struct BranchOrder {
    StaticOrder so;
    __device__ __forceinline__ bool next(int i, Unit& u) const { int pm, cn; if (!so.tile(i / 3, pm, cn)) return false; u.k = i % 3; u.pm = pm; u.pn = 4 * u.k + cn; return true; }
    __device__ __forceinline__ size_t a_off(const Unit& u) const { return (size_t)(u.k == 0 ? QA : (u.k == 1 ? QB_ : QC_)) * 2; }
};

struct EpiQKV {
    static constexpr bool PERM = true, AFTER_DRAIN = false;
    bf16_t* O; float* flog; const float* bfg;
    __device__ __forceinline__ bool keep(const Unit&) const { return false; }
    __device__ __forceinline__ void operator()(f32x4 (&acc)[2][2][4][2], const Unit& u, int wr, int wc, int fr, int fq) const {
        if (u.pn == 15) {
            if (wc == 0 && fq == 0) {
                const f32x4 b0 = *(const f32x4*)(bfg), b1 = *(const f32x4*)(bfg + 4);
#pragma unroll
                for (int ai = 0; ai < 2; ++ai)
#pragma unroll
                    for (int m = 0; m < 4; ++m) { float* fp = flog + (size_t)(u.pm * BM + ai * HALF + wr * 64 + m * 16 + fr) * 8;
                        *(f32x4*)fp = acc[ai][0][m][0] + b0; *(f32x4*)(fp + 4) = acc[ai][0][m][1] + b1; }
            }
            return;
        }
        const int row0 = u.pm * BM + wr * 64 + fr, col0 = u.pn * BM + wc * 32 + 8 * fq;
        const bool isq = (u.pn < 2) || (u.pn == 3) || (u.pn == 4) || (u.pn == 9) || (u.pn == 10);
        const float qs = isq ? 0.125f * LOG2E : 1.0f;
#pragma unroll
        for (int ai = 0; ai < 2; ++ai)
#pragma unroll
            for (int m = 0; m < 4; ++m) { bf16_t* rowp = O + (size_t)(row0 + ai * HALF + m * 16) * PITCH + col0;
#pragma unroll
                for (int bj = 0; bj < 2; ++bj) { const f32x4 v0 = acc[ai][bj][m][0] * qs, v1 = acc[ai][bj][m][1] * qs;
                    u32x4 w; w.x = cvt_pk_bf16(v0[0], v0[1]); w.y = cvt_pk_bf16(v0[2], v0[3]); w.z = cvt_pk_bf16(v1[0], v1[1]); w.w = cvt_pk_bf16(v1[2], v1[3]);
                    *(u32x4*)(rowp + bj * HALF) = w; } }
    }
};
struct EpiGate {
    static constexpr bool PERM = true, AFTER_DRAIN = false;
    bf16_t* O;
    __device__ __forceinline__ bool keep(const Unit&) const { return false; }
    __device__ __forceinline__ void operator()(f32x4 (&acc)[2][2][4][2], const Unit& u, int wr, int wc, int fr, int fq) const {
        const int row0 = u.pm * BM + wr * 64 + fr, col0 = gate_col(u.pn) + wc * 32 + 8 * fq;
#pragma unroll
        for (int ai = 0; ai < 2; ++ai)
#pragma unroll
            for (int m = 0; m < 4; ++m) { bf16_t* rowp = O + (size_t)(row0 + ai * HALF + m * 16) * PITCH + col0;
#pragma unroll
                for (int bj = 0; bj < 2; ++bj) { f32x4 v0 = acc[ai][bj][m][0], v1 = acc[ai][bj][m][1];
#pragma unroll
                    for (int i = 0; i < 4; ++i) { v0[i] = fmaxf(sigmoidf_(v0[i]), 1e-6f); v1[i] = fmaxf(sigmoidf_(v1[i]), 1e-6f); }
                    u32x4 w; w.x = cvt_pk_bf16(v0[0], v0[1]); w.y = cvt_pk_bf16(v0[2], v0[3]); w.z = cvt_pk_bf16(v1[0], v1[1]); w.w = cvt_pk_bf16(v1[2], v1[3]);
                    *(u32x4*)(rowp + bj * HALF) = w; } }
    }
};
struct EpiBranch {
    static constexpr bool PERM = true, AFTER_DRAIN = false;
    const bf16_t* P; bf16_t* O;
    __device__ __forceinline__ bool keep(const Unit& u) const { return u.k < 2; }
    __device__ __forceinline__ void operator()(f32x4 (&acc)[2][2][4][2], const Unit& u, int wr, int wc, int fr, int fq) const {
        const int cn = u.pn & 3, k = u.k;
        const int row0 = u.pm * BM + wr * 64 + fr, cofs = wc * 32 + 8 * fq;
        const int gc0 = gate_col(4 * k + cn) + cofs, gc1 = gate_col(4 * (k < 2 ? k + 1 : 2) + cn) + cofs;
#pragma unroll
        for (int ai = 0; ai < 2; ++ai)
#pragma unroll
            for (int m = 0; m < 4; ++m) { const size_t ro = (size_t)(row0 + ai * HALF + m * 16);
#pragma unroll
                for (int bj = 0; bj < 2; ++bj) {
                    const u32x4 ga = *(const u32x4*)(P + ro * PITCH + gc0 + bj * HALF);
                    float s[8] = {bf_lo(ga.x), bf_hi(ga.x), bf_lo(ga.y), bf_hi(ga.y), bf_lo(ga.z), bf_hi(ga.z), bf_lo(ga.w), bf_hi(ga.w)};
                    if (k < 2) { const u32x4 gb = *(const u32x4*)(P + ro * PITCH + gc1 + bj * HALF);
                        const float t[8] = {bf_lo(gb.x), bf_hi(gb.x), bf_lo(gb.y), bf_hi(gb.y), bf_lo(gb.z), bf_hi(gb.z), bf_lo(gb.w), bf_hi(gb.w)};
#pragma unroll
                        for (int i = 0; i < 8; ++i) s[i] = s[i] * __builtin_amdgcn_rcpf(t[i]); }
                    f32x4 v0 = acc[ai][bj][m][0], v1 = acc[ai][bj][m][1];
#pragma unroll
                    for (int i = 0; i < 4; ++i) { v0[i] *= s[i]; v1[i] *= s[4 + i]; }
                    if (k < 2) { acc[ai][bj][m][0] = v0; acc[ai][bj][m][1] = v1; }
                    else { u32x4 w; w.x = cvt_pk_bf16(v0[0], v0[1]); w.y = cvt_pk_bf16(v0[2], v0[3]); w.z = cvt_pk_bf16(v1[0], v1[1]); w.w = cvt_pk_bf16(v1[2], v1[3]);
                        *(u32x4*)(O + ro * D + cn * BM + cofs + bj * HALF) = w; } } }
    }
};
struct EpiRes {
    static constexpr bool PERM = false, AFTER_DRAIN = true;
    __device__ __forceinline__ void fused(f32x4 (&acc)[2][2][4][2], const Unit& u, int wr, int wc, int fr, int fq, LAS unsigned char* lds, int wid, int lane) const {
        constexpr int TP = 260;
        LAS float* T = (LAS float*)lds;
        const int b = u.pm >> 3, colg = u.pn * BM + 4 * lane;
        const f32x4 gg = *(const f32x4*)(gmod + (size_t)b * 6144 + colg);
        f32x4 xk[32];
#pragma unroll
        for (int ai = 0; ai < 2; ++ai) {
#pragma unroll
            for (int m = 0; m < 4; ++m)
#pragma unroll
                for (int bj = 0; bj < 2; ++bj)
#pragma unroll
                    for (int n = 0; n < 2; ++n) *(LAS f32x4*)(T + (wr * 64 + m * 16 + fr) * TP + bj * HALF + wc * 32 + n * 16 + 4 * fq) = acc[ai][bj][m][n];
            asm volatile("s_waitcnt lgkmcnt(0)" ::: "memory"); __builtin_amdgcn_s_barrier(); asm volatile("" ::: "memory");
#pragma unroll
            for (int hb = 0; hb < 2; ++hb) { f32x4 bs[8]; float ss[8];
#pragma unroll
                for (int rr = 0; rr < 8; ++rr) { const int rl = wid + 8 * (hb * 8 + rr); bs[rr] = __builtin_nontemporal_load((const f32x4*)(base + (size_t)(u.pm * BM + ai * HALF + rl) * D + colg)); }
#pragma unroll
                for (int rr = 0; rr < 8; ++rr) { const int rl = wid + 8 * (hb * 8 + rr); const f32x4 v = *(LAS const f32x4*)(T + rl * TP + 4 * lane);
                    const f32x4 o = bs[rr] + gg * v; ss[rr] = (o.x * o.x + o.y * o.y) + (o.z * o.z + o.w * o.w);
                    xk[ai * 16 + hb * 8 + rr] = o;
                    if (mode != 2) *(f32x4*)(out + (size_t)(u.pm * BM + ai * HALF + rl) * D + colg) = o; }
                if (mode != 0) {
                    const float tot = reduce8(ss, lane);
                    if (lane < 8) { const int rl = wid + 8 * (hb * 8 + lane);
                        __hip_atomic_store(slots + (size_t)(u.pm * BM + ai * HALF + rl) * 4 + u.pn, tot, __ATOMIC_RELAXED, __HIP_MEMORY_SCOPE_AGENT); }
                } }
            asm volatile("s_waitcnt lgkmcnt(0)" ::: "memory"); __builtin_amdgcn_s_barrier(); asm volatile("" ::: "memory");
        }
        if (mode == 0) return;
        asm volatile("s_waitcnt vmcnt(0)" ::: "memory");
        unsigned* pc = cnt + 64 * u.pm;
        if (lane == 0) __hip_atomic_fetch_add(pc, 1u, __ATOMIC_RELAXED, __HIP_MEMORY_SCOPE_AGENT);
        if (wid == 0) {
            unsigned sp = 0;
            while ((unsigned)__builtin_amdgcn_readfirstlane(__hip_atomic_load(pc, __ATOMIC_RELAXED, __HIP_MEMORY_SCOPE_AGENT)) < 32u) { __builtin_amdgcn_s_sleep(2); if (++sp > (1u << 18)) break; }
            __builtin_amdgcn_fence(__ATOMIC_ACQUIRE, "agent");
        }
        asm volatile("s_waitcnt vmcnt(0) lgkmcnt(0)" ::: "memory"); __builtin_amdgcn_s_barrier(); asm volatile("" ::: "memory");
        float rs;
        { const int k = lane & 31, rl = wid + 8 * (k & 15); const float* sl = slots + (size_t)(u.pm * BM + (k >> 4) * HALF + rl) * 4;
          const float t = (__hip_atomic_load(sl + 0, __ATOMIC_RELAXED, __HIP_MEMORY_SCOPE_AGENT) + __hip_atomic_load(sl + 1, __ATOMIC_RELAXED, __HIP_MEMORY_SCOPE_AGENT))
                        + (__hip_atomic_load(sl + 2, __ATOMIC_RELAXED, __HIP_MEMORY_SCOPE_AGENT) + __hip_atomic_load(sl + 3, __ATOMIC_RELAXED, __HIP_MEMORY_SCOPE_AGENT));
          rs = 1.0f / sqrtf(t * (1.0f / D) + EPS); }
        f32x4 am, sh;
        { const f32x4 gv = *(const f32x4*)(ng + colg);
          if (mode == 1) { am = gv * (1.0f + *(const f32x4*)(nscale + (size_t)b * 6144 + colg)); sh = *(const f32x4*)(nshift + (size_t)b * 6144 + colg); }
          else { am = gv; sh = (f32x4){0.f, 0.f, 0.f, 0.f}; } }
#pragma unroll
        for (int kb = 0; kb < 4; ++kb) {
#pragma unroll
            for (int rr = 0; rr < 8; ++rr) { const int k = kb * 8 + rr, rl = wid + 8 * (k & 15); const size_t ro = (size_t)(u.pm * BM + (k >> 4) * HALF + rl);
                const float rstd = __uint_as_float(__builtin_amdgcn_readlane(__float_as_uint(rs), k));
                const f32x4 hv = xk[k] * rstd * am + sh;
                if (mode == 1) { u32x2 w; w.x = cvt_pk_bf16(hv.x, hv.y); w.y = cvt_pk_bf16(hv.z, hv.w); *(u32x2*)(hn + ro * D + colg) = w; }
                else *(f32x4*)(out + ro * D + colg) = hv; } }
    }
    const float* base; float* out; const float* gmod;
    int mode; float* slots; unsigned* cnt; const float* ng; const float* nshift; const float* nscale; bf16_t* hn;
    __device__ __forceinline__ bool keep(const Unit&) const { return false; }
    __device__ __forceinline__ void operator()(f32x4 (&acc)[2][2][4][2], const Unit& u, int wr, int wc, int fr, int fq) const {
        const int b = u.pm >> 3;
        const int col0 = u.pn * BM + wc * 32 + 4 * fq;
        const float* gv = gmod + (size_t)b * 6144 + col0;
        f32x4 gg[2][2];
#pragma unroll
        for (int bj = 0; bj < 2; ++bj)
#pragma unroll
            for (int n = 0; n < 2; ++n) gg[bj][n] = *(const f32x4*)(gv + bj * HALF + n * 16);
#pragma unroll
        for (int ai = 0; ai < 2; ++ai)
#pragma unroll
            for (int m = 0; m < 4; ++m) { const size_t off = (size_t)(u.pm * BM + ai * HALF + wr * 64 + m * 16 + fr) * D + col0;
#pragma unroll
                for (int bj = 0; bj < 2; ++bj)
#pragma unroll
                    for (int n = 0; n < 2; ++n) { const f32x4 bs = *(const f32x4*)(base + off + bj * HALF + n * 16);
                        *(f32x4*)(out + off + bj * HALF + n * 16) = bs + gg[bj][n] * acc[ai][bj][m][n]; } }
    }
};
struct EpiSwiglu {
    static constexpr bool PERM = true, AFTER_DRAIN = false;
    bf16_t* O;
    __device__ __forceinline__ bool keep(const Unit&) const { return false; }
    __device__ __forceinline__ void operator()(f32x4 (&acc)[2][2][4][2], const Unit& u, int wr, int wc, int fr, int fq) const {
        const int row0 = u.pm * BM + wr * 64 + fr, col0 = u.pn * HALF + wc * 32 + 8 * fq;
#pragma unroll
        for (int ai = 0; ai < 2; ++ai)
#pragma unroll
            for (int m = 0; m < 4; ++m) { bf16_t* rowp = O + (size_t)(row0 + ai * HALF + m * 16) * FFH + col0;
                f32x4 r0, r1;
#pragma unroll
                for (int i = 0; i < 4; ++i) { const float g0 = acc[ai][0][m][0][i], g1 = acc[ai][0][m][1][i];
                    r0[i] = g0 * sigmoidf_(g0) * acc[ai][1][m][0][i]; r1[i] = g1 * sigmoidf_(g1) * acc[ai][1][m][1][i]; }
                u32x4 w; w.x = cvt_pk_bf16(r0[0], r0[1]); w.y = cvt_pk_bf16(r0[2], r0[3]); w.z = cvt_pk_bf16(r1[0], r1[1]); w.w = cvt_pk_bf16(r1[2], r1[3]);
                *(u32x4*)rowp = w; }
    }
};

template <class Epi, class Sched>
__device__ __forceinline__ void gemm_phase(LAS unsigned char* lds, const Gemm g, const Sched& S, const Epi& E) {
    const int tid = tid_opaque(), wid = __builtin_amdgcn_readfirstlane(tid >> 6), lane = tid & 63, wr = wid >> 2, wc = wid & 3, fr = lane & 15, fq = lane >> 4;
    const int K = g.K, nt = K / BK, lda = g.lda;
    unsigned voffA[2], voffB[2];
#pragma unroll
    for (int i = 0; i < 2; ++i) { int R, C; stage_rc(tid * 16 + i * 8192, R, C); const int Rb = Epi::PERM ? ((R & ~31) + perm32(R & 31)) : R;
        voffA[i] = (unsigned)(R * lda + C) * 2u; voffB[i] = (unsigned)(Rb * K + C) * 2u; }
    const size_t kstep = (size_t)(BK * 2);
    const size_t hstepA = (size_t)HALF * lda * 2, hstepB = (size_t)HALF * K * 2;
    const size_t tstepA = 2 * hstepA, tstepB = 2 * hstepB;
    const unsigned ldsw = (unsigned)wid * 1024u;
    const int aoff = lds_byte(wr * 64 + fr, fq * 8), boff = lds_byte(wc * 32 + fr, fq * 8);
#define PG8_SA(b, h) (((b) * 2 + (h)) * HTB)
#define PG8_SB(b, h) ((4 + (b) * 2 + (h)) * HTB)
#define PG8_STAGE(bufoff, gbase, voff) do { _Pragma("unroll") for (int _i = 0; _i < 2; ++_i) \
        __builtin_amdgcn_global_load_lds((const unsigned*)((const char*)(gbase) + (voff)[_i]), (LAS unsigned*)(lds + (bufoff) + ldsw + _i * 8192), 16, 0, 0); } while (0)
#define PG8_LDA(dst, b, h) do { _Pragma("unroll") for (int m = 0; m < 4; ++m) _Pragma("unroll") for (int k = 0; k < 2; ++k) dst[m][k] = *(const LAS bf16x8*)(lds + PG8_SA(b, h) + aoff + m * 2048 + k * 1024); } while (0)
#define PG8_LDB(dst, b, h) do { _Pragma("unroll") for (int n = 0; n < 2; ++n) _Pragma("unroll") for (int k = 0; k < 2; ++k) dst[n][k] = *(const LAS bf16x8*)(lds + PG8_SB(b, h) + boff + n * 2048 + k * 1024); } while (0)
#define PG8_MMA(ai, bj, At, Bt) do { __builtin_amdgcn_s_setprio(1); _Pragma("unroll") for (int m = 0; m < 4; ++m) _Pragma("unroll") for (int n = 0; n < 2; ++n) _Pragma("unroll") for (int k = 0; k < 2; ++k) \
        acc[ai][bj][m][n] = __builtin_amdgcn_mfma_f32_16x16x32_bf16(Bt[n][k], At[m][k], acc[ai][bj][m][n], 0, 0, 0); __builtin_amdgcn_s_setprio(0); } while (0)
#define PG8_WAIT_V(n) asm volatile("s_waitcnt vmcnt(" #n ")" ::: "memory")
#define PG8_WAIT_L(n) asm volatile("s_waitcnt lgkmcnt(" #n ")" ::: "memory")
#define PG8_BAR __builtin_amdgcn_s_barrier()
#define PG8_SCHED __builtin_amdgcn_sched_barrier(0)
    Unit cur, nxt; int ui = 0;
    if (!S.next(0, cur)) return;
    f32x4 acc[2][2][4][2];
#pragma unroll
    for (int a = 0; a < 2; ++a)
#pragma unroll
        for (int b = 0; b < 2; ++b)
#pragma unroll
            for (int m = 0; m < 4; ++m)
#pragma unroll
                for (int n = 0; n < 2; ++n) acc[a][b][m][n] = (f32x4){0.f, 0.f, 0.f, 0.f};
    bf16x8 At[4][2], B0[2][2], B1[2][2];
    const char* cA = (const char*)g.A + S.a_off(cur) + (size_t)cur.pm * tstepA; const char* cB = (const char*)g.Bt + (size_t)cur.pn * tstepB;
    PG8_STAGE(PG8_SB(0, 0), cB, voffB); PG8_STAGE(PG8_SB(0, 1), cB + hstepB, voffB); PG8_STAGE(PG8_SA(0, 0), cA, voffA); PG8_STAGE(PG8_SA(0, 1), cA + hstepA, voffA);
    if (wr == 1) PG8_BAR;
    PG8_WAIT_V(2); PG8_BAR;
    PG8_STAGE(PG8_SB(1, 0), cB + kstep, voffB); PG8_STAGE(PG8_SA(1, 0), cA + kstep, voffA); PG8_STAGE(PG8_SB(1, 1), cB + hstepB + kstep, voffB);
    PG8_WAIT_V(6); PG8_BAR;
    for (;;) {
        const bool has_next = S.next(ui + 1, nxt);
        const char* nA = has_next ? (const char*)g.A + S.a_off(nxt) + (size_t)nxt.pm * tstepA : cA; const char* nB = has_next ? (const char*)g.Bt + (size_t)nxt.pn * tstepB : cB;
        for (int t = 0; t < nt; t += 2) {
            const bool last = (t == nt - 2);
            const char* a1 = cA + (size_t)(t + 1) * kstep;
            const char* a2 = last ? nA : cA + (size_t)(t + 2) * kstep; const char* b2 = last ? nB : cB + (size_t)(t + 2) * kstep;
            const char* a3 = a2 + kstep; const char* b3 = b2 + kstep;
            PG8_LDB(B0, 0, 0); PG8_LDB(B1, 0, 1); PG8_SCHED; PG8_LDA(At, 0, 0); PG8_STAGE(PG8_SA(1, 1), a1 + hstepA, voffA);
            PG8_WAIT_V(8); PG8_WAIT_L(0); PG8_BAR; PG8_MMA(0, 0, At, B0); PG8_MMA(0, 1, At, B1); PG8_BAR; PG8_SCHED;
            PG8_LDA(At, 0, 1); PG8_STAGE(PG8_SB(0, 0), b2, voffB); PG8_STAGE(PG8_SB(0, 1), b2 + hstepB, voffB); PG8_STAGE(PG8_SA(0, 0), a2, voffA);
            PG8_WAIT_V(8); PG8_WAIT_L(0); PG8_BAR; PG8_MMA(1, 0, At, B0); PG8_MMA(1, 1, At, B1); PG8_BAR; PG8_SCHED;
            PG8_LDB(B0, 1, 0); PG8_LDB(B1, 1, 1); PG8_SCHED; PG8_LDA(At, 1, 0); PG8_STAGE(PG8_SA(0, 1), a2 + hstepA, voffA);
            PG8_WAIT_V(8); PG8_WAIT_L(0); PG8_BAR; PG8_MMA(0, 0, At, B0); PG8_MMA(0, 1, At, B1); PG8_BAR; PG8_SCHED;
            PG8_LDA(At, 1, 1); PG8_STAGE(PG8_SB(1, 0), b3, voffB); PG8_STAGE(PG8_SB(1, 1), b3 + hstepB, voffB); PG8_STAGE(PG8_SA(1, 0), a3, voffA);
            PG8_WAIT_V(8); PG8_WAIT_L(0); PG8_BAR; PG8_MMA(1, 0, At, B0); PG8_MMA(1, 1, At, B1); PG8_BAR; PG8_SCHED;
        }
        if (wr == 0) PG8_BAR;
        if (!(Epi::AFTER_DRAIN && !has_next)) E(acc, cur, wr, wc, fr, fq);
        if (!has_next) break;
        if (!E.keep(cur)) {
#pragma unroll
            for (int a = 0; a < 2; ++a)
#pragma unroll
                for (int b = 0; b < 2; ++b)
#pragma unroll
                    for (int m = 0; m < 4; ++m)
#pragma unroll
                        for (int n = 0; n < 2; ++n) acc[a][b][m][n] = (f32x4){0.f, 0.f, 0.f, 0.f};
        }
        cur = nxt; cA = nA; cB = nB; ++ui;
        if (wr == 1) PG8_BAR;
    }
    PG8_WAIT_V(0);
    PG8_BAR;
    if constexpr (Epi::AFTER_DRAIN) E.fused(acc, cur, wr, wc, fr, fq, lds, wid, lane);
#undef PG8_SA
#undef PG8_SB
#undef PG8_STAGE
#undef PG8_LDA
#undef PG8_LDB
#undef PG8_MMA
#undef PG8_WAIT_V
#undef PG8_WAIT_L
#undef PG8_BAR
#undef PG8_SCHED
}
}

namespace att {
typedef short v4i16_t __attribute__((ext_vector_type(4)));
__device__ __forceinline__ int crow(int r, int hi) { return (r & 3) + 8 * (r >> 2) + 4 * hi; }
__device__ __forceinline__ s16x4 vtr(LAS const unsigned char* p) { return __builtin_bit_cast(s16x4, __builtin_amdgcn_ds_read_tr16_b64_v4i16((LAS v4i16_t*)p)); }
constexpr float C2 = 0.125f * LOG2E;
constexpr float NEG = -1e30f;
constexpr int LDS_K = 0, LDS_V = 32768, LDS_REL = 65536, LDS_CUM = 69632;

__device__ __forceinline__ float max3f(float a, float b, float c) { return __builtin_fmaxf(__builtin_fmaxf(a, b), c); }
constexpr float THR = 8.0f;
template <int VAR>
__device__ __forceinline__ void tile(LAS unsigned char* lds, int cur, int kt, int dk, const bf16x8 (&qr)[4], float& mref, float& lrow, f32x16& o0, f32x16& o1, f32x16& negm, bool& first,
                                     LAS float* relX, LAS float* ckL, float slopeL, const f32x16& kf0, const int (&koff)[4], int qloc, int hi, int r32, int lane) {
            LAS const unsigned char* kp = lds + LDS_K + cur * 8192 + r32 * 128;
            f32x16 p0, p1;
            __builtin_amdgcn_s_setprio(1);
#pragma unroll
            for (int d0 = 0; d0 < 4; ++d0) {
                const bf16x8 k0 = *(LAS const bf16x8*)(kp + koff[d0]), k1 = *(LAS const bf16x8*)(kp + 4096 + koff[d0]);
                if (d0 == 0) { p0 = __builtin_amdgcn_mfma_f32_32x32x16_bf16(k0, qr[0], negm, 0, 0, 0); p1 = __builtin_amdgcn_mfma_f32_32x32x16_bf16(k1, qr[0], negm, 0, 0, 0); }
                else { p0 = __builtin_amdgcn_mfma_f32_32x32x16_bf16(k0, qr[d0], p0, 0, 0, 0); p1 = __builtin_amdgcn_mfma_f32_32x32x16_bf16(k1, qr[d0], p1, 0, 0, 0); }
            }
            __builtin_amdgcn_s_setprio(0);
            if (VAR == 0) {
                const float dqf = (float)(64 * dk + qloc);
                const f32x16 d0v = dqf - kf0, d1v = d0v - 32.0f;
#pragma unroll
                for (int r = 0; r < 16; ++r) { p0[r] = __builtin_fmaf(-slopeL, __builtin_fabsf(d0v[r]), p0[r]); p1[r] = __builtin_fmaf(-slopeL, __builtin_fabsf(d1v[r]), p1[r]); }
            } else if (VAR == 1) {
                LAS const float* ckp = ckL + kt * 64 + 4 * hi;
                f32x16 c0v, c1v;
#pragma unroll
                for (int g = 0; g < 4; ++g) { const f32x4 c0 = *(LAS const f32x4*)(ckp + 8 * g), c1 = *(LAS const f32x4*)(ckp + 32 + 8 * g);
#pragma unroll
                    for (int i = 0; i < 4; ++i) { c0v[4 * g + i] = c0[i]; c1v[4 * g + i] = c1[i]; } }
                p0 = p0 - c0v; p1 = p1 - c1v;
                if (dk == 0) {
#pragma unroll
                    for (int r = 0; r < 16; ++r) { const int key = crow(r, hi); if (key > qloc) p0[r] = NEG; if (key + 32 > qloc) p1[r] = NEG; }
                }
            } else {
                if (dk >= 3) { const float rf = relX[64];
                    p0 = p0 + rf; p1 = p1 + rf;
                } else {
                    LAS const float* rb = relX + 64 + (128 - 64 * dk - qloc) + 4 * hi;
                    f32x16 b0v, b1v;
#pragma unroll
                    for (int r = 0; r < 16; ++r) { b0v[r] = rb[(r & 3) + 8 * (r >> 2)]; b1v[r] = rb[32 + (r & 3) + 8 * (r >> 2)]; }
                    p0 = p0 + b0v; p1 = p1 + b1v;
                }
            }
            float ra = max3f(p0[0], p0[1], p0[2]), rb2 = max3f(p1[0], p1[1], p1[2]);
#pragma unroll
            for (int r = 3; r < 15; r += 2) { ra = max3f(ra, p0[r], p0[r + 1]); rb2 = max3f(rb2, p1[r], p1[r + 1]); }
            float rm = max3f(ra, rb2, __builtin_fmaxf(p0[15], p1[15]));
            rm = __builtin_fmaxf(rm, __shfl_xor(rm, 32));
            if (first || __any(rm > THR)) {
                const float dl = first ? rm : __builtin_fmaxf(rm, 0.f);
                mref += dl;
                p0 = p0 - dl; p1 = p1 - dl;
                const float f = first ? 1.0f : __builtin_amdgcn_exp2f(-dl);
                lrow *= f; o0 = o0 * f; o1 = o1 * f;
#pragma unroll
                for (int r = 0; r < 16; ++r) negm[r] = -mref;
                first = false;
            }
#pragma unroll
            for (int r = 0; r < 16; ++r) { p0[r] = __builtin_amdgcn_exp2f(p0[r]); p1[r] = __builtin_amdgcn_exp2f(p1[r]); }
            { const f32x16 sv = p0 + p1;
              float ls = 0.f;
#pragma unroll
              for (int r = 0; r < 16; r += 4) ls += (sv[r] + sv[r + 1]) + (sv[r + 2] + sv[r + 3]);
              lrow += ls; }
            u32x4 pw[4];
#pragma unroll
            for (int i = 0; i < 4; ++i) { pw[0][i] = cvt_pk_bf16(p0[2 * i], p0[2 * i + 1]); pw[1][i] = cvt_pk_bf16(p0[8 + 2 * i], p0[9 + 2 * i]);
                                          pw[2][i] = cvt_pk_bf16(p1[2 * i], p1[2 * i + 1]); pw[3][i] = cvt_pk_bf16(p1[8 + 2 * i], p1[9 + 2 * i]); }
            const unsigned vb = (unsigned)(uintptr_t)(lds + LDS_V + cur * 8192 + ((lane >> 4) & 1) * 32 + (lane & 3) * 8 + (4 * hi + ((lane & 15) >> 2)) * 64);
#pragma unroll
            for (int d0 = 0; d0 < 2; ++d0) {
                s16x4 lo[4], hh[4];
#pragma unroll
                for (int ks = 0; ks < 4; ++ks) {
                    asm volatile("ds_read_b64_tr_b16 %0, %1 offset:%c2" : "=&v"(lo[ks]) : "v"(vb), "i"(d0 * 4096 + ks * 1024) : "memory");
                    asm volatile("ds_read_b64_tr_b16 %0, %1 offset:%c2" : "=&v"(hh[ks]) : "v"(vb), "i"(d0 * 4096 + ks * 1024 + 512) : "memory"); }
                asm volatile("s_waitcnt lgkmcnt(0)" ::: "memory"); __builtin_amdgcn_sched_barrier(0);
#pragma unroll
                for (int ks = 0; ks < 4; ++ks) {
                    const bf16x8 pf = __builtin_bit_cast(bf16x8, pw[ks]);
                    const bf16x8 vf = (bf16x8){lo[ks][0], lo[ks][1], lo[ks][2], lo[ks][3], hh[ks][0], hh[ks][1], hh[ks][2], hh[ks][3]};
                    if (d0 == 0) o0 = __builtin_amdgcn_mfma_f32_32x32x16_bf16(vf, pf, o0, 0, 0, 0);
                    else o1 = __builtin_amdgcn_mfma_f32_32x32x16_bf16(vf, pf, o1, 0, 0, 0);
                }
            }
}
struct Src { const bf16_t* k; const bf16_t* v; const bf16_t* q; int nt; };
__device__ __forceinline__ Src make_src(int var, const bf16_t* proj, int b, int h, int qb, int lane, int wid) {
    const int qc = var == 0 ? QA : (var == 1 ? QB_ : QC_), kc = var == 0 ? KA : (var == 1 ? KB_ : KC_), vc = var == 0 ? VA : (var == 1 ? VB_ : VC_);
    const int kvh = var == 0 ? (h >> 2) : h, back = var == 0 ? 2 : (var == 1 ? 1000 : 8);
    const int kt_lo = var == 1 ? 0 : (4 * qb - back > 0 ? 4 * qb - back : 0), kt_hi = 4 * qb + 3;
    const size_t row0 = (size_t)b * SEQ + (size_t)kt_lo * 64;
    const int kkey = wid * 8 + (lane >> 3), kchunk = (lane & 7) ^ ((kkey >> 1) & 7);
    Src s;
    s.k = proj + (row0 + kkey) * PITCH + kc + kvh * 64 + kchunk * 8;
    s.v = proj + (row0 + 16 * (wid & 3) + (lane >> 2)) * PITCH + vc + kvh * 64 + (wid >> 2) * 32 + (lane & 3) * 8;
    s.q = proj + ((size_t)b * SEQ + qb * 256 + wid * 32 + (lane & 31)) * PITCH + qc + h * 64 + (lane >> 5) * 8;
    s.nt = kt_hi - kt_lo + 1;
    return s;
}
template <int VAR>
__device__ __forceinline__ void unit(LAS unsigned char* lds, bf16_t* proj, const float* sinks, int b, int h, int qb, int& cur, bool prefetched, bool has_next, const Src& nx, bf16x8 (&qr)[4]) {
    const int tid = tid_opaque(), lane = tid & 63, r32 = lane & 31, hi = lane >> 5; const int wid = __builtin_amdgcn_readfirstlane(tid >> 6);
    const Src me = make_src(VAR, proj, b, h, qb, lane, wid);
    const int nt = me.nt, kt_hi = 4 * qb + 3, kt_lo = kt_hi - nt + 1;
    const int c = 4 * qb + (wid >> 1);
    constexpr int BACK = VAR == 0 ? 2 : (VAR == 1 ? 1000 : 8);
    LAS float* relX = (LAS float*)(lds + LDS_REL);
    LAS float* ckL = (LAS float*)(lds + LDS_CUM);
#define ATT_DMA2(kp_, vp_, slot) do { \
        __builtin_amdgcn_global_load_lds((const unsigned*)(kp_), (LAS unsigned*)(lds + LDS_K + (slot) * 8192 + wid * 1024), 16, 0, 0); \
        __builtin_amdgcn_global_load_lds((const unsigned*)(vp_), (LAS unsigned*)(lds + LDS_V + (slot) * 8192 + wid * 1024), 16, 0, 0); } while (0)
    if (!prefetched) {
        ATT_DMA2(me.k, me.v, cur); ATT_DMA2(me.k + (size_t)64 * PITCH, me.v + (size_t)64 * PITCH, (cur + 1) & 3); ATT_DMA2(me.k + (size_t)128 * PITCH, me.v + (size_t)128 * PITCH, (cur + 2) & 3);
#pragma unroll
        for (int d0 = 0; d0 < 4; ++d0) qr[d0] = *(const bf16x8*)(me.q + d0 * 16);
    }
    const float sinkL = VAR == 0 ? sinks[h] * LOG2E : 0.f;
    float mref = 0.f, lrow = 0.f; bool first = true;
    f32x16 negm;
#pragma unroll
    for (int r = 0; r < 16; ++r) negm[r] = 0.f;
    int koff[4];
#pragma unroll
    for (int d0 = 0; d0 < 4; ++d0) koff[d0] = ((2 * d0 + hi) ^ ((r32 >> 1) & 7)) << 4;
    f32x16 o0, o1;
#pragma unroll
    for (int r = 0; r < 16; ++r) { o0[r] = 0.f; o1[r] = 0.f; }
    const float slopeL = VAR == 0 ? exp2f(-(float)(h + 1)) * LOG2E : 0.f;
    const int qloc = 32 * (wid & 1) + r32;
    f32x16 kf0;
#pragma unroll
    for (int r = 0; r < 16; ++r) kf0[r] = (float)crow(r, hi);
    bf16x8 qn[4];
#pragma unroll
    for (int d0 = 0; d0 < 4; ++d0) qn[d0] = qr[d0];
    for (int i = 0; i < nt; ++i) {
        const int kt = kt_lo + i;
        if (prefetched && i == 0) asm volatile("s_waitcnt vmcnt(8) lgkmcnt(0)" ::: "memory");
        else asm volatile("s_waitcnt vmcnt(4) lgkmcnt(0)" ::: "memory");
        __builtin_amdgcn_s_barrier(); asm volatile("" ::: "memory");
        { const int i3 = i + 3; const bf16_t* kp; const bf16_t* vp;
          if (i3 < nt) { kp = me.k + (size_t)i3 * 64 * PITCH; vp = me.v + (size_t)i3 * 64 * PITCH; }
          else if (has_next) { kp = nx.k + (size_t)(i3 - nt) * 64 * PITCH; vp = nx.v + (size_t)(i3 - nt) * 64 * PITCH; }
          else { kp = me.k + (size_t)(nt - 1) * 64 * PITCH; vp = me.v + (size_t)(nt - 1) * 64 * PITCH; }
          ATT_DMA2(kp, vp, (cur + 3) & 3); }
        if (has_next && i == nt - 1) {
#pragma unroll
            for (int d0 = 0; d0 < 4; ++d0) qn[d0] = *(const bf16x8*)(nx.q + d0 * 16);
        }
        { const int dk = c - kt; if (dk >= 0 && dk <= BACK) tile<VAR>(lds, cur, kt, dk, qr, mref, lrow, o0, o1, negm, first, relX, ckL, slopeL, kf0, koff, qloc, hi, r32, lane); }
        cur = (cur + 1) & 3;
    }
    if (!has_next) {
        asm volatile("s_waitcnt vmcnt(0) lgkmcnt(0)" ::: "memory");
        __builtin_amdgcn_s_barrier(); asm volatile("" ::: "memory");
    }
#undef ATT_DMA2
    lrow += __shfl_xor(lrow, 32);
    if (VAR == 0) lrow += exp2f(sinkL - mref);
    const float rl = 1.0f / lrow;
    bf16_t* orow = const_cast<bf16_t*>(me.q) - hi * 8 + 4 * hi;
#pragma unroll
    for (int g = 0; g < 4; ++g) {
        u32x2 w0, w1;
        w0.x = cvt_pk_bf16(o0[4 * g] * rl, o0[4 * g + 1] * rl); w0.y = cvt_pk_bf16(o0[4 * g + 2] * rl, o0[4 * g + 3] * rl);
        w1.x = cvt_pk_bf16(o1[4 * g] * rl, o1[4 * g + 1] * rl); w1.y = cvt_pk_bf16(o1[4 * g + 2] * rl, o1[4 * g + 3] * rl);
        *(u32x2*)(orow + 8 * g) = w0; *(u32x2*)(orow + 32 + 8 * g) = w1;
    }
#pragma unroll
    for (int d0 = 0; d0 < 4; ++d0) qr[d0] = qn[d0];
}
}

__device__ __forceinline__ void mod_phase(LAS unsigned char* lds, const float* cvec, const float* w_ada, const float* b_ada, float* mod) {
    const int tid = tid_opaque(), lane = tid & 63, wid = tid >> 6;
    LAS float* condL = (LAS float*)lds;
    LAS float* red = (LAS float*)(lds + 32768);
    for (int i = tid; i < BATCH * D; i += 512) { const float c = cvec[i]; condL[i] = c / (1.0f + __expf(-c)); }
    __syncthreads();
    for (int cb = blockIdx.x; cb < 192; cb += gridDim.x) {
        const int l = cb / 96, e0 = (cb % 96) * 64;
        float acc[8];
#pragma unroll
        for (int b = 0; b < 8; ++b) acc[b] = 0.f;
        const float* w = w_ada + ((size_t)l * D + wid * 128) * 6144 + e0 + lane;
#pragma unroll 4
        for (int d = 0; d < 128; ++d) { const float wv = __builtin_nontemporal_load(&w[(size_t)d * 6144]);
#pragma unroll
            for (int b = 0; b < 8; ++b) acc[b] += condL[b * D + wid * 128 + d] * wv; }
#pragma unroll
        for (int b = 0; b < 8; ++b) red[(wid * 8 + b) * 64 + lane] = acc[b];
        __syncthreads();
        { const int b = tid >> 6; float s = b_ada[l * 6144 + e0 + lane];
#pragma unroll
          for (int w8 = 0; w8 < 8; ++w8) s += red[(w8 * 8 + b) * 64 + lane];
          mod[(size_t)(l * 8 + b) * 6144 + e0 + lane] = s; }
        __syncthreads();
    }
}
__device__ __forceinline__ void transpose_item(const float* W, int Nsrc, int nsrc, int k0, bf16_t* WT, int K, int ndst, LAS float* scr, int lane) {
#pragma unroll 8
    for (int i = 0; i < 32; ++i) { const int kk = 2 * i + (lane >> 5); scr[kk * 33 + (lane & 31)] = __builtin_nontemporal_load(&W[(size_t)(k0 + kk) * Nsrc + nsrc + (lane & 31)]); }
    asm volatile("s_waitcnt lgkmcnt(0)" ::: "memory");
    const int c = lane & 7;
#pragma unroll
    for (int j = 0; j < 4; ++j) { const int n = (lane >> 3) + 8 * j; const LAS float* s = scr + (8 * c) * 33 + n;
        u32x4 o; o.x = cvt_pk_bf16(s[0 * 33], s[1 * 33]); o.y = cvt_pk_bf16(s[2 * 33], s[3 * 33]); o.z = cvt_pk_bf16(s[4 * 33], s[5 * 33]); o.w = cvt_pk_bf16(s[6 * 33], s[7 * 33]);
        *(u32x4*)(WT + (size_t)(ndst + n) * K + k0 + 8 * c) = o; }
    asm volatile("s_waitcnt lgkmcnt(0)" ::: "memory");
}
struct Ptrs {
    const float *x, *c, *norm_mix_g, *norm_ffn_g, *w_ada, *b_ada, *w_in, *b_forget, *sinks, *rel_bias, *w_branch, *w_out, *w_ffn_in, *w_ffn_out, *final_norm_g;
};
__device__ __forceinline__ void convert_phase(LAS unsigned char* lds, const Ptrs& P, unsigned char* ws) {
    const int tid = tid_opaque(), lane = tid & 63, wid = tid >> 6;
    LAS float* scr = (LAS float*)(lds + 65536 + wid * 8448);
    const int gw = blockIdx.x * 8 + wid, NGW = gridDim.x * 8;
    constexpr int I_QKV = 16 * (NQKV / 32), I_G = 16 * (NG / 32), I_BR = 3 * 8 * 32, I_OUT = 16 * 32, I_FI = 16 * (FF2 / 32), I_FO = (FFH / 64) * 32, I_FB = 64;
    constexpr int I_LAYER = I_QKV + I_G + I_BR + I_OUT + I_FI + I_FO + I_FB;
    for (int it = gw; it < 2 * I_LAYER; it += NGW) {
        const int l = it / I_LAYER; int r = it % I_LAYER;
        unsigned char* wl = ws + WS_W + (size_t)l * W_LAYER;
        if (r < I_QKV) { const int nb = r % (NQKV / 32), kb = r / (NQKV / 32), n0 = 32 * nb;
            transpose_item(P.w_in + (size_t)l * D * NIN, NIN, n0 < 2304 ? n0 : n0 + 8, 64 * kb, (bf16_t*)(wl + W_QKV), D, n0, scr, lane); continue; } r -= I_QKV;
        if (r < I_G) { const int nb = r % (NG / 32), kb = r / (NG / 32), n0 = 32 * nb;
            transpose_item(P.w_in + (size_t)l * D * NIN, NIN, G_SRC + n0, 64 * kb, (bf16_t*)(wl + W_G), D, n0, scr, lane); continue; } r -= I_G;
        if (r < I_BR) { const int k = r / 256, rr = r % 256, nb = rr % 32, kb = rr / 32;
            transpose_item(P.w_branch + ((size_t)l * 3 + k) * 512 * D, D, 32 * nb, 64 * kb, (bf16_t*)(wl + W_BR), 512, k * D + 32 * nb, scr, lane); continue; } r -= I_BR;
        if (r < I_OUT) { const int nb = r % 32, kb = r / 32;
            transpose_item(P.w_out + (size_t)l * D * D, D, 32 * nb, 64 * kb, (bf16_t*)(wl + W_OUT), D, 32 * nb, scr, lane); continue; } r -= I_OUT;
        if (r < I_FI) { const int nb = r % (FF2 / 32), kb = r / (FF2 / 32), n0 = 32 * nb, pn = n0 >> 8, w = n0 & 255;
            const int src = w < 128 ? 128 * pn + w : FFH + 128 * pn + (w - 128);
            transpose_item(P.w_ffn_in + (size_t)l * D * FF2, FF2, src, 64 * kb, (bf16_t*)(wl + W_FI), D, n0, scr, lane); continue; } r -= I_FI;
        if (r < I_FO) { const int nb = r % 32, kb = r / 32;
            transpose_item(P.w_ffn_out + (size_t)l * FFH * D, D, 32 * nb, 64 * kb, (bf16_t*)(wl + W_FO), FFH, 32 * nb, scr, lane); continue; } r -= I_FO;
        {
            const float* wsrc = P.w_in + (size_t)l * D * NIN + FB_SRC;
#pragma unroll
            for (int q = 0; q < 4; ++q) { const int n = 4 * r + q; u32x4 o0 = {0u, 0u, 0u, 0u}, o1 = {0u, 0u, 0u, 0u};
                if (n < 8) { float v[16];
#pragma unroll
                    for (int i = 0; i < 16; ++i) v[i] = wsrc[(size_t)(16 * lane + i) * NIN + n];
                    o0.x = cvt_pk_bf16(v[0], v[1]); o0.y = cvt_pk_bf16(v[2], v[3]); o0.z = cvt_pk_bf16(v[4], v[5]); o0.w = cvt_pk_bf16(v[6], v[7]);
                    o1.x = cvt_pk_bf16(v[8], v[9]); o1.y = cvt_pk_bf16(v[10], v[11]); o1.z = cvt_pk_bf16(v[12], v[13]); o1.w = cvt_pk_bf16(v[14], v[15]); }
                bf16_t* dst = (bf16_t*)(wl + W_QKV) + (size_t)(NQKV + n) * D + 16 * lane;
                *(u32x4*)dst = o0; *(u32x4*)(dst + 8) = o1; }
        }
    }
}
__device__ __forceinline__ float reduce8(const float (&a)[8], int lane) {
    float b[4], c[2];
    const bool b0 = lane & 1, b1 = lane & 2, b2 = lane & 4;
#pragma unroll
    for (int i = 0; i < 4; ++i) { const float keep = b0 ? a[2 * i + 1] : a[2 * i], send = b0 ? a[2 * i] : a[2 * i + 1]; b[i] = keep + __shfl_xor(send, 1); }
#pragma unroll
    for (int i = 0; i < 2; ++i) { const float keep = b1 ? b[2 * i + 1] : b[2 * i], send = b1 ? b[2 * i] : b[2 * i + 1]; c[i] = keep + __shfl_xor(send, 2); }
    float d = (b2 ? c[1] : c[0]) + __shfl_xor(b2 ? c[0] : c[1], 4);
    d += __shfl_xor(d, 8); d += __shfl_xor(d, 16); d += __shfl_xor(d, 32);
    return d;
}
template <bool FB>
__device__ __forceinline__ void norm_phase(LAS unsigned char* lds, const float* xin, const float* g, const float* shift0, const float* scale0, bf16_t* hout,
                                           const float* w_in_l, const float* b_forget_l, float* flog) {
    const int tid = tid_opaque(), lane = tid & 63, wid = tid >> 6;
    LAS float* wfb = (LAS float*)lds;
    if (FB) { for (int i = tid; i < 8 * D; i += 512) { const int d = i >> 3, e = i & 7; wfb[e * D + d] = w_in_l[(size_t)d * NIN + FB_SRC + e]; } __syncthreads(); }
    const int gw = blockIdx.x * 8 + wid, NGW = gridDim.x * 8;
    for (int rc = gw; rc < M / 4; rc += NGW) {
        const int row0 = rc * 4, b = row0 / SEQ;
        f32x4 v[4][4];
#pragma unroll
        for (int r = 0; r < 4; ++r) { const f32x4* xr = (const f32x4*)(xin + (size_t)(row0 + r) * D) + lane;
#pragma unroll
            for (int j = 0; j < 4; ++j) v[r][j] = xr[64 * j]; }
        f32x4 am[4], sh[4];
#pragma unroll
        for (int j = 0; j < 4; ++j) { const int d = 4 * lane + 256 * j; const f32x4 gv = *(const f32x4*)(g + d), sc = *(const f32x4*)(scale0 + (size_t)b * 6144 + d);
            am[j] = gv * (1.0f + sc); sh[j] = *(const f32x4*)(shift0 + (size_t)b * 6144 + d); }
        float ss[8];
#pragma unroll
        for (int r = 0; r < 4; ++r) { float s = 0.f;
#pragma unroll
            for (int j = 0; j < 4; ++j) s += (v[r][j].x * v[r][j].x + v[r][j].y * v[r][j].y) + (v[r][j].z * v[r][j].z + v[r][j].w * v[r][j].w);
            ss[r] = s; ss[r + 4] = 0.f; }
        const float tot = reduce8(ss, lane);
        const float rs = 1.0f / sqrtf(tot * (1.0f / D) + EPS);
#pragma unroll
        for (int r = 0; r < 4; ++r) { const float rstd = __uint_as_float(__builtin_amdgcn_readlane(__float_as_uint(rs), r));
            u32x2* o8 = (u32x2*)(hout + (size_t)(row0 + r) * D) + lane;
#pragma unroll
            for (int j = 0; j < 4; ++j) { v[r][j] = v[r][j] * rstd * am[j] + sh[j]; u32x2 w; w.x = cvt_pk_bf16(v[r][j].x, v[r][j].y); w.y = cvt_pk_bf16(v[r][j].z, v[r][j].w); o8[64 * j] = w; } }
        if (FB) {
            float pe[4][8];
#pragma unroll
            for (int e = 0; e < 8; ++e) { f32x4 wv[4];
#pragma unroll
                for (int j = 0; j < 4; ++j) wv[j] = *(LAS const f32x4*)(wfb + e * D + 4 * lane + 256 * j);
#pragma unroll
                for (int r = 0; r < 4; ++r) { float a = 0.f;
#pragma unroll
                    for (int j = 0; j < 4; ++j) a += (v[r][j].x * wv[j].x + v[r][j].y * wv[j].y) + (v[r][j].z * wv[j].z + v[r][j].w * wv[j].w);
                    pe[r][e] = a; } }
            const float bfv = b_forget_l[lane & 7];
#pragma unroll
            for (int r = 0; r < 4; ++r) { const float f = reduce8(pe[r], lane) + bfv; if (lane < 8) flog[(size_t)(row0 + r) * 8 + lane] = f; }
        }
    }
}
__device__ __forceinline__ void cumsum_lds(LAS unsigned char* lds, const float* flog, int b, int h) {
    const int tid = tid_opaque(), lane = tid & 63, wid = tid >> 6;
    LAS float* wt = (LAS float*)(lds + att::LDS_REL);
    LAS float* ckL = (LAS float*)(lds + att::LDS_CUM);
    float v[4]; float run = 0.f;
#pragma unroll
    for (int i = 0; i < 4; ++i) { const float f = flog[((size_t)b * SEQ + 4 * tid + i) * 8 + h];
        const float ls = fminf(f, 0.f) - log1pf(expf(-fabsf(f))); run += ls; v[i] = run; }
    float inc = run;
#pragma unroll
    for (int o = 1; o < 64; o <<= 1) { const float t = __shfl_up(inc, o); if (lane >= o) inc += t; }
    if (lane == 63) wt[wid] = inc;
    __syncthreads();
    float base = inc - run;
    for (int w8 = 0; w8 < wid; ++w8) base += wt[w8];
    f32x4 o4 = {(v[0] + base) * LOG2E, (v[1] + base) * LOG2E, (v[2] + base) * LOG2E, (v[3] + base) * LOG2E};
    *(LAS f32x4*)(ckL + 4 * tid) = o4;
    __syncthreads();
}
__device__ __forceinline__ void final_norm_phase(float* x, const float* g) {
    const int tid = tid_opaque(), lane = tid & 63, wid = tid >> 6;
    const int gw = blockIdx.x * 8 + wid, NGW = gridDim.x * 8;
    f32x4 gv[4];
#pragma unroll
    for (int j = 0; j < 4; ++j) gv[j] = *(const f32x4*)(g + 4 * lane + 256 * j);
    for (int row = gw; row < M; row += NGW) {
        f32x4* xr = (f32x4*)(x + (size_t)row * D) + lane;
        f32x4 v[4]; float s = 0.f;
#pragma unroll
        for (int j = 0; j < 4; ++j) { v[j] = xr[64 * j]; s += (v[j].x * v[j].x + v[j].y * v[j].y) + (v[j].z * v[j].z + v[j].w * v[j].w); }
        const float rstd = 1.0f / sqrtf(wave_sum(s) * (1.0f / D) + EPS);
#pragma unroll
        for (int j = 0; j < 4; ++j) xr[64 * j] = v[j] * rstd * gv[j];
    }
}


#define XB_TMO      128
#define XB_XCNT(j)  (256  + 64 * (j))
#define XB_XSUB(j)  (1280 + 64 * (j))
#define XB_XGEN(j)  (2304 + 64 * (j))
#define XB_TOP      3328
#define XB_TOPGEN   3392
#define XCD_BAR_WORDS 3456
#define XB_SPIN_CAP (1u << 18)
__device__ __forceinline__ unsigned xb_ld(unsigned* p)              { return __hip_atomic_load(p, __ATOMIC_RELAXED, __HIP_MEMORY_SCOPE_AGENT); }
__device__ __forceinline__ unsigned xb_add(unsigned* p, unsigned v) { return __hip_atomic_fetch_add(p, v, __ATOMIC_RELAXED, __HIP_MEMORY_SCOPE_AGENT); }
__device__ __forceinline__ unsigned xb_xcc_id() { return (unsigned)__builtin_amdgcn_s_getreg((3 << 11) | 20) & 0xFu; }
#define XB_SPIN(cond, bar) do { unsigned _sp = 0; while (cond) { __builtin_amdgcn_s_sleep(1); \
    if ((++_sp & 255u) == 0u) { if (xb_ld(&(bar)[XB_TMO])) break; if (_sp > XB_SPIN_CAP) { atomicAdd(&(bar)[XB_TMO], 1u); break; } } } } while (0)
__device__ __forceinline__ void xcd_barrier_complete(unsigned* bar, unsigned x, unsigned& nloc, unsigned& nx) {
    const unsigned G = gridDim.x * gridDim.y * gridDim.z;
    unsigned sum, cnt, mine, sp = 0u;
    for (;;) {
        sum = 0u; cnt = 0u; mine = 0u;
#pragma unroll
        for (unsigned j = 0; j < 16; ++j) { const unsigned c = xb_ld(&bar[XB_XCNT(j)]); sum += c; cnt += (c > 0u) ? 1u : 0u; mine = (j == x) ? c : mine; }
        if (sum == G) break;
        __builtin_amdgcn_s_sleep(1);
        if ((++sp & 255u) == 0u) { if (xb_ld(&bar[XB_TMO])) break; if (sp > XB_SPIN_CAP) { atomicAdd(&bar[XB_TMO], 1u); break; } }
    }
    nloc = mine > 0u ? mine : 1u; nx = cnt > 0u ? cnt : 1u;
}
__device__ __forceinline__ void xcd_barrier(unsigned* bar, volatile LAS unsigned* st) {
    asm volatile("s_waitcnt vmcnt(0)" ::: "memory");
    __syncthreads();
    if (threadIdx.x == 0) {
        const unsigned x = xb_xcc_id();
        __builtin_amdgcn_s_waitcnt(0);
        unsigned nloc = st[0], nx = st[1];
        if (nloc == 0u) { xcd_barrier_complete(bar, x, nloc, nx); st[0] = nloc; st[1] = nx; }
        const unsigned old = xb_add(&bar[XB_XSUB(x)], 1u);
        const unsigned gen = old / nloc;
        if (old + 1u == (gen + 1u) * nloc) {
            __builtin_amdgcn_fence(__ATOMIC_RELEASE, "agent");
            asm volatile("s_waitcnt vmcnt(0)" ::: "memory");
            const unsigned og = xb_add(&bar[XB_TOP], 1u);
            const unsigned tg = og / nx;
            if (og + 1u == (tg + 1u) * nx) xb_add(&bar[XB_TOPGEN], 1u);
            else XB_SPIN(xb_ld(&bar[XB_TOPGEN]) == tg, bar);
            __builtin_amdgcn_fence(__ATOMIC_ACQUIRE, "agent");
            xb_add(&bar[XB_XGEN(x)], 1u);
            asm volatile("s_waitcnt vmcnt(0)" ::: "memory");
        } else {
            XB_SPIN(xb_ld(&bar[XB_XGEN(x)]) == gen, bar);
            __builtin_amdgcn_fence(__ATOMIC_ACQUIRE, "agent");
            asm volatile("s_waitcnt vmcnt(0)" ::: "memory");
        }
    }
    __syncthreads();
}

constexpr int LDS_BYTES = 147456;
constexpr int N_PHASES = 20;
#ifndef PH_MASK
#define PH_MASK 0xFFFF
#endif
#define PHON(k) ((PH_MASK >> (k)) & 1)
struct Args { Ptrs p; float* out; unsigned char* ws; int ph_lo, ph_hi; };

__global__ void __launch_bounds__(512, 2) fwd_kernel(Args a) {
    extern __shared__ __attribute__((aligned(16))) unsigned char lds_raw[];
    LAS unsigned char* lds = (LAS unsigned char*)lds_raw;
    cg::grid_group grid = cg::this_grid();
    volatile LAS unsigned* bst = (volatile LAS unsigned*)(lds + LDS_BYTES - 128);
    if (threadIdx.x == 0) { bst[0] = 0u; bst[1] = 0u; }
    __syncthreads();
    const Ptrs& P = a.p;
#ifdef PROBE_MASK
    #define pst ((LAS unsigned long long*)(unsigned)(LDS_BYTES - 64))
    if (threadIdx.x == 0) { pst[0] = __builtin_amdgcn_s_memrealtime(); pst[1] = 0; pst[2] = 0; }
#define PROBE_KIND(p) ((p) == 0 ? 0 : ((p) == N_PHASES - 1 ? 10 : ((((p) - 1) % 9) == 0 ? 1 : ((((p) - 1) % 9) + 1))))
#define PROBE_STEP(p) do { if (threadIdx.x == 0) { const unsigned long long t_now = __builtin_amdgcn_s_memrealtime(); \
        if ((PROBE_MASK >> PROBE_KIND(p)) & 1) pst[1] += ((PROBE_MASK >> 16) & 1) ? (t_now - pst[2]) : (((PROBE_MASK >> 17) & 1) ? (pst[2] - pst[0]) : (t_now - pst[0])); pst[0] = t_now; } } while (0)
#endif
    if (a.ph_hi - a.ph_lo > 1) {
        if (blockIdx.x == 0) { unsigned* z = (unsigned*)(a.ws + WS_BAR); for (int i = threadIdx.x; i < (int)(WS_ZERO_BYTES / 4); i += 512) z[i] = 0u; }
        grid.sync();
        if (threadIdx.x == 0) xb_add(&((unsigned*)(a.ws + WS_BAR))[XB_XCNT(xb_xcc_id())], 1u);
    }
    const bool fuse_norm = (gridDim.x == 256) && (a.ph_hi - a.ph_lo > 1);
    for (int ph = a.ph_lo; ph < a.ph_hi; ++ph) {
        if (fuse_norm && (ph == N_PHASES - 1 || (ph >= 1 && (ph - 1) % 9 == 6) || ph == 10)) continue;
#ifdef PROBE_MASK
        if (ph > a.ph_lo && threadIdx.x == 0) pst[2] = __builtin_amdgcn_s_memrealtime();
#endif
        if (ph > a.ph_lo) xcd_barrier((unsigned*)(a.ws + WS_BAR), bst);
#ifdef PROBE_MASK
        if (ph > a.ph_lo) PROBE_STEP(ph - 1);
#endif
        unsigned char* ws = a.ws; float* outp = a.out; int G = gridDim.x, bx = blockIdx.x;
        asm volatile("" : "+s"(ws), "+s"(outp), "+s"(G), "+s"(bx));
        float* mod = (float*)(ws + WS_MOD); float* flog = (float*)(ws + WS_FLOG); const float* cumL = nullptr;
        bf16_t* hbuf = (bf16_t*)(ws + WS_H); bf16_t* proj = (bf16_t*)(ws + WS_PROJ); bf16_t* act = (bf16_t*)(ws + WS_PROJ);
        if (ph == 0) {
            if (PHON(9)) mod_phase(lds, P.c, P.w_ada, P.b_ada, mod); if (PHON(10)) convert_phase(lds, P, ws); continue; }
        if (ph == N_PHASES - 1) { if (PHON(11)) final_norm_phase(outp, P.final_norm_g); continue; }
        const int l = (ph - 1) / 9, sp = (ph - 1) % 9;
        const unsigned char* wl = ws + WS_W + (size_t)l * W_LAYER;
        const float* modl = mod + (size_t)l * 8 * 6144;
        const float* xin = l == 0 ? P.x : outp;
        switch (sp) {
        case 0: if (PHON(0)) norm_phase<false>(lds, xin, P.norm_mix_g + l * D, modl + 0 * D, modl + 1 * D, hbuf, nullptr, nullptr, nullptr); break;
        case 1: if (PHON(1)) {
            pg8::Gemm g{hbuf, (const bf16_t*)(wl + W_QKV), M, NQKVF, D, D}; pg8::StaticOrder S; S.init(M, NQKVF, G, bx);
            pg8::EpiQKV E{proj, flog, P.b_forget + l * 8}; pg8::gemm_phase(lds, g, S, E); } break;
        case 2: if (PHON(2)) {
            for (int v0 = bx; v0 < 256; v0 += G) {
                const int v = (G == 256) ? ((v0 & 7) * 32 + (v0 >> 3)) : v0;
                const int bh = v >> 2, j = v & 3, b = bh >> 3, h = bh & 7;
                cumsum_lds(lds, flog, b, h);
                {
                    LAS float* relX = (LAS float*)(lds + att::LDS_REL); const float* relh = P.rel_bias + l * 8 * 257 + h * 257;
                    for (int i = tid_opaque(); i < 321; i += 512) { const int jj = i - 64; relX[i] = relh[256 - (jj > 0 ? jj : 0)] * LOG2E; }
                    __syncthreads(); }
                const int tid_ = tid_opaque(), lane_ = tid_ & 63, wid_ = __builtin_amdgcn_readfirstlane(tid_ >> 6);
                const att::Src s1 = att::make_src(1, proj, b, h, j, lane_, wid_), s2 = att::make_src(2, proj, b, h, 2 * j, lane_, wid_), s3 = att::make_src(2, proj, b, h, 2 * j + 1, lane_, wid_),
                               s4 = att::make_src(0, proj, b, h, 2 * j, lane_, wid_), s5 = att::make_src(0, proj, b, h, 2 * j + 1, lane_, wid_);
                int cur = 0; bf16x8 qr[4];
                const float* sk = P.sinks + l * 8;
                att::unit<1>(lds, proj, sk, b, h, 7 - j, cur, false, true, s1, qr);
                att::unit<1>(lds, proj, sk, b, h, j, cur, true, true, s2, qr);
                att::unit<2>(lds, proj, sk, b, h, 2 * j, cur, true, true, s3, qr);
                att::unit<2>(lds, proj, sk, b, h, 2 * j + 1, cur, true, true, s4, qr);
                att::unit<0>(lds, proj, sk, b, h, 2 * j, cur, true, true, s5, qr);
                att::unit<0>(lds, proj, sk, b, h, 2 * j + 1, cur, true, false, s5, qr);
            } } break;
        case 3: if (PHON(3)) { pg8::Gemm g{hbuf, (const bf16_t*)(wl + W_G), M, NG, D, D}; pg8::StaticOrder S; S.init(M, NG, G, bx);
            pg8::EpiGate E{proj}; pg8::gemm_phase(lds, g, S, E); } break;
        case 4: if (PHON(4)) { pg8::Gemm g{proj, (const bf16_t*)(wl + W_BR), M, 3 * D, 512, PITCH}; pg8::BranchOrder S; S.so.init(M, D, G, bx);
            pg8::EpiBranch E{proj, hbuf}; pg8::gemm_phase(lds, g, S, E); } break;
        case 5: if (PHON(5)) { pg8::Gemm g{hbuf, (const bf16_t*)(wl + W_OUT), M, D, D, D}; pg8::StaticOrder S; S.init(M, D, G, bx);
            pg8::EpiRes E{xin, outp, modl + 2 * D, fuse_norm ? 1 : 0, (float*)(ws + WS_SLOT), (unsigned*)(ws + WS_CNT) + l * 4096, P.norm_ffn_g + l * D, modl + 3 * D, modl + 4 * D, hbuf};
            pg8::gemm_phase(lds, g, S, E); } break;
        case 6: if (PHON(6)) norm_phase<false>(lds, outp, P.norm_ffn_g + l * D, modl + 3 * D, modl + 4 * D, hbuf, nullptr, nullptr, nullptr); break;
        case 7: if (PHON(7)) { pg8::Gemm g{hbuf, (const bf16_t*)(wl + W_FI), M, FF2, D, D}; pg8::StaticOrder S; S.init(M, FF2, G, bx);
            pg8::EpiSwiglu E{act}; pg8::gemm_phase(lds, g, S, E); } break;
        case 8: if (PHON(8)) { pg8::Gemm g{act, (const bf16_t*)(wl + W_FO), M, D, FFH, FFH}; pg8::StaticOrder S; S.init(M, D, G, bx);
            const float* modn = mod + (size_t)(l + 1 < DEPTH ? l + 1 : l) * 8 * 6144;
            pg8::EpiRes E{outp, outp, modl + 5 * D, fuse_norm ? (l == DEPTH - 1 ? 2 : 1) : 0, (float*)(ws + WS_SLOT) + (size_t)M * 4, (unsigned*)(ws + WS_CNT) + (2 + l) * 4096,
                          l == DEPTH - 1 ? P.final_norm_g : P.norm_mix_g + (l + 1) * D, modn + 0 * D, modn + 1 * D, hbuf};
            pg8::gemm_phase(lds, g, S, E); } break;
        }
    }
#ifdef PROBE_MASK
    if (threadIdx.x == 0) pst[2] = __builtin_amdgcn_s_memrealtime();
    grid.sync();
    PROBE_STEP(N_PHASES - 1);
    __syncthreads();
    if (blockIdx.x == 0) { const int n = (int)((float)(unsigned)pst[1] * 0.15f); for (int i = threadIdx.x; i < n; i += 512) a.out[i] += 0.1f; }
#endif
}

extern "C" void kernel_launch(void* const* d_in, const int* in_sizes, int n_in, void* d_out, int out_size, void* d_ws, size_t ws_size, hipStream_t stream) {
    static int grid = 0;
    if (grid == 0) {
        if (n_in != 15 || out_size != M * D || ws_size < WS_END) { fprintf(stderr, "kernel_launch: unexpected shapes (n_in %d out %d ws %zu)\n", n_in, out_size, ws_size); grid = -1; return; }
        int dev = 0, cus = 0, per_cu = 0;
        hipGetDevice(&dev); hipDeviceGetAttribute(&cus, hipDeviceAttributeMultiprocessorCount, dev);
        if (hipFuncSetAttribute((const void*)fwd_kernel, hipFuncAttributeMaxDynamicSharedMemorySize, LDS_BYTES) != hipSuccess) { fprintf(stderr, "kernel_launch: hipFuncSetAttribute failed\n"); grid = -1; return; }
        if (hipOccupancyMaxActiveBlocksPerMultiprocessor(&per_cu, (const void*)fwd_kernel, 512, LDS_BYTES) != hipSuccess || per_cu < 1) { fprintf(stderr, "kernel_launch: occupancy query gave %d\n", per_cu); per_cu = 1; }
        (void)hipGetLastError();
        grid = cus * (per_cu > 1 ? 1 : per_cu);
        if (grid > 256) grid = 256;
    }
    if (grid < 0) return;
    Args a{};
    const float** pp = (const float**)&a.p;
    for (int i = 0; i < 15; ++i) pp[i] = (const float*)d_in[i];
    a.out = (float*)d_out; a.ws = (unsigned char*)d_ws;
#if N_LAUNCH_MODE
    for (int ph = 0; ph < N_PHASES; ++ph) { a.ph_lo = ph; a.ph_hi = ph + 1; hipLaunchKernelGGL(fwd_kernel, dim3(grid), dim3(512), LDS_BYTES, stream, a); }
#else
    a.ph_lo = 0; a.ph_hi = N_PHASES;
    void* args[] = {&a};
    hipError_t e = hipLaunchCooperativeKernel((const void*)fwd_kernel, dim3(grid), dim3(512), args, LDS_BYTES, stream);
    if (e != hipSuccess) fprintf(stderr, "cooperative launch failed: %s (grid %d)\n", hipGetErrorString(e), grid);
#endif
}
```

```cpp
#include <hip/hip_runtime.h>
#include <hip/hip_cooperative_groups.h>
#include <cstdio>
#include <cstdint>
namespace cg = cooperative_groups;

#ifndef N_LAUNCH_MODE
#define N_LAUNCH_MODE 0
#endif

#define LAS __attribute__((address_space(3)))
typedef unsigned short bf16_t;
typedef short bf16x8 __attribute__((ext_vector_type(8)));
typedef short s16x4 __attribute__((ext_vector_type(4)));
typedef float f32x4 __attribute__((ext_vector_type(4)));
typedef float f32x16 __attribute__((ext_vector_type(16)));
typedef unsigned u32x4 __attribute__((ext_vector_type(4)));
typedef unsigned u32x2 __attribute__((ext_vector_type(2)));

constexpr int BATCH = 8, SEQ = 2048, D = 1024, M = BATCH * SEQ, DEPTH = 2;
constexpr int NIN = 6920, FFH = 2816, FF2 = 2 * FFH;
constexpr int PITCH = 4608;
constexpr int NQKV = 3840, NQKVF = 4096, NG = 3072;
constexpr int FB_SRC = 2304;
constexpr int G_SRC = 3848;
constexpr float EPS = 1e-6f;
constexpr float LOG2E = 1.4426950408889634f;

constexpr size_t MiB = 1u << 20;
constexpr size_t WS_MOD = 0;
constexpr size_t WS_FLOG = 512 * 1024;
constexpr size_t WS_BAR = 1536 * 1024;
constexpr size_t WS_CNT = WS_BAR + 16384;
constexpr size_t WS_ZERO_BYTES = 16384 + 4 * 16384;
constexpr size_t WS_SLOT = 1024 * 1024;
constexpr size_t WS_W = 2 * MiB;
constexpr size_t W_QKV = 0, W_G = W_QKV + (size_t)NQKVF * D * 2, W_BR = W_G + (size_t)NG * D * 2, W_OUT = W_BR + (size_t)3 * D * 512 * 2,
                 W_FI = W_OUT + (size_t)D * D * 2, W_FO = W_FI + (size_t)FF2 * D * 2, W_LAYER = W_FO + (size_t)D * FFH * 2;
static_assert(W_LAYER == 35 * MiB + 512 * 1024, "weights per layer");
constexpr size_t WS_H = WS_W + 2 * W_LAYER;
constexpr size_t WS_PROJ = WS_H + (size_t)M * D * 2;
constexpr size_t WS_END = WS_PROJ + (size_t)M * PITCH * 2;
static_assert(WS_END <= 256 * MiB, "workspace");

constexpr int QA = 0, KA = 512, VA = 640, QB_ = 768, KB_ = 1280, VB_ = 1792, QC_ = 2304, KC_ = 2816, VC_ = 3328;
__host__ __device__ __forceinline__ int gate_col(int j) {
    return j == 0 ? 512 : (j < 4 ? 3840 + 256 * (j - 1) : (j < 8 ? 1280 + 256 * (j - 4) : 2816 + 256 * (j - 8)));
}

__device__ __forceinline__ unsigned cvt_pk_bf16(float lo, float hi) { unsigned r; asm volatile("v_cvt_pk_bf16_f32 %0, %1, %2" : "=v"(r) : "v"(lo), "v"(hi)); return r; }
__device__ __forceinline__ float bf_lo(unsigned w) { return __uint_as_float(w << 16); }
__device__ __forceinline__ float bf_hi(unsigned w) { return __uint_as_float(w & 0xffff0000u); }
__device__ __forceinline__ float wave_sum(float v) {
#pragma unroll
    for (int o = 1; o < 64; o <<= 1) v += __shfl_xor(v, o);
    return v;
}
__device__ __forceinline__ int tid_opaque() { int t = threadIdx.x; asm volatile("" : "+v"(t)); return t; }
__device__ __forceinline__ float sigmoidf_(float x) { return __builtin_amdgcn_rcpf(1.0f + __builtin_amdgcn_exp2f(-LOG2E * x)); }

__device__ __forceinline__ float reduce8(const float (&a)[8], int lane);
namespace pg8 {
constexpr int BM = 256, BK = 64, HALF = 128, HTB = HALF * BK * 2, STAGE_BYTES = 8 * HTB, NXCD = 8, WGM = 8;
__host__ __device__ __forceinline__ int lds_byte(int r, int c) { const int st = (r >> 4) * 2 + (c >> 5), rr = r & 15, cc = c & 31, ob = rr * 64 + cc * 2; return st * 1024 + (ob ^ (((ob >> 9) & 1) << 5)); }
__host__ __device__ __forceinline__ void stage_rc(int b, int& R, int& C) { const int st = b / 1024, sb = b % 1024, swz = sb ^ (((sb >> 9) & 1) << 5); R = (st >> 1) * 16 + swz / 64; C = (st & 1) * 32 + (swz % 64) / 2; }
__host__ __device__ __forceinline__ int perm32(int rho) { const int n = rho >> 4, i = rho & 15; return 8 * (i >> 2) + 4 * n + (i & 3); }

struct Unit { int pm, pn, k; };
struct Gemm { const bf16_t* A; const bf16_t* Bt; int M, N, K, lda; };

struct StaticOrder {
    int nM, nN, nwg, G, c;
    __device__ void init(int M_, int N_, int G_, int c_) { nM = M_ / BM; nN = N_ / BM; nwg = nM * nN; G = G_; c = c_; }
    __device__ __forceinline__ bool tile(int i, int& pm, int& pn) const {
        const long L = (long)i * G + c; if (L >= nwg) return false;
        int wgid = (int)L; { const int q = nwg / NXCD, r = nwg % NXCD, xcd = wgid % NXCD, off = wgid / NXCD; wgid = (xcd < r ? xcd * (q + 1) : r * (q + 1) + (xcd - r) * q) + off; }
        const int nig = WGM * nN, gid = wgid / nig, fm = gid * WGM, gsz = (nM - fm) < WGM ? (nM - fm) : WGM;
        pm = fm + ((wgid % nig) % gsz); pn = (wgid % nig) / gsz; return true;
    }
    __device__ __forceinline__ bool next(int i, Unit& u) const { u.k = 0; return tile(i, u.pm, u.pn); }
    __device__ __forceinline__ size_t a_off(const Unit&) const { return 0; }
};
struct BranchOrder {
    StaticOrder so;
    __device__ __forceinline__ bool next(int i, Unit& u) const { int pm, cn; if (!so.tile(i / 3, pm, cn)) return false; u.k = i % 3; u.pm = pm; u.pn = 4 * u.k + cn; return true; }
    __device__ __forceinline__ size_t a_off(const Unit& u) const { return (size_t)(u.k == 0 ? QA : (u.k == 1 ? QB_ : QC_)) * 2; }
};

struct EpiQKV {
    static constexpr bool PERM = true, AFTER_DRAIN = false;
    bf16_t* O; float* flog; const float* bfg;
    __device__ __forceinline__ bool keep(const Unit&) const { return false; }
    __device__ __forceinline__ void operator()(f32x4 (&acc)[2][2][4][2], const Unit& u, int wr, int wc, int fr, int fq) const {
        if (u.pn == 15) {
            if (wc == 0 && fq == 0) {
                const f32x4 b0 = *(const f32x4*)(bfg), b1 = *(const f32x4*)(bfg + 4);
#pragma unroll
                for (int ai = 0; ai < 2; ++ai)
#pragma unroll
                    for (int m = 0; m < 4; ++m) { float* fp = flog + (size_t)(u.pm * BM + ai * HALF + wr * 64 + m * 16 + fr) * 8;
                        *(f32x4*)fp = acc[ai][0][m][0] + b0; *(f32x4*)(fp + 4) = acc[ai][0][m][1] + b1; }
            }
            return;
        }
        const int row0 = u.pm * BM + wr * 64 + fr, col0 = u.pn * BM + wc * 32 + 8 * fq;
        const bool isq = (u.pn < 2) || (u.pn == 3) || (u.pn == 4) || (u.pn == 9) || (u.pn == 10);
        const float qs = isq ? 0.125f * LOG2E : 1.0f;
#pragma unroll
        for (int ai = 0; ai < 2; ++ai)
#pragma unroll
            for (int m = 0; m < 4; ++m) { bf16_t* rowp = O + (size_t)(row0 + ai * HALF + m * 16) * PITCH + col0;
#pragma unroll
                for (int bj = 0; bj < 2; ++bj) { const f32x4 v0 = acc[ai][bj][m][0] * qs, v1 = acc[ai][bj][m][1] * qs;
                    u32x4 w; w.x = cvt_pk_bf16(v0[0], v0[1]); w.y = cvt_pk_bf16(v0[2], v0[3]); w.z = cvt_pk_bf16(v1[0], v1[1]); w.w = cvt_pk_bf16(v1[2], v1[3]);
                    *(u32x4*)(rowp + bj * HALF) = w; } }
    }
};
struct EpiGate {
    static constexpr bool PERM = true, AFTER_DRAIN = false;
    bf16_t* O;
    __device__ __forceinline__ bool keep(const Unit&) const { return false; }
    __device__ __forceinline__ void operator()(f32x4 (&acc)[2][2][4][2], const Unit& u, int wr, int wc, int fr, int fq) const {
        const int row0 = u.pm * BM + wr * 64 + fr, col0 = gate_col(u.pn) + wc * 32 + 8 * fq;
#pragma unroll
        for (int ai = 0; ai < 2; ++ai)
#pragma unroll
            for (int m = 0; m < 4; ++m) { bf16_t* rowp = O + (size_t)(row0 + ai * HALF + m * 16) * PITCH + col0;
#pragma unroll
                for (int bj = 0; bj < 2; ++bj) { f32x4 v0 = acc[ai][bj][m][0], v1 = acc[ai][bj][m][1];
#pragma unroll
                    for (int i = 0; i < 4; ++i) { v0[i] = fmaxf(sigmoidf_(v0[i]), 1e-6f); v1[i] = fmaxf(sigmoidf_(v1[i]), 1e-6f); }
                    u32x4 w; w.x = cvt_pk_bf16(v0[0], v0[1]); w.y = cvt_pk_bf16(v0[2], v0[3]); w.z = cvt_pk_bf16(v1[0], v1[1]); w.w = cvt_pk_bf16(v1[2], v1[3]);
                    *(u32x4*)(rowp + bj * HALF) = w; } }
    }
};
struct EpiBranch {
    static constexpr bool PERM = true, AFTER_DRAIN = false;
    const bf16_t* P; bf16_t* O;
    __device__ __forceinline__ bool keep(const Unit& u) const { return u.k < 2; }
    __device__ __forceinline__ void operator()(f32x4 (&acc)[2][2][4][2], const Unit& u, int wr, int wc, int fr, int fq) const {
        const int cn = u.pn & 3, k = u.k;
        const int row0 = u.pm * BM + wr * 64 + fr, cofs = wc * 32 + 8 * fq;
        const int gc0 = gate_col(4 * k + cn) + cofs, gc1 = gate_col(4 * (k < 2 ? k + 1 : 2) + cn) + cofs;
#pragma unroll
        for (int ai = 0; ai < 2; ++ai)
#pragma unroll
            for (int m = 0; m < 4; ++m) { const size_t ro = (size_t)(row0 + ai * HALF + m * 16);
#pragma unroll
                for (int bj = 0; bj < 2; ++bj) {
                    const u32x4 ga = *(const u32x4*)(P + ro * PITCH + gc0 + bj * HALF);
                    float s[8] = {bf_lo(ga.x), bf_hi(ga.x), bf_lo(ga.y), bf_hi(ga.y), bf_lo(ga.z), bf_hi(ga.z), bf_lo(ga.w), bf_hi(ga.w)};
                    if (k < 2) { const u32x4 gb = *(const u32x4*)(P + ro * PITCH + gc1 + bj * HALF);
                        const float t[8] = {bf_lo(gb.x), bf_hi(gb.x), bf_lo(gb.y), bf_hi(gb.y), bf_lo(gb.z), bf_hi(gb.z), bf_lo(gb.w), bf_hi(gb.w)};
#pragma unroll
                        for (int i = 0; i < 8; ++i) s[i] = s[i] * __builtin_amdgcn_rcpf(t[i]); }
                    f32x4 v0 = acc[ai][bj][m][0], v1 = acc[ai][bj][m][1];
#pragma unroll
                    for (int i = 0; i < 4; ++i) { v0[i] *= s[i]; v1[i] *= s[4 + i]; }
                    if (k < 2) { acc[ai][bj][m][0] = v0; acc[ai][bj][m][1] = v1; }
                    else { u32x4 w; w.x = cvt_pk_bf16(v0[0], v0[1]); w.y = cvt_pk_bf16(v0[2], v0[3]); w.z = cvt_pk_bf16(v1[0], v1[1]); w.w = cvt_pk_bf16(v1[2], v1[3]);
                        *(u32x4*)(O + ro * D + cn * BM + cofs + bj * HALF) = w; } } }
    }
};
struct EpiRes {
    static constexpr bool PERM = false, AFTER_DRAIN = true;
    __device__ __forceinline__ void fused(f32x4 (&acc)[2][2][4][2], const Unit& u, int wr, int wc, int fr, int fq, LAS unsigned char* lds, int wid, int lane) const {
        constexpr int TP = 260;
        LAS float* T = (LAS float*)lds;
        const int b = u.pm >> 3, colg = u.pn * BM + 4 * lane;
        const f32x4 gg = *(const f32x4*)(gmod + (size_t)b * 6144 + colg);
        f32x4 xk[32];
#pragma unroll
        for (int ai = 0; ai < 2; ++ai) {
#pragma unroll
            for (int m = 0; m < 4; ++m)
#pragma unroll
                for (int bj = 0; bj < 2; ++bj)
#pragma unroll
                    for (int n = 0; n < 2; ++n) *(LAS f32x4*)(T + (wr * 64 + m * 16 + fr) * TP + bj * HALF + wc * 32 + n * 16 + 4 * fq) = acc[ai][bj][m][n];
            asm volatile("s_waitcnt lgkmcnt(0)" ::: "memory"); __builtin_amdgcn_s_barrier(); asm volatile("" ::: "memory");
#pragma unroll
            for (int hb = 0; hb < 2; ++hb) { f32x4 bs[8]; float ss[8];
#pragma unroll
                for (int rr = 0; rr < 8; ++rr) { const int rl = wid + 8 * (hb * 8 + rr); bs[rr] = __builtin_nontemporal_load((const f32x4*)(base + (size_t)(u.pm * BM + ai * HALF + rl) * D + colg)); }
#pragma unroll
                for (int rr = 0; rr < 8; ++rr) { const int rl = wid + 8 * (hb * 8 + rr); const f32x4 v = *(LAS const f32x4*)(T + rl * TP + 4 * lane);
                    const f32x4 o = bs[rr] + gg * v; ss[rr] = (o.x * o.x + o.y * o.y) + (o.z * o.z + o.w * o.w);
                    xk[ai * 16 + hb * 8 + rr] = o;
                    if (mode != 2) *(f32x4*)(out + (size_t)(u.pm * BM + ai * HALF + rl) * D + colg) = o; }
                if (mode != 0) {
                    const float tot = reduce8(ss, lane);
                    if (lane < 8) { const int rl = wid + 8 * (hb * 8 + lane);
                        __hip_atomic_store(slots + (size_t)(u.pm * BM + ai * HALF + rl) * 4 + u.pn, tot, __ATOMIC_RELAXED, __HIP_MEMORY_SCOPE_AGENT); }
                } }
            asm volatile("s_waitcnt lgkmcnt(0)" ::: "memory"); __builtin_amdgcn_s_barrier(); asm volatile("" ::: "memory");
        }
        if (mode == 0) return;
        asm volatile("s_waitcnt vmcnt(0)" ::: "memory");
        unsigned* pc = cnt + 64 * u.pm;
        if (lane == 0) __hip_atomic_fetch_add(pc, 1u, __ATOMIC_RELAXED, __HIP_MEMORY_SCOPE_AGENT);
        if (wid == 0) {
            unsigned sp = 0;
            while ((unsigned)__builtin_amdgcn_readfirstlane(__hip_atomic_load(pc, __ATOMIC_RELAXED, __HIP_MEMORY_SCOPE_AGENT)) < 32u) { __builtin_amdgcn_s_sleep(2); if (++sp > (1u << 18)) break; }
            __builtin_amdgcn_fence(__ATOMIC_ACQUIRE, "agent");
        }
        asm volatile("s_waitcnt vmcnt(0) lgkmcnt(0)" ::: "memory"); __builtin_amdgcn_s_barrier(); asm volatile("" ::: "memory");
        float rs;
        { const int k = lane & 31, rl = wid + 8 * (k & 15); const float* sl = slots + (size_t)(u.pm * BM + (k >> 4) * HALF + rl) * 4;
          const float t = (__hip_atomic_load(sl + 0, __ATOMIC_RELAXED, __HIP_MEMORY_SCOPE_AGENT) + __hip_atomic_load(sl + 1, __ATOMIC_RELAXED, __HIP_MEMORY_SCOPE_AGENT))
                        + (__hip_atomic_load(sl + 2, __ATOMIC_RELAXED, __HIP_MEMORY_SCOPE_AGENT) + __hip_atomic_load(sl + 3, __ATOMIC_RELAXED, __HIP_MEMORY_SCOPE_AGENT));
          rs = 1.0f / sqrtf(t * (1.0f / D) + EPS); }
        f32x4 am, sh;
        { const f32x4 gv = *(const f32x4*)(ng + colg);
          if (mode == 1) { am = gv * (1.0f + *(const f32x4*)(nscale + (size_t)b * 6144 + colg)); sh = *(const f32x4*)(nshift + (size_t)b * 6144 + colg); }
          else { am = gv; sh = (f32x4){0.f, 0.f, 0.f, 0.f}; } }
#pragma unroll
        for (int kb = 0; kb < 4; ++kb) {
#pragma unroll
            for (int rr = 0; rr < 8; ++rr) { const int k = kb * 8 + rr, rl = wid + 8 * (k & 15); const size_t ro = (size_t)(u.pm * BM + (k >> 4) * HALF + rl);
                const float rstd = __uint_as_float(__builtin_amdgcn_readlane(__float_as_uint(rs), k));
                const f32x4 hv = xk[k] * rstd * am + sh;
                if (mode == 1) { u32x2 w; w.x = cvt_pk_bf16(hv.x, hv.y); w.y = cvt_pk_bf16(hv.z, hv.w); *(u32x2*)(hn + ro * D + colg) = w; }
                else *(f32x4*)(out + ro * D + colg) = hv; } }
    }
    const float* base; float* out; const float* gmod;
    int mode; float* slots; unsigned* cnt; const float* ng; const float* nshift; const float* nscale; bf16_t* hn;
    __device__ __forceinline__ bool keep(const Unit&) const { return false; }
    __device__ __forceinline__ void operator()(f32x4 (&acc)[2][2][4][2], const Unit& u, int wr, int wc, int fr, int fq) const {
        const int b = u.pm >> 3;
        const int col0 = u.pn * BM + wc * 32 + 4 * fq;
        const float* gv = gmod + (size_t)b * 6144 + col0;
        f32x4 gg[2][2];
#pragma unroll
        for (int bj = 0; bj < 2; ++bj)
#pragma unroll
            for (int n = 0; n < 2; ++n) gg[bj][n] = *(const f32x4*)(gv + bj * HALF + n * 16);
#pragma unroll
        for (int ai = 0; ai < 2; ++ai)
#pragma unroll
            for (int m = 0; m < 4; ++m) { const size_t off = (size_t)(u.pm * BM + ai * HALF + wr * 64 + m * 16 + fr) * D + col0;
#pragma unroll
                for (int bj = 0; bj < 2; ++bj)
#pragma unroll
                    for (int n = 0; n < 2; ++n) { const f32x4 bs = *(const f32x4*)(base + off + bj * HALF + n * 16);
                        *(f32x4*)(out + off + bj * HALF + n * 16) = bs + gg[bj][n] * acc[ai][bj][m][n]; } }
    }
};
struct EpiSwiglu {
    static constexpr bool PERM = true, AFTER_DRAIN = false;
    bf16_t* O;
    __device__ __forceinline__ bool keep(const Unit&) const { return false; }
    __device__ __forceinline__ void operator()(f32x4 (&acc)[2][2][4][2], const Unit& u, int wr, int wc, int fr, int fq) const {
        const int row0 = u.pm * BM + wr * 64 + fr, col0 = u.pn * HALF + wc * 32 + 8 * fq;
#pragma unroll
        for (int ai = 0; ai < 2; ++ai)
#pragma unroll
            for (int m = 0; m < 4; ++m) { bf16_t* rowp = O + (size_t)(row0 + ai * HALF + m * 16) * FFH + col0;
                f32x4 r0, r1;
#pragma unroll
                for (int i = 0; i < 4; ++i) { const float g0 = acc[ai][0][m][0][i], g1 = acc[ai][0][m][1][i];
                    r0[i] = g0 * sigmoidf_(g0) * acc[ai][1][m][0][i]; r1[i] = g1 * sigmoidf_(g1) * acc[ai][1][m][1][i]; }
                u32x4 w; w.x = cvt_pk_bf16(r0[0], r0[1]); w.y = cvt_pk_bf16(r0[2], r0[3]); w.z = cvt_pk_bf16(r1[0], r1[1]); w.w = cvt_pk_bf16(r1[2], r1[3]);
                *(u32x4*)rowp = w; }
    }
};

template <class Epi, class Sched>
__device__ __forceinline__ void gemm_phase(LAS unsigned char* lds, const Gemm g, const Sched& S, const Epi& E) {
    const int tid = tid_opaque(), wid = __builtin_amdgcn_readfirstlane(tid >> 6), lane = tid & 63, wr = wid >> 2, wc = wid & 3, fr = lane & 15, fq = lane >> 4;
    const int K = g.K, nt = K / BK, lda = g.lda;
    unsigned voffA[2], voffB[2];
#pragma unroll
    for (int i = 0; i < 2; ++i) { int R, C; stage_rc(tid * 16 + i * 8192, R, C); const int Rb = Epi::PERM ? ((R & ~31) + perm32(R & 31)) : R;
        voffA[i] = (unsigned)(R * lda + C) * 2u; voffB[i] = (unsigned)(Rb * K + C) * 2u; }
    const size_t kstep = (size_t)(BK * 2);
    const size_t hstepA = (size_t)HALF * lda * 2, hstepB = (size_t)HALF * K * 2;
    const size_t tstepA = 2 * hstepA, tstepB = 2 * hstepB;
    const unsigned ldsw = (unsigned)wid * 1024u;
    const int aoff = lds_byte(wr * 64 + fr, fq * 8), boff = lds_byte(wc * 32 + fr, fq * 8);
#define PG8_SA(b, h) (((b) * 2 + (h)) * HTB)
#define PG8_SB(b, h) ((4 + (b) * 2 + (h)) * HTB)
#define PG8_STAGE(bufoff, gbase, voff) do { _Pragma("unroll") for (int _i = 0; _i < 2; ++_i) \
        __builtin_amdgcn_global_load_lds((const unsigned*)((const char*)(gbase) + (voff)[_i]), (LAS unsigned*)(lds + (bufoff) + ldsw + _i * 8192), 16, 0, 0); } while (0)
#define PG8_LDA(dst, b, h) do { _Pragma("unroll") for (int m = 0; m < 4; ++m) _Pragma("unroll") for (int k = 0; k < 2; ++k) dst[m][k] = *(const LAS bf16x8*)(lds + PG8_SA(b, h) + aoff + m * 2048 + k * 1024); } while (0)
#define PG8_LDB(dst, b, h) do { _Pragma("unroll") for (int n = 0; n < 2; ++n) _Pragma("unroll") for (int k = 0; k < 2; ++k) dst[n][k] = *(const LAS bf16x8*)(lds + PG8_SB(b, h) + boff + n * 2048 + k * 1024); } while (0)
#define PG8_MMA(ai, bj, At, Bt) do { __builtin_amdgcn_s_setprio(1); _Pragma("unroll") for (int m = 0; m < 4; ++m) _Pragma("unroll") for (int n = 0; n < 2; ++n) _Pragma("unroll") for (int k = 0; k < 2; ++k) \
        acc[ai][bj][m][n] = __builtin_amdgcn_mfma_f32_16x16x32_bf16(Bt[n][k], At[m][k], acc[ai][bj][m][n], 0, 0, 0); __builtin_amdgcn_s_setprio(0); } while (0)
#define PG8_WAIT_V(n) asm volatile("s_waitcnt vmcnt(" #n ")" ::: "memory")
#define PG8_WAIT_L(n) asm volatile("s_waitcnt lgkmcnt(" #n ")" ::: "memory")
#define PG8_BAR __builtin_amdgcn_s_barrier()
#define PG8_SCHED __builtin_amdgcn_sched_barrier(0)
    Unit cur, nxt; int ui = 0;
    if (!S.next(0, cur)) return;
    f32x4 acc[2][2][4][2];
#pragma unroll
    for (int a = 0; a < 2; ++a)
#pragma unroll
        for (int b = 0; b < 2; ++b)
#pragma unroll
            for (int m = 0; m < 4; ++m)
#pragma unroll
                for (int n = 0; n < 2; ++n) acc[a][b][m][n] = (f32x4){0.f, 0.f, 0.f, 0.f};
    bf16x8 At[4][2], B0[2][2], B1[2][2];
    const char* cA = (const char*)g.A + S.a_off(cur) + (size_t)cur.pm * tstepA; const char* cB = (const char*)g.Bt + (size_t)cur.pn * tstepB;
    PG8_STAGE(PG8_SB(0, 0), cB, voffB); PG8_STAGE(PG8_SB(0, 1), cB + hstepB, voffB); PG8_STAGE(PG8_SA(0, 0), cA, voffA); PG8_STAGE(PG8_SA(0, 1), cA + hstepA, voffA);
    if (wr == 1) PG8_BAR;
    PG8_WAIT_V(2); PG8_BAR;
    PG8_STAGE(PG8_SB(1, 0), cB + kstep, voffB); PG8_STAGE(PG8_SA(1, 0), cA + kstep, voffA); PG8_STAGE(PG8_SB(1, 1), cB + hstepB + kstep, voffB);
    PG8_WAIT_V(6); PG8_BAR;
    for (;;) {
        const bool has_next = S.next(ui + 1, nxt);
        const char* nA = has_next ? (const char*)g.A + S.a_off(nxt) + (size_t)nxt.pm * tstepA : cA; const char* nB = has_next ? (const char*)g.Bt + (size_t)nxt.pn * tstepB : cB;
        for (int t = 0; t < nt; t += 2) {
            const bool last = (t == nt - 2);
            const char* a1 = cA + (size_t)(t + 1) * kstep;
            const char* a2 = last ? nA : cA + (size_t)(t + 2) * kstep; const char* b2 = last ? nB : cB + (size_t)(t + 2) * kstep;
            const char* a3 = a2 + kstep; const char* b3 = b2 + kstep;
            PG8_LDB(B0, 0, 0); PG8_LDB(B1, 0, 1); PG8_SCHED; PG8_LDA(At, 0, 0); PG8_STAGE(PG8_SA(1, 1), a1 + hstepA, voffA);
            PG8_WAIT_V(8); PG8_WAIT_L(0); PG8_BAR; PG8_MMA(0, 0, At, B0); PG8_MMA(0, 1, At, B1); PG8_BAR; PG8_SCHED;
            PG8_LDA(At, 0, 1); PG8_STAGE(PG8_SB(0, 0), b2, voffB); PG8_STAGE(PG8_SB(0, 1), b2 + hstepB, voffB); PG8_STAGE(PG8_SA(0, 0), a2, voffA);
            PG8_WAIT_V(8); PG8_WAIT_L(0); PG8_BAR; PG8_MMA(1, 0, At, B0); PG8_MMA(1, 1, At, B1); PG8_BAR; PG8_SCHED;
            PG8_LDB(B0, 1, 0); PG8_LDB(B1, 1, 1); PG8_SCHED; PG8_LDA(At, 1, 0); PG8_STAGE(PG8_SA(0, 1), a2 + hstepA, voffA);
            PG8_WAIT_V(8); PG8_WAIT_L(0); PG8_BAR; PG8_MMA(0, 0, At, B0); PG8_MMA(0, 1, At, B1); PG8_BAR; PG8_SCHED;
            PG8_LDA(At, 1, 1); PG8_STAGE(PG8_SB(1, 0), b3, voffB); PG8_STAGE(PG8_SB(1, 1), b3 + hstepB, voffB); PG8_STAGE(PG8_SA(1, 0), a3, voffA);
            PG8_WAIT_V(8); PG8_WAIT_L(0); PG8_BAR; PG8_MMA(1, 0, At, B0); PG8_MMA(1, 1, At, B1); PG8_BAR; PG8_SCHED;
        }
        if (wr == 0) PG8_BAR;
        if (!(Epi::AFTER_DRAIN && !has_next)) E(acc, cur, wr, wc, fr, fq);
        if (!has_next) break;
        if (!E.keep(cur)) {
#pragma unroll
            for (int a = 0; a < 2; ++a)
#pragma unroll
                for (int b = 0; b < 2; ++b)
#pragma unroll
                    for (int m = 0; m < 4; ++m)
#pragma unroll
                        for (int n = 0; n < 2; ++n) acc[a][b][m][n] = (f32x4){0.f, 0.f, 0.f, 0.f};
        }
        cur = nxt; cA = nA; cB = nB; ++ui;
        if (wr == 1) PG8_BAR;
    }
    PG8_WAIT_V(0);
    PG8_BAR;
    if constexpr (Epi::AFTER_DRAIN) E.fused(acc, cur, wr, wc, fr, fq, lds, wid, lane);
#undef PG8_SA
#undef PG8_SB
#undef PG8_STAGE
#undef PG8_LDA
#undef PG8_LDB
#undef PG8_MMA
#undef PG8_WAIT_V
#undef PG8_WAIT_L
#undef PG8_BAR
#undef PG8_SCHED
}
}

namespace att {
typedef short v4i16_t __attribute__((ext_vector_type(4)));
__device__ __forceinline__ int crow(int r, int hi) { return (r & 3) + 8 * (r >> 2) + 4 * hi; }
__device__ __forceinline__ s16x4 vtr(LAS const unsigned char* p) { return __builtin_bit_cast(s16x4, __builtin_amdgcn_ds_read_tr16_b64_v4i16((LAS v4i16_t*)p)); }
constexpr float C2 = 0.125f * LOG2E;
constexpr float NEG = -1e30f;
constexpr int LDS_K = 0, LDS_V = 32768, LDS_REL = 65536, LDS_CUM = 69632;

__device__ __forceinline__ float max3f(float a, float b, float c) { return __builtin_fmaxf(__builtin_fmaxf(a, b), c); }
constexpr float THR = 8.0f;
template <int VAR>
__device__ __forceinline__ void tile(LAS unsigned char* lds, int cur, int kt, int dk, const bf16x8 (&qr)[4], float& mref, float& lrow, f32x16& o0, f32x16& o1, f32x16& negm, bool& first,
                                     LAS float* relX, LAS float* ckL, float slopeL, const f32x16& kf0, const int (&koff)[4], int qloc, int hi, int r32, int lane) {
            LAS const unsigned char* kp = lds + LDS_K + cur * 8192 + r32 * 128;
            f32x16 p0, p1;
            __builtin_amdgcn_s_setprio(1);
#pragma unroll
            for (int d0 = 0; d0 < 4; ++d0) {
                const bf16x8 k0 = *(LAS const bf16x8*)(kp + koff[d0]), k1 = *(LAS const bf16x8*)(kp + 4096 + koff[d0]);
                if (d0 == 0) { p0 = __builtin_amdgcn_mfma_f32_32x32x16_bf16(k0, qr[0], negm, 0, 0, 0); p1 = __builtin_amdgcn_mfma_f32_32x32x16_bf16(k1, qr[0], negm, 0, 0, 0); }
                else { p0 = __builtin_amdgcn_mfma_f32_32x32x16_bf16(k0, qr[d0], p0, 0, 0, 0); p1 = __builtin_amdgcn_mfma_f32_32x32x16_bf16(k1, qr[d0], p1, 0, 0, 0); }
            }
            __builtin_amdgcn_s_setprio(0);
            if (VAR == 0) {
                const float dqf = (float)(64 * dk + qloc);
                const f32x16 d0v = dqf - kf0, d1v = d0v - 32.0f;
#pragma unroll
                for (int r = 0; r < 16; ++r) { p0[r] = __builtin_fmaf(-slopeL, __builtin_fabsf(d0v[r]), p0[r]); p1[r] = __builtin_fmaf(-slopeL, __builtin_fabsf(d1v[r]), p1[r]); }
            } else if (VAR == 1) {
                LAS const float* ckp = ckL + kt * 64 + 4 * hi;
                f32x16 c0v, c1v;
#pragma unroll
                for (int g = 0; g < 4; ++g) { const f32x4 c0 = *(LAS const f32x4*)(ckp + 8 * g), c1 = *(LAS const f32x4*)(ckp + 32 + 8 * g);
#pragma unroll
                    for (int i = 0; i < 4; ++i) { c0v[4 * g + i] = c0[i]; c1v[4 * g + i] = c1[i]; } }
                p0 = p0 - c0v; p1 = p1 - c1v;
                if (dk == 0) {
#pragma unroll
                    for (int r = 0; r < 16; ++r) { const int key = crow(r, hi); if (key > qloc) p0[r] = NEG; if (key + 32 > qloc) p1[r] = NEG; }
                }
            } else {
                if (dk >= 3) { const float rf = relX[64];
                    p0 = p0 + rf; p1 = p1 + rf;
                } else {
                    LAS const float* rb = relX + 64 + (128 - 64 * dk - qloc) + 4 * hi;
                    f32x16 b0v, b1v;
#pragma unroll
                    for (int r = 0; r < 16; ++r) { b0v[r] = rb[(r & 3) + 8 * (r >> 2)]; b1v[r] = rb[32 + (r & 3) + 8 * (r >> 2)]; }
                    p0 = p0 + b0v; p1 = p1 + b1v;
                }
            }
            float ra = max3f(p0[0], p0[1], p0[2]), rb2 = max3f(p1[0], p1[1], p1[2]);
#pragma unroll
            for (int r = 3; r < 15; r += 2) { ra = max3f(ra, p0[r], p0[r + 1]); rb2 = max3f(rb2, p1[r], p1[r + 1]); }
            float rm = max3f(ra, rb2, __builtin_fmaxf(p0[15], p1[15]));
            rm = __builtin_fmaxf(rm, __shfl_xor(rm, 32));
            if (first || __any(rm > THR)) {
                const float dl = first ? rm : __builtin_fmaxf(rm, 0.f);
                mref += dl;
                p0 = p0 - dl; p1 = p1 - dl;
                const float f = first ? 1.0f : __builtin_amdgcn_exp2f(-dl);
                lrow *= f; o0 = o0 * f; o1 = o1 * f;
#pragma unroll
                for (int r = 0; r < 16; ++r) negm[r] = -mref;
                first = false;
            }
#pragma unroll
            for (int r = 0; r < 16; ++r) { p0[r] = __builtin_amdgcn_exp2f(p0[r]); p1[r] = __builtin_amdgcn_exp2f(p1[r]); }
            { const f32x16 sv = p0 + p1;
              float ls = 0.f;
#pragma unroll
              for (int r = 0; r < 16; r += 4) ls += (sv[r] + sv[r + 1]) + (sv[r + 2] + sv[r + 3]);
              lrow += ls; }
            u32x4 pw[4];
#pragma unroll
            for (int i = 0; i < 4; ++i) { pw[0][i] = cvt_pk_bf16(p0[2 * i], p0[2 * i + 1]); pw[1][i] = cvt_pk_bf16(p0[8 + 2 * i], p0[9 + 2 * i]);
                                          pw[2][i] = cvt_pk_bf16(p1[2 * i], p1[2 * i + 1]); pw[3][i] = cvt_pk_bf16(p1[8 + 2 * i], p1[9 + 2 * i]); }
            const unsigned vb = (unsigned)(uintptr_t)(lds + LDS_V + cur * 8192 + ((lane >> 4) & 1) * 32 + (lane & 3) * 8 + (4 * hi + ((lane & 15) >> 2)) * 64);
#pragma unroll
            for (int d0 = 0; d0 < 2; ++d0) {
                s16x4 lo[4], hh[4];
#pragma unroll
                for (int ks = 0; ks < 4; ++ks) {
                    asm volatile("ds_read_b64_tr_b16 %0, %1 offset:%c2" : "=&v"(lo[ks]) : "v"(vb), "i"(d0 * 4096 + ks * 1024) : "memory");
                    asm volatile("ds_read_b64_tr_b16 %0, %1 offset:%c2" : "=&v"(hh[ks]) : "v"(vb), "i"(d0 * 4096 + ks * 1024 + 512) : "memory"); }
                asm volatile("s_waitcnt lgkmcnt(0)" ::: "memory"); __builtin_amdgcn_sched_barrier(0);
#pragma unroll
                for (int ks = 0; ks < 4; ++ks) {
                    const bf16x8 pf = __builtin_bit_cast(bf16x8, pw[ks]);
                    const bf16x8 vf = (bf16x8){lo[ks][0], lo[ks][1], lo[ks][2], lo[ks][3], hh[ks][0], hh[ks][1], hh[ks][2], hh[ks][3]};
                    if (d0 == 0) o0 = __builtin_amdgcn_mfma_f32_32x32x16_bf16(vf, pf, o0, 0, 0, 0);
                    else o1 = __builtin_amdgcn_mfma_f32_32x32x16_bf16(vf, pf, o1, 0, 0, 0);
                }
            }
}
struct Src { const bf16_t* k; const bf16_t* v; const bf16_t* q; int nt; };
__device__ __forceinline__ Src make_src(int var, const bf16_t* proj, int b, int h, int qb, int lane, int wid) {
    const int qc = var == 0 ? QA : (var == 1 ? QB_ : QC_), kc = var == 0 ? KA : (var == 1 ? KB_ : KC_), vc = var == 0 ? VA : (var == 1 ? VB_ : VC_);
    const int kvh = var == 0 ? (h >> 2) : h, back = var == 0 ? 2 : (var == 1 ? 1000 : 8);
    const int kt_lo = var == 1 ? 0 : (4 * qb - back > 0 ? 4 * qb - back : 0), kt_hi = 4 * qb + 3;
    const size_t row0 = (size_t)b * SEQ + (size_t)kt_lo * 64;
    const int kkey = wid * 8 + (lane >> 3), kchunk = (lane & 7) ^ ((kkey >> 1) & 7);
    Src s;
    s.k = proj + (row0 + kkey) * PITCH + kc + kvh * 64 + kchunk * 8;
    s.v = proj + (row0 + 16 * (wid & 3) + (lane >> 2)) * PITCH + vc + kvh * 64 + (wid >> 2) * 32 + (lane & 3) * 8;
    s.q = proj + ((size_t)b * SEQ + qb * 256 + wid * 32 + (lane & 31)) * PITCH + qc + h * 64 + (lane >> 5) * 8;
    s.nt = kt_hi - kt_lo + 1;
    return s;
}
template <int VAR>
__device__ __forceinline__ void unit(LAS unsigned char* lds, bf16_t* proj, const float* sinks, int b, int h, int qb, int& cur, bool prefetched, bool has_next, const Src& nx, bf16x8 (&qr)[4]) {
    const int tid = tid_opaque(), lane = tid & 63, r32 = lane & 31, hi = lane >> 5; const int wid = __builtin_amdgcn_readfirstlane(tid >> 6);
    const Src me = make_src(VAR, proj, b, h, qb, lane, wid);
    const int nt = me.nt, kt_hi = 4 * qb + 3, kt_lo = kt_hi - nt + 1;
    const int c = 4 * qb + (wid >> 1);
    constexpr int BACK = VAR == 0 ? 2 : (VAR == 1 ? 1000 : 8);
    LAS float* relX = (LAS float*)(lds + LDS_REL);
    LAS float* ckL = (LAS float*)(lds + LDS_CUM);
#define ATT_DMA2(kp_, vp_, slot) do { \
        __builtin_amdgcn_global_load_lds((const unsigned*)(kp_), (LAS unsigned*)(lds + LDS_K + (slot) * 8192 + wid * 1024), 16, 0, 0); \
        __builtin_amdgcn_global_load_lds((const unsigned*)(vp_), (LAS unsigned*)(lds + LDS_V + (slot) * 8192 + wid * 1024), 16, 0, 0); } while (0)
    if (!prefetched) {
        ATT_DMA2(me.k, me.v, cur); ATT_DMA2(me.k + (size_t)64 * PITCH, me.v + (size_t)64 * PITCH, (cur + 1) & 3); ATT_DMA2(me.k + (size_t)128 * PITCH, me.v + (size_t)128 * PITCH, (cur + 2) & 3);
#pragma unroll
        for (int d0 = 0; d0 < 4; ++d0) qr[d0] = *(const bf16x8*)(me.q + d0 * 16);
    }
    const float sinkL = VAR == 0 ? sinks[h] * LOG2E : 0.f;
    float mref = 0.f, lrow = 0.f; bool first = true;
    f32x16 negm;
#pragma unroll
    for (int r = 0; r < 16; ++r) negm[r] = 0.f;
    int koff[4];
#pragma unroll
    for (int d0 = 0; d0 < 4; ++d0) koff[d0] = ((2 * d0 + hi) ^ ((r32 >> 1) & 7)) << 4;
    f32x16 o0, o1;
#pragma unroll
    for (int r = 0; r < 16; ++r) { o0[r] = 0.f; o1[r] = 0.f; }
    const float slopeL = VAR == 0 ? exp2f(-(float)(h + 1)) * LOG2E : 0.f;
    const int qloc = 32 * (wid & 1) + r32;
    f32x16 kf0;
#pragma unroll
    for (int r = 0; r < 16; ++r) kf0[r] = (float)crow(r, hi);
    bf16x8 qn[4];
#pragma unroll
    for (int d0 = 0; d0 < 4; ++d0) qn[d0] = qr[d0];
    for (int i = 0; i < nt; ++i) {
        const int kt = kt_lo + i;
        if (prefetched && i == 0) asm volatile("s_waitcnt vmcnt(8) lgkmcnt(0)" ::: "memory");
        else asm volatile("s_waitcnt vmcnt(4) lgkmcnt(0)" ::: "memory");
        __builtin_amdgcn_s_barrier(); asm volatile("" ::: "memory");
        { const int i3 = i + 3; const bf16_t* kp; const bf16_t* vp;
          if (i3 < nt) { kp = me.k + (size_t)i3 * 64 * PITCH; vp = me.v + (size_t)i3 * 64 * PITCH; }
          else if (has_next) { kp = nx.k + (size_t)(i3 - nt) * 64 * PITCH; vp = nx.v + (size_t)(i3 - nt) * 64 * PITCH; }
          else { kp = me.k + (size_t)(nt - 1) * 64 * PITCH; vp = me.v + (size_t)(nt - 1) * 64 * PITCH; }
          ATT_DMA2(kp, vp, (cur + 3) & 3); }
        if (has_next && i == nt - 1) {
#pragma unroll
            for (int d0 = 0; d0 < 4; ++d0) qn[d0] = *(const bf16x8*)(nx.q + d0 * 16);
        }
        { const int dk = c - kt; if (dk >= 0 && dk <= BACK) tile<VAR>(lds, cur, kt, dk, qr, mref, lrow, o0, o1, negm, first, relX, ckL, slopeL, kf0, koff, qloc, hi, r32, lane); }
        cur = (cur + 1) & 3;
    }
    if (!has_next) {
        asm volatile("s_waitcnt vmcnt(0) lgkmcnt(0)" ::: "memory");
        __builtin_amdgcn_s_barrier(); asm volatile("" ::: "memory");
    }
#undef ATT_DMA2
    lrow += __shfl_xor(lrow, 32);
    if (VAR == 0) lrow += exp2f(sinkL - mref);
    const float rl = 1.0f / lrow;
    bf16_t* orow = const_cast<bf16_t*>(me.q) - hi * 8 + 4 * hi;
#pragma unroll
    for (int g = 0; g < 4; ++g) {
        u32x2 w0, w1;
        w0.x = cvt_pk_bf16(o0[4 * g] * rl, o0[4 * g + 1] * rl); w0.y = cvt_pk_bf16(o0[4 * g + 2] * rl, o0[4 * g + 3] * rl);
        w1.x = cvt_pk_bf16(o1[4 * g] * rl, o1[4 * g + 1] * rl); w1.y = cvt_pk_bf16(o1[4 * g + 2] * rl, o1[4 * g + 3] * rl);
        *(u32x2*)(orow + 8 * g) = w0; *(u32x2*)(orow + 32 + 8 * g) = w1;
    }
#pragma unroll
    for (int d0 = 0; d0 < 4; ++d0) qr[d0] = qn[d0];
}
}

__device__ __forceinline__ void mod_phase(LAS unsigned char* lds, const float* cvec, const float* w_ada, const float* b_ada, float* mod) {
    const int tid = tid_opaque(), lane = tid & 63, wid = tid >> 6;
    LAS float* condL = (LAS float*)lds;
    LAS float* red = (LAS float*)(lds + 32768);
    for (int i = tid; i < BATCH * D; i += 512) { const float c = cvec[i]; condL[i] = c / (1.0f + __expf(-c)); }
    __syncthreads();
    for (int cb = blockIdx.x; cb < 192; cb += gridDim.x) {
        const int l = cb / 96, e0 = (cb % 96) * 64;
        float acc[8];
#pragma unroll
        for (int b = 0; b < 8; ++b) acc[b] = 0.f;
        const float* w = w_ada + ((size_t)l * D + wid * 128) * 6144 + e0 + lane;
#pragma unroll 4
        for (int d = 0; d < 128; ++d) { const float wv = __builtin_nontemporal_load(&w[(size_t)d * 6144]);
#pragma unroll
            for (int b = 0; b < 8; ++b) acc[b] += condL[b * D + wid * 128 + d] * wv; }
#pragma unroll
        for (int b = 0; b < 8; ++b) red[(wid * 8 + b) * 64 + lane] = acc[b];
        __syncthreads();
        { const int b = tid >> 6; float s = b_ada[l * 6144 + e0 + lane];
#pragma unroll
          for (int w8 = 0; w8 < 8; ++w8) s += red[(w8 * 8 + b) * 64 + lane];
          mod[(size_t)(l * 8 + b) * 6144 + e0 + lane] = s; }
        __syncthreads();
    }
}
__device__ __forceinline__ void transpose_item(const float* W, int Nsrc, int nsrc, int k0, bf16_t* WT, int K, int ndst, LAS float* scr, int lane) {
#pragma unroll 8
    for (int i = 0; i < 32; ++i) { const int kk = 2 * i + (lane >> 5); scr[kk * 33 + (lane & 31)] = __builtin_nontemporal_load(&W[(size_t)(k0 + kk) * Nsrc + nsrc + (lane & 31)]); }
    asm volatile("s_waitcnt lgkmcnt(0)" ::: "memory");
    const int c = lane & 7;
#pragma unroll
    for (int j = 0; j < 4; ++j) { const int n = (lane >> 3) + 8 * j; const LAS float* s = scr + (8 * c) * 33 + n;
        u32x4 o; o.x = cvt_pk_bf16(s[0 * 33], s[1 * 33]); o.y = cvt_pk_bf16(s[2 * 33], s[3 * 33]); o.z = cvt_pk_bf16(s[4 * 33], s[5 * 33]); o.w = cvt_pk_bf16(s[6 * 33], s[7 * 33]);
        *(u32x4*)(WT + (size_t)(ndst + n) * K + k0 + 8 * c) = o; }
    asm volatile("s_waitcnt lgkmcnt(0)" ::: "memory");
}
struct Ptrs {
    const float *x, *c, *norm_mix_g, *norm_ffn_g, *w_ada, *b_ada, *w_in, *b_forget, *sinks, *rel_bias, *w_branch, *w_out, *w_ffn_in, *w_ffn_out, *final_norm_g;
};
__device__ __forceinline__ void convert_phase(LAS unsigned char* lds, const Ptrs& P, unsigned char* ws) {
    const int tid = tid_opaque(), lane = tid & 63, wid = tid >> 6;
    LAS float* scr = (LAS float*)(lds + 65536 + wid * 8448);
    const int gw = blockIdx.x * 8 + wid, NGW = gridDim.x * 8;
    constexpr int I_QKV = 16 * (NQKV / 32), I_G = 16 * (NG / 32), I_BR = 3 * 8 * 32, I_OUT = 16 * 32, I_FI = 16 * (FF2 / 32), I_FO = (FFH / 64) * 32, I_FB = 64;
    constexpr int I_LAYER = I_QKV + I_G + I_BR + I_OUT + I_FI + I_FO + I_FB;
    for (int it = gw; it < 2 * I_LAYER; it += NGW) {
        const int l = it / I_LAYER; int r = it % I_LAYER;
        unsigned char* wl = ws + WS_W + (size_t)l * W_LAYER;
        if (r < I_QKV) { const int nb = r % (NQKV / 32), kb = r / (NQKV / 32), n0 = 32 * nb;
            transpose_item(P.w_in + (size_t)l * D * NIN, NIN, n0 < 2304 ? n0 : n0 + 8, 64 * kb, (bf16_t*)(wl + W_QKV), D, n0, scr, lane); continue; } r -= I_QKV;
        if (r < I_G) { const int nb = r % (NG / 32), kb = r / (NG / 32), n0 = 32 * nb;
            transpose_item(P.w_in + (size_t)l * D * NIN, NIN, G_SRC + n0, 64 * kb, (bf16_t*)(wl + W_G), D, n0, scr, lane); continue; } r -= I_G;
        if (r < I_BR) { const int k = r / 256, rr = r % 256, nb = rr % 32, kb = rr / 32;
            transpose_item(P.w_branch + ((size_t)l * 3 + k) * 512 * D, D, 32 * nb, 64 * kb, (bf16_t*)(wl + W_BR), 512, k * D + 32 * nb, scr, lane); continue; } r -= I_BR;
        if (r < I_OUT) { const int nb = r % 32, kb = r / 32;
            transpose_item(P.w_out + (size_t)l * D * D, D, 32 * nb, 64 * kb, (bf16_t*)(wl + W_OUT), D, 32 * nb, scr, lane); continue; } r -= I_OUT;
        if (r < I_FI) { const int nb = r % (FF2 / 32), kb = r / (FF2 / 32), n0 = 32 * nb, pn = n0 >> 8, w = n0 & 255;
            const int src = w < 128 ? 128 * pn + w : FFH + 128 * pn + (w - 128);
            transpose_item(P.w_ffn_in + (size_t)l * D * FF2, FF2, src, 64 * kb, (bf16_t*)(wl + W_FI), D, n0, scr, lane); continue; } r -= I_FI;
        if (r < I_FO) { const int nb = r % 32, kb = r / 32;
            transpose_item(P.w_ffn_out + (size_t)l * FFH * D, D, 32 * nb, 64 * kb, (bf16_t*)(wl + W_FO), FFH, 32 * nb, scr, lane); continue; } r -= I_FO;
        {
            const float* wsrc = P.w_in + (size_t)l * D * NIN + FB_SRC;
#pragma unroll
            for (int q = 0; q < 4; ++q) { const int n = 4 * r + q; u32x4 o0 = {0u, 0u, 0u, 0u}, o1 = {0u, 0u, 0u, 0u};
                if (n < 8) { float v[16];
#pragma unroll
                    for (int i = 0; i < 16; ++i) v[i] = wsrc[(size_t)(16 * lane + i) * NIN + n];
                    o0.x = cvt_pk_bf16(v[0], v[1]); o0.y = cvt_pk_bf16(v[2], v[3]); o0.z = cvt_pk_bf16(v[4], v[5]); o0.w = cvt_pk_bf16(v[6], v[7]);
                    o1.x = cvt_pk_bf16(v[8], v[9]); o1.y = cvt_pk_bf16(v[10], v[11]); o1.z = cvt_pk_bf16(v[12], v[13]); o1.w = cvt_pk_bf16(v[14], v[15]); }
                bf16_t* dst = (bf16_t*)(wl + W_QKV) + (size_t)(NQKV + n) * D + 16 * lane;
                *(u32x4*)dst = o0; *(u32x4*)(dst + 8) = o1; }
        }
    }
}
__device__ __forceinline__ float reduce8(const float (&a)[8], int lane) {
    float b[4], c[2];
    const bool b0 = lane & 1, b1 = lane & 2, b2 = lane & 4;
#pragma unroll
    for (int i = 0; i < 4; ++i) { const float keep = b0 ? a[2 * i + 1] : a[2 * i], send = b0 ? a[2 * i] : a[2 * i + 1]; b[i] = keep + __shfl_xor(send, 1); }
#pragma unroll
    for (int i = 0; i < 2; ++i) { const float keep = b1 ? b[2 * i + 1] : b[2 * i], send = b1 ? b[2 * i] : b[2 * i + 1]; c[i] = keep + __shfl_xor(send, 2); }
    float d = (b2 ? c[1] : c[0]) + __shfl_xor(b2 ? c[0] : c[1], 4);
    d += __shfl_xor(d, 8); d += __shfl_xor(d, 16); d += __shfl_xor(d, 32);
    return d;
}
template <bool FB>
__device__ __forceinline__ void norm_phase(LAS unsigned char* lds, const float* xin, const float* g, const float* shift0, const float* scale0, bf16_t* hout,
                                           const float* w_in_l, const float* b_forget_l, float* flog) {
    const int tid = tid_opaque(), lane = tid & 63, wid = tid >> 6;
    LAS float* wfb = (LAS float*)lds;
    if (FB) { for (int i = tid; i < 8 * D; i += 512) { const int d = i >> 3, e = i & 7; wfb[e * D + d] = w_in_l[(size_t)d * NIN + FB_SRC + e]; } __syncthreads(); }
    const int gw = blockIdx.x * 8 + wid, NGW = gridDim.x * 8;
    for (int rc = gw; rc < M / 4; rc += NGW) {
        const int row0 = rc * 4, b = row0 / SEQ;
        f32x4 v[4][4];
#pragma unroll
        for (int r = 0; r < 4; ++r) { const f32x4* xr = (const f32x4*)(xin + (size_t)(row0 + r) * D) + lane;
#pragma unroll
            for (int j = 0; j < 4; ++j) v[r][j] = __builtin_nontemporal_load(xr + 64 * j); }
        f32x4 am[4], sh[4];
#pragma unroll
        for (int j = 0; j < 4; ++j) { const int d = 4 * lane + 256 * j; const f32x4 gv = *(const f32x4*)(g + d), sc = *(const f32x4*)(scale0 + (size_t)b * 6144 + d);
            am[j] = gv * (1.0f + sc); sh[j] = *(const f32x4*)(shift0 + (size_t)b * 6144 + d); }
        float ss[8];
#pragma unroll
        for (int r = 0; r < 4; ++r) { float s = 0.f;
#pragma unroll
            for (int j = 0; j < 4; ++j) s += (v[r][j].x * v[r][j].x + v[r][j].y * v[r][j].y) + (v[r][j].z * v[r][j].z + v[r][j].w * v[r][j].w);
            ss[r] = s; ss[r + 4] = 0.f; }
        const float tot = reduce8(ss, lane);
        const float rs = 1.0f / sqrtf(tot * (1.0f / D) + EPS);
#pragma unroll
        for (int r = 0; r < 4; ++r) { const float rstd = __uint_as_float(__builtin_amdgcn_readlane(__float_as_uint(rs), r));
            u32x2* o8 = (u32x2*)(hout + (size_t)(row0 + r) * D) + lane;
#pragma unroll
            for (int j = 0; j < 4; ++j) { v[r][j] = v[r][j] * rstd * am[j] + sh[j]; u32x2 w; w.x = cvt_pk_bf16(v[r][j].x, v[r][j].y); w.y = cvt_pk_bf16(v[r][j].z, v[r][j].w); o8[64 * j] = w; } }
        if (FB) {
            float pe[4][8];
#pragma unroll
            for (int e = 0; e < 8; ++e) { f32x4 wv[4];
#pragma unroll
                for (int j = 0; j < 4; ++j) wv[j] = *(LAS const f32x4*)(wfb + e * D + 4 * lane + 256 * j);
#pragma unroll
                for (int r = 0; r < 4; ++r) { float a = 0.f;
#pragma unroll
                    for (int j = 0; j < 4; ++j) a += (v[r][j].x * wv[j].x + v[r][j].y * wv[j].y) + (v[r][j].z * wv[j].z + v[r][j].w * wv[j].w);
                    pe[r][e] = a; } }
            const float bfv = b_forget_l[lane & 7];
#pragma unroll
            for (int r = 0; r < 4; ++r) { const float f = reduce8(pe[r], lane) + bfv; if (lane < 8) flog[(size_t)(row0 + r) * 8 + lane] = f; }
        }
    }
}
__device__ __forceinline__ void cumsum_lds(LAS unsigned char* lds, const float* flog, int b, int h) {
    const int tid = tid_opaque(), lane = tid & 63, wid = tid >> 6;
    LAS float* wt = (LAS float*)(lds + att::LDS_REL);
    LAS float* ckL = (LAS float*)(lds + att::LDS_CUM);
    float v[4]; float run = 0.f;
#pragma unroll
    for (int i = 0; i < 4; ++i) { const float f = flog[((size_t)b * SEQ + 4 * tid + i) * 8 + h];
        const float ls = fminf(f, 0.f) - log1pf(expf(-fabsf(f))); run += ls; v[i] = run; }
    float inc = run;
#pragma unroll
    for (int o = 1; o < 64; o <<= 1) { const float t = __shfl_up(inc, o); if (lane >= o) inc += t; }
    if (lane == 63) wt[wid] = inc;
    __syncthreads();
    float base = inc - run;
    for (int w8 = 0; w8 < wid; ++w8) base += wt[w8];
    f32x4 o4 = {(v[0] + base) * LOG2E, (v[1] + base) * LOG2E, (v[2] + base) * LOG2E, (v[3] + base) * LOG2E};
    *(LAS f32x4*)(ckL + 4 * tid) = o4;
    __syncthreads();
}
__device__ __forceinline__ void final_norm_phase(float* x, const float* g) {
    const int tid = tid_opaque(), lane = tid & 63, wid = tid >> 6;
    const int gw = blockIdx.x * 8 + wid, NGW = gridDim.x * 8;
    f32x4 gv[4];
#pragma unroll
    for (int j = 0; j < 4; ++j) gv[j] = *(const f32x4*)(g + 4 * lane + 256 * j);
    for (int row = gw; row < M; row += NGW) {
        f32x4* xr = (f32x4*)(x + (size_t)row * D) + lane;
        f32x4 v[4]; float s = 0.f;
#pragma unroll
        for (int j = 0; j < 4; ++j) { v[j] = xr[64 * j]; s += (v[j].x * v[j].x + v[j].y * v[j].y) + (v[j].z * v[j].z + v[j].w * v[j].w); }
        const float rstd = 1.0f / sqrtf(wave_sum(s) * (1.0f / D) + EPS);
#pragma unroll
        for (int j = 0; j < 4; ++j) xr[64 * j] = v[j] * rstd * gv[j];
    }
}


#define XB_TMO      128
#define XB_XCNT(j)  (256  + 64 * (j))
#define XB_XSUB(j)  (1280 + 64 * (j))
#define XB_XGEN(j)  (2304 + 64 * (j))
#define XB_TOP      3328
#define XB_TOPGEN   3392
#define XCD_BAR_WORDS 3456
#define XB_SPIN_CAP (1u << 18)
__device__ __forceinline__ unsigned xb_ld(unsigned* p)              { return __hip_atomic_load(p, __ATOMIC_RELAXED, __HIP_MEMORY_SCOPE_AGENT); }
__device__ __forceinline__ unsigned xb_add(unsigned* p, unsigned v) { return __hip_atomic_fetch_add(p, v, __ATOMIC_RELAXED, __HIP_MEMORY_SCOPE_AGENT); }
__device__ __forceinline__ unsigned xb_xcc_id() { return (unsigned)__builtin_amdgcn_s_getreg((3 << 11) | 20) & 0xFu; }
#define XB_SPIN(cond, bar) do { unsigned _sp = 0; while (cond) { __builtin_amdgcn_s_sleep(1); \
    if ((++_sp & 255u) == 0u) { if (xb_ld(&(bar)[XB_TMO])) break; if (_sp > XB_SPIN_CAP) { atomicAdd(&(bar)[XB_TMO], 1u); break; } } } } while (0)
__device__ __forceinline__ void xcd_barrier_complete(unsigned* bar, unsigned x, unsigned& nloc, unsigned& nx) {
    const unsigned G = gridDim.x * gridDim.y * gridDim.z;
    unsigned sum, cnt, mine, sp = 0u;
    for (;;) {
        sum = 0u; cnt = 0u; mine = 0u;
#pragma unroll
        for (unsigned j = 0; j < 16; ++j) { const unsigned c = xb_ld(&bar[XB_XCNT(j)]); sum += c; cnt += (c > 0u) ? 1u : 0u; mine = (j == x) ? c : mine; }
        if (sum == G) break;
        __builtin_amdgcn_s_sleep(1);
        if ((++sp & 255u) == 0u) { if (xb_ld(&bar[XB_TMO])) break; if (sp > XB_SPIN_CAP) { atomicAdd(&bar[XB_TMO], 1u); break; } }
    }
    nloc = mine > 0u ? mine : 1u; nx = cnt > 0u ? cnt : 1u;
}
__device__ __forceinline__ void xcd_barrier(unsigned* bar, volatile LAS unsigned* st) {
    asm volatile("s_waitcnt vmcnt(0)" ::: "memory");
    __syncthreads();
    if (threadIdx.x == 0) {
        const unsigned x = xb_xcc_id();
        __builtin_amdgcn_s_waitcnt(0);
        unsigned nloc = st[0], nx = st[1];
        if (nloc == 0u) { xcd_barrier_complete(bar, x, nloc, nx); st[0] = nloc; st[1] = nx; }
        const unsigned old = xb_add(&bar[XB_XSUB(x)], 1u);
        const unsigned gen = old / nloc;
        if (old + 1u == (gen + 1u) * nloc) {
            __builtin_amdgcn_fence(__ATOMIC_RELEASE, "agent");
            asm volatile("s_waitcnt vmcnt(0)" ::: "memory");
            const unsigned og = xb_add(&bar[XB_TOP], 1u);
            const unsigned tg = og / nx;
            if (og + 1u == (tg + 1u) * nx) xb_add(&bar[XB_TOPGEN], 1u);
            else XB_SPIN(xb_ld(&bar[XB_TOPGEN]) == tg, bar);
            __builtin_amdgcn_fence(__ATOMIC_ACQUIRE, "agent");
            xb_add(&bar[XB_XGEN(x)], 1u);
            asm volatile("s_waitcnt vmcnt(0)" ::: "memory");
        } else {
            XB_SPIN(xb_ld(&bar[XB_XGEN(x)]) == gen, bar);
            __builtin_amdgcn_fence(__ATOMIC_ACQUIRE, "agent");
            asm volatile("s_waitcnt vmcnt(0)" ::: "memory");
        }
    }
    __syncthreads();
}

constexpr int LDS_BYTES = 147456;
constexpr int N_PHASES = 20;
#ifndef PH_MASK
#define PH_MASK 0xFFFF
#endif
#define PHON(k) ((PH_MASK >> (k)) & 1)
struct Args { Ptrs p; float* out; unsigned char* ws; int ph_lo, ph_hi; };

__global__ void __launch_bounds__(512, 2) fwd_kernel(Args a) {
    extern __shared__ __attribute__((aligned(16))) unsigned char lds_raw[];
    LAS unsigned char* lds = (LAS unsigned char*)lds_raw;
    cg::grid_group grid = cg::this_grid();
    volatile LAS unsigned* bst = (volatile LAS unsigned*)(lds + LDS_BYTES - 128);
    if (threadIdx.x == 0) { bst[0] = 0u; bst[1] = 0u; }
    __syncthreads();
    const Ptrs& P = a.p;
#ifdef PROBE_MASK
    #define pst ((LAS unsigned long long*)(unsigned)(LDS_BYTES - 64))
    if (threadIdx.x == 0) { pst[0] = __builtin_amdgcn_s_memrealtime(); pst[1] = 0; pst[2] = 0; }
#define PROBE_KIND(p) ((p) == 0 ? 0 : ((p) == N_PHASES - 1 ? 10 : ((((p) - 1) % 9) == 0 ? 1 : ((((p) - 1) % 9) + 1))))
#define PROBE_STEP(p) do { if (threadIdx.x == 0) { const unsigned long long t_now = __builtin_amdgcn_s_memrealtime(); \
        if ((PROBE_MASK >> PROBE_KIND(p)) & 1) pst[1] += ((PROBE_MASK >> 16) & 1) ? (t_now - pst[2]) : (((PROBE_MASK >> 17) & 1) ? (pst[2] - pst[0]) : (t_now - pst[0])); pst[0] = t_now; } } while (0)
#endif
    if (a.ph_hi - a.ph_lo > 1) {
        if (blockIdx.x == 0) { unsigned* z = (unsigned*)(a.ws + WS_BAR); for (int i = threadIdx.x; i < (int)(WS_ZERO_BYTES / 4); i += 512) z[i] = 0u; }
        grid.sync();
        if (threadIdx.x == 0) xb_add(&((unsigned*)(a.ws + WS_BAR))[XB_XCNT(xb_xcc_id())], 1u);
    }
    const bool fuse_norm = (gridDim.x == 256) && (a.ph_hi - a.ph_lo > 1);
    for (int ph = a.ph_lo; ph < a.ph_hi; ++ph) {
        if (fuse_norm && (ph == N_PHASES - 1 || (ph >= 1 && (ph - 1) % 9 == 6) || ph == 10)) continue;
#ifdef PROBE_MASK
        if (ph > a.ph_lo && threadIdx.x == 0) pst[2] = __builtin_amdgcn_s_memrealtime();
#endif
        if (ph > a.ph_lo) xcd_barrier((unsigned*)(a.ws + WS_BAR), bst);
#ifdef PROBE_MASK
        if (ph > a.ph_lo) PROBE_STEP(ph - 1);
#endif
        unsigned char* ws = a.ws; float* outp = a.out; int G = gridDim.x, bx = blockIdx.x;
        asm volatile("" : "+s"(ws), "+s"(outp), "+s"(G), "+s"(bx));
        float* mod = (float*)(ws + WS_MOD); float* flog = (float*)(ws + WS_FLOG); const float* cumL = nullptr;
        bf16_t* hbuf = (bf16_t*)(ws + WS_H); bf16_t* proj = (bf16_t*)(ws + WS_PROJ); bf16_t* act = (bf16_t*)(ws + WS_PROJ);
        if (ph == 0) {
            if (PHON(9)) mod_phase(lds, P.c, P.w_ada, P.b_ada, mod); if (PHON(10)) convert_phase(lds, P, ws); continue; }
        if (ph == N_PHASES - 1) { if (PHON(11)) final_norm_phase(outp, P.final_norm_g); continue; }
        const int l = (ph - 1) / 9, sp = (ph - 1) % 9;
        const unsigned char* wl = ws + WS_W + (size_t)l * W_LAYER;
        const float* modl = mod + (size_t)l * 8 * 6144;
        const float* xin = l == 0 ? P.x : outp;
        switch (sp) {
        case 0: if (PHON(0)) norm_phase<false>(lds, xin, P.norm_mix_g + l * D, modl + 0 * D, modl + 1 * D, hbuf, nullptr, nullptr, nullptr); break;
        case 1: if (PHON(1)) {
            pg8::Gemm g{hbuf, (const bf16_t*)(wl + W_QKV), M, NQKVF, D, D}; pg8::StaticOrder S; S.init(M, NQKVF, G, bx);
            pg8::EpiQKV E{proj, flog, P.b_forget + l * 8}; pg8::gemm_phase(lds, g, S, E); } break;
        case 2: if (PHON(2)) {
            for (int v0 = bx; v0 < 256; v0 += G) {
                const int v = (G == 256) ? ((v0 & 7) * 32 + (v0 >> 3)) : v0;
                const int bh = v >> 2, j = v & 3, b = bh >> 3, h = bh & 7;
                cumsum_lds(lds, flog, b, h);
                {
                    LAS float* relX = (LAS float*)(lds + att::LDS_REL); const float* relh = P.rel_bias + l * 8 * 257 + h * 257;
                    for (int i = tid_opaque(); i < 321; i += 512) { const int jj = i - 64; relX[i] = relh[256 - (jj > 0 ? jj : 0)] * LOG2E; }
                    __syncthreads(); }
                const int tid_ = tid_opaque(), lane_ = tid_ & 63, wid_ = __builtin_amdgcn_readfirstlane(tid_ >> 6);
                const att::Src s1 = att::make_src(1, proj, b, h, j, lane_, wid_), s2 = att::make_src(2, proj, b, h, 2 * j, lane_, wid_), s3 = att::make_src(2, proj, b, h, 2 * j + 1, lane_, wid_),
                               s4 = att::make_src(0, proj, b, h, 2 * j, lane_, wid_), s5 = att::make_src(0, proj, b, h, 2 * j + 1, lane_, wid_);
                int cur = 0; bf16x8 qr[4];
                const float* sk = P.sinks + l * 8;
                att::unit<1>(lds, proj, sk, b, h, 7 - j, cur, false, true, s1, qr);
                att::unit<1>(lds, proj, sk, b, h, j, cur, true, true, s2, qr);
                att::unit<2>(lds, proj, sk, b, h, 2 * j, cur, true, true, s3, qr);
                att::unit<2>(lds, proj, sk, b, h, 2 * j + 1, cur, true, true, s4, qr);
                att::unit<0>(lds, proj, sk, b, h, 2 * j, cur, true, true, s5, qr);
                att::unit<0>(lds, proj, sk, b, h, 2 * j + 1, cur, true, false, s5, qr);
            } } break;
        case 3: if (PHON(3)) { pg8::Gemm g{hbuf, (const bf16_t*)(wl + W_G), M, NG, D, D}; pg8::StaticOrder S; S.init(M, NG, G, bx);
            pg8::EpiGate E{proj}; pg8::gemm_phase(lds, g, S, E); } break;
        case 4: if (PHON(4)) { pg8::Gemm g{proj, (const bf16_t*)(wl + W_BR), M, 3 * D, 512, PITCH}; pg8::BranchOrder S; S.so.init(M, D, G, bx);
            pg8::EpiBranch E{proj, hbuf}; pg8::gemm_phase(lds, g, S, E); } break;
        case 5: if (PHON(5)) { pg8::Gemm g{hbuf, (const bf16_t*)(wl + W_OUT), M, D, D, D}; pg8::StaticOrder S; S.init(M, D, G, bx);
            pg8::EpiRes E{xin, outp, modl + 2 * D, fuse_norm ? 1 : 0, (float*)(ws + WS_SLOT), (unsigned*)(ws + WS_CNT) + l * 4096, P.norm_ffn_g + l * D, modl + 3 * D, modl + 4 * D, hbuf};
            pg8::gemm_phase(lds, g, S, E); } break;
        case 6: if (PHON(6)) norm_phase<false>(lds, outp, P.norm_ffn_g + l * D, modl + 3 * D, modl + 4 * D, hbuf, nullptr, nullptr, nullptr); break;
        case 7: if (PHON(7)) { pg8::Gemm g{hbuf, (const bf16_t*)(wl + W_FI), M, FF2, D, D}; pg8::StaticOrder S; S.init(M, FF2, G, bx);
            pg8::EpiSwiglu E{act}; pg8::gemm_phase(lds, g, S, E); } break;
        case 8: if (PHON(8)) { pg8::Gemm g{act, (const bf16_t*)(wl + W_FO), M, D, FFH, FFH}; pg8::StaticOrder S; S.init(M, D, G, bx);
            const float* modn = mod + (size_t)(l + 1 < DEPTH ? l + 1 : l) * 8 * 6144;
            pg8::EpiRes E{outp, outp, modl + 5 * D, fuse_norm ? (l == DEPTH - 1 ? 2 : 1) : 0, (float*)(ws + WS_SLOT) + (size_t)M * 4, (unsigned*)(ws + WS_CNT) + (2 + l) * 4096,
                          l == DEPTH - 1 ? P.final_norm_g : P.norm_mix_g + (l + 1) * D, modn + 0 * D, modn + 1 * D, hbuf};
            pg8::gemm_phase(lds, g, S, E); } break;
        }
    }
#ifdef PROBE_MASK
    if (threadIdx.x == 0) pst[2] = __builtin_amdgcn_s_memrealtime();
    grid.sync();
    PROBE_STEP(N_PHASES - 1);
    __syncthreads();
    if (blockIdx.x == 0) { const int n = (int)((float)(unsigned)pst[1] * 0.15f); for (int i = threadIdx.x; i < n; i += 512) a.out[i] += 0.1f; }
#endif
}

extern "C" void kernel_launch(void* const* d_in, const int* in_sizes, int n_in, void* d_out, int out_size, void* d_ws, size_t ws_size, hipStream_t stream) {
    static int grid = 0;
    if (grid == 0) {
        if (n_in != 15 || out_size != M * D || ws_size < WS_END) { fprintf(stderr, "kernel_launch: unexpected shapes (n_in %d out %d ws %zu)\n", n_in, out_size, ws_size); grid = -1; return; }
        int dev = 0, cus = 0, per_cu = 0;
        hipGetDevice(&dev); hipDeviceGetAttribute(&cus, hipDeviceAttributeMultiprocessorCount, dev);
        if (hipFuncSetAttribute((const void*)fwd_kernel, hipFuncAttributeMaxDynamicSharedMemorySize, LDS_BYTES) != hipSuccess) { fprintf(stderr, "kernel_launch: hipFuncSetAttribute failed\n"); grid = -1; return; }
        if (hipOccupancyMaxActiveBlocksPerMultiprocessor(&per_cu, (const void*)fwd_kernel, 512, LDS_BYTES) != hipSuccess || per_cu < 1) { fprintf(stderr, "kernel_launch: occupancy query gave %d\n", per_cu); per_cu = 1; }
        (void)hipGetLastError();
        grid = cus * (per_cu > 1 ? 1 : per_cu);
        if (grid > 256) grid = 256;
    }
    if (grid < 0) return;
    Args a{};
    const float** pp = (const float**)&a.p;
    for (int i = 0; i < 15; ++i) pp[i] = (const float*)d_in[i];
    a.out = (float*)d_out; a.ws = (unsigned char*)d_ws;
#if N_LAUNCH_MODE
    for (int ph = 0; ph < N_PHASES; ++ph) { a.ph_lo = ph; a.ph_hi = ph + 1; hipLaunchKernelGGL(fwd_kernel, dim3(grid), dim3(512), LDS_BYTES, stream, a); }
#else
    a.ph_lo = 0; a.ph_hi = N_PHASES;
    void* args[] = {&a};
    hipError_t e = hipLaunchCooperativeKernel((const void*)fwd_kernel, dim3(grid), dim3(512), args, LDS_BYTES, stream);
    if (e != hipSuccess) fprintf(stderr, "cooperative launch failed: %s (grid %d)\n", hipGetErrorString(e), grid);
#endif
}
```

```cpp
#include <hip/hip_runtime.h>
#include <hip/hip_cooperative_groups.h>
#include <cstdio>
#include <cstdint>
namespace cg = cooperative_groups;

#ifndef N_LAUNCH_MODE
#define N_LAUNCH_MODE 0
#endif

#define LAS __attribute__((address_space(3)))
typedef unsigned short bf16_t;
typedef short bf16x8 __attribute__((ext_vector_type(8)));
typedef short s16x4 __attribute__((ext_vector_type(4)));
typedef float f32x4 __attribute__((ext_vector_type(4)));
typedef float f32x16 __attribute__((ext_vector_type(16)));
typedef unsigned u32x4 __attribute__((ext_vector_type(4)));
typedef unsigned u32x2 __attribute__((ext_vector_type(2)));

constexpr int BATCH = 8, SEQ = 2048, D = 1024, M = BATCH * SEQ, DEPTH = 2;
constexpr int NIN = 6920, FFH = 2816, FF2 = 2 * FFH;
constexpr int PITCH = 4608;
constexpr int NQKV = 3840, NQKVF = 4096, NG = 3072;
constexpr int FB_SRC = 2304;
constexpr int G_SRC = 3848;
constexpr float EPS = 1e-6f;
constexpr float LOG2E = 1.4426950408889634f;

constexpr size_t MiB = 1u << 20;
constexpr size_t WS_MOD = 0;
constexpr size_t WS_FLOG = 512 * 1024;
constexpr size_t WS_BAR = 1536 * 1024;
constexpr size_t WS_CNT = WS_BAR + 16384;
constexpr size_t WS_ZERO_BYTES = 16384 + 4 * 16384;
constexpr size_t WS_SLOT = 1024 * 1024;
constexpr size_t WS_W = 2 * MiB;
constexpr size_t W_QKV = 0, W_G = W_QKV + (size_t)NQKVF * D * 2, W_BR = W_G + (size_t)NG * D * 2, W_OUT = W_BR + (size_t)3 * D * 512 * 2,
                 W_FI = W_OUT + (size_t)D * D * 2, W_FO = W_FI + (size_t)FF2 * D * 2, W_LAYER = W_FO + (size_t)D * FFH * 2;
static_assert(W_LAYER == 35 * MiB + 512 * 1024, "weights per layer");
constexpr size_t WS_H = WS_W + 2 * W_LAYER;
constexpr size_t WS_PROJ = WS_H + (size_t)M * D * 2;
constexpr size_t WS_END = WS_PROJ + (size_t)M * PITCH * 2;
static_assert(WS_END <= 256 * MiB, "workspace");

constexpr int QA = 0, KA = 512, VA = 640, QB_ = 768, KB_ = 1280, VB_ = 1792, QC_ = 2304, KC_ = 2816, VC_ = 3328;
__host__ __device__ __forceinline__ int gate_col(int j) {
    return j == 0 ? 512 : (j < 4 ? 3840 + 256 * (j - 1) : (j < 8 ? 1280 + 256 * (j - 4) : 2816 + 256 * (j - 8)));
}

__device__ __forceinline__ unsigned cvt_pk_bf16(float lo, float hi) { unsigned r; asm volatile("v_cvt_pk_bf16_f32 %0, %1, %2" : "=v"(r) : "v"(lo), "v"(hi)); return r; }
__device__ __forceinline__ float bf_lo(unsigned w) { return __uint_as_float(w << 16); }
__device__ __forceinline__ float bf_hi(unsigned w) { return __uint_as_float(w & 0xffff0000u); }
__device__ __forceinline__ float wave_sum(float v) {
#pragma unroll
    for (int o = 1; o < 64; o <<= 1) v += __shfl_xor(v, o);
    return v;
}
__device__ __forceinline__ int tid_opaque() { int t = threadIdx.x; asm volatile("" : "+v"(t)); return t; }
__device__ __forceinline__ float sigmoidf_(float x) { return __builtin_amdgcn_rcpf(1.0f + __builtin_amdgcn_exp2f(-LOG2E * x)); }

__device__ __forceinline__ float reduce8(const float (&a)[8], int lane);
namespace pg8 {
constexpr int BM = 256, BK = 64, HALF = 128, HTB = HALF * BK * 2, STAGE_BYTES = 8 * HTB, NXCD = 8, WGM = 8;
__host__ __device__ __forceinline__ int lds_byte(int r, int c) { const int st = (r >> 4) * 2 + (c >> 5), rr = r & 15, cc = c & 31, ob = rr * 64 + cc * 2; return st * 1024 + (ob ^ (((ob >> 9) & 1) << 5)); }
__host__ __device__ __forceinline__ void stage_rc(int b, int& R, int& C) { const int st = b / 1024, sb = b % 1024, swz = sb ^ (((sb >> 9) & 1) << 5); R = (st >> 1) * 16 + swz / 64; C = (st & 1) * 32 + (swz % 64) / 2; }
__host__ __device__ __forceinline__ int perm32(int rho) { const int n = rho >> 4, i = rho & 15; return 8 * (i >> 2) + 4 * n + (i & 3); }

struct Unit { int pm, pn, k; };
struct Gemm { const bf16_t* A; const bf16_t* Bt; int M, N, K, lda; };

struct StaticOrder {
    int nM, nN, nwg, G, c;
    __device__ void init(int M_, int N_, int G_, int c_) { nM = M_ / BM; nN = N_ / BM; nwg = nM * nN; G = G_; c = c_; }
    __device__ __forceinline__ bool tile(int i, int& pm, int& pn) const {
        const long L = (long)i * G + c; if (L >= nwg) return false;
        int wgid = (int)L; { const int q = nwg / NXCD, r = nwg % NXCD, xcd = wgid % NXCD, off = wgid / NXCD; wgid = (xcd < r ? xcd * (q + 1) : r * (q + 1) + (xcd - r) * q) + off; }
        const int nig = WGM * nN, gid = wgid / nig, fm = gid * WGM, gsz = (nM - fm) < WGM ? (nM - fm) : WGM;
        pm = fm + ((wgid % nig) % gsz); pn = (wgid % nig) / gsz; return true;
    }
    __device__ __forceinline__ bool next(int i, Unit& u) const { u.k = 0; return tile(i, u.pm, u.pn); }
    __device__ __forceinline__ size_t a_off(const Unit&) const { return 0; }
};
struct BranchOrder {
    StaticOrder so;
    __device__ __forceinline__ bool next(int i, Unit& u) const { int pm, cn; if (!so.tile(i / 3, pm, cn)) return false; u.k = i % 3; u.pm = pm; u.pn = 4 * u.k + cn; return true; }
    __device__ __forceinline__ size_t a_off(const Unit& u) const { return (size_t)(u.k == 0 ? QA : (u.k == 1 ? QB_ : QC_)) * 2; }
};

struct EpiQKV {
    static constexpr bool PERM = true, AFTER_DRAIN = false;
    bf16_t* O; float* flog; const float* bfg;
    __device__ __forceinline__ bool keep(const Unit&) const { return false; }
    __device__ __forceinline__ void operator()(f32x4 (&acc)[2][2][4][2], const Unit& u, int wr, int wc, int fr, int fq) const {
        if (u.pn == 15) {
            if (wc == 0 && fq == 0) {
                const f32x4 b0 = *(const f32x4*)(bfg), b1 = *(const f32x4*)(bfg + 4);
#pragma unroll
                for (int ai = 0; ai < 2; ++ai)
#pragma unroll
                    for (int m = 0; m < 4; ++m) { float* fp = flog + (size_t)(u.pm * BM + ai * HALF + wr * 64 + m * 16 + fr) * 8;
                        *(f32x4*)fp = acc[ai][0][m][0] + b0; *(f32x4*)(fp + 4) = acc[ai][0][m][1] + b1; }
            }
            return;
        }
        const int row0 = u.pm * BM + wr * 64 + fr, col0 = u.pn * BM + wc * 32 + 8 * fq;
        const bool isq = (u.pn < 2) || (u.pn == 3) || (u.pn == 4) || (u.pn == 9) || (u.pn == 10);
        const float qs = isq ? 0.125f * LOG2E : 1.0f;
#pragma unroll
        for (int ai = 0; ai < 2; ++ai)
#pragma unroll
            for (int m = 0; m < 4; ++m) { bf16_t* rowp = O + (size_t)(row0 + ai * HALF + m * 16) * PITCH + col0;
#pragma unroll
                for (int bj = 0; bj < 2; ++bj) { const f32x4 v0 = acc[ai][bj][m][0] * qs, v1 = acc[ai][bj][m][1] * qs;
                    u32x4 w; w.x = cvt_pk_bf16(v0[0], v0[1]); w.y = cvt_pk_bf16(v0[2], v0[3]); w.z = cvt_pk_bf16(v1[0], v1[1]); w.w = cvt_pk_bf16(v1[2], v1[3]);
                    *(u32x4*)(rowp + bj * HALF) = w; } }
    }
};
struct EpiGate {
    static constexpr bool PERM = true, AFTER_DRAIN = false;
    bf16_t* O;
    __device__ __forceinline__ bool keep(const Unit&) const { return false; }
    __device__ __forceinline__ void operator()(f32x4 (&acc)[2][2][4][2], const Unit& u, int wr, int wc, int fr, int fq) const {
        const int row0 = u.pm * BM + wr * 64 + fr, col0 = gate_col(u.pn) + wc * 32 + 8 * fq;
#pragma unroll
        for (int ai = 0; ai < 2; ++ai)
#pragma unroll
            for (int m = 0; m < 4; ++m) { bf16_t* rowp = O + (size_t)(row0 + ai * HALF + m * 16) * PITCH + col0;
#pragma unroll
                for (int bj = 0; bj < 2; ++bj) { f32x4 v0 = acc[ai][bj][m][0], v1 = acc[ai][bj][m][1];
#pragma unroll
                    for (int i = 0; i < 4; ++i) { v0[i] = fmaxf(sigmoidf_(v0[i]), 1e-6f); v1[i] = fmaxf(sigmoidf_(v1[i]), 1e-6f); }
                    u32x4 w; w.x = cvt_pk_bf16(v0[0], v0[1]); w.y = cvt_pk_bf16(v0[2], v0[3]); w.z = cvt_pk_bf16(v1[0], v1[1]); w.w = cvt_pk_bf16(v1[2], v1[3]);
                    *(u32x4*)(rowp + bj * HALF) = w; } }
    }
};
struct EpiBranch {
    static constexpr bool PERM = true, AFTER_DRAIN = false;
    const bf16_t* P; bf16_t* O;
    __device__ __forceinline__ bool keep(const Unit& u) const { return u.k < 2; }
    __device__ __forceinline__ void operator()(f32x4 (&acc)[2][2][4][2], const Unit& u, int wr, int wc, int fr, int fq) const {
        const int cn = u.pn & 3, k = u.k;
        const int row0 = u.pm * BM + wr * 64 + fr, cofs = wc * 32 + 8 * fq;
        const int gc0 = gate_col(4 * k + cn) + cofs, gc1 = gate_col(4 * (k < 2 ? k + 1 : 2) + cn) + cofs;
#pragma unroll
        for (int ai = 0; ai < 2; ++ai)
#pragma unroll
            for (int m = 0; m < 4; ++m) { const size_t ro = (size_t)(row0 + ai * HALF + m * 16);
#pragma unroll
                for (int bj = 0; bj < 2; ++bj) {
                    const u32x4 ga = __builtin_nontemporal_load((const u32x4*)(P + ro * PITCH + gc0 + bj * HALF));
                    float s[8] = {bf_lo(ga.x), bf_hi(ga.x), bf_lo(ga.y), bf_hi(ga.y), bf_lo(ga.z), bf_hi(ga.z), bf_lo(ga.w), bf_hi(ga.w)};
                    if (k < 2) { const u32x4 gb = *(const u32x4*)(P + ro * PITCH + gc1 + bj * HALF);
                        const float t[8] = {bf_lo(gb.x), bf_hi(gb.x), bf_lo(gb.y), bf_hi(gb.y), bf_lo(gb.z), bf_hi(gb.z), bf_lo(gb.w), bf_hi(gb.w)};
#pragma unroll
                        for (int i = 0; i < 8; ++i) s[i] = s[i] * __builtin_amdgcn_rcpf(t[i]); }
                    f32x4 v0 = acc[ai][bj][m][0], v1 = acc[ai][bj][m][1];
#pragma unroll
                    for (int i = 0; i < 4; ++i) { v0[i] *= s[i]; v1[i] *= s[4 + i]; }
                    if (k < 2) { acc[ai][bj][m][0] = v0; acc[ai][bj][m][1] = v1; }
                    else { u32x4 w; w.x = cvt_pk_bf16(v0[0], v0[1]); w.y = cvt_pk_bf16(v0[2], v0[3]); w.z = cvt_pk_bf16(v1[0], v1[1]); w.w = cvt_pk_bf16(v1[2], v1[3]);
                        *(u32x4*)(O + ro * D + cn * BM + cofs + bj * HALF) = w; } } }
    }
};
struct EpiRes {
    static constexpr bool PERM = false, AFTER_DRAIN = true;
    __device__ __forceinline__ void fused(f32x4 (&acc)[2][2][4][2], const Unit& u, int wr, int wc, int fr, int fq, LAS unsigned char* lds, int wid, int lane) const {
        constexpr int TP = 260;
        LAS float* T = (LAS float*)lds;
        const int b = u.pm >> 3, colg = u.pn * BM + 4 * lane;
        const f32x4 gg = *(const f32x4*)(gmod + (size_t)b * 6144 + colg);
        f32x4 xk[32];
#pragma unroll
        for (int ai = 0; ai < 2; ++ai) {
#pragma unroll
            for (int m = 0; m < 4; ++m)
#pragma unroll
                for (int bj = 0; bj < 2; ++bj)
#pragma unroll
                    for (int n = 0; n < 2; ++n) *(LAS f32x4*)(T + (wr * 64 + m * 16 + fr) * TP + bj * HALF + wc * 32 + n * 16 + 4 * fq) = acc[ai][bj][m][n];
            asm volatile("s_waitcnt lgkmcnt(0)" ::: "memory"); __builtin_amdgcn_s_barrier(); asm volatile("" ::: "memory");
#pragma unroll
            for (int hb = 0; hb < 2; ++hb) { f32x4 bs[8]; float ss[8];
#pragma unroll
                for (int rr = 0; rr < 8; ++rr) { const int rl = wid + 8 * (hb * 8 + rr); bs[rr] = __builtin_nontemporal_load((const f32x4*)(base + (size_t)(u.pm * BM + ai * HALF + rl) * D + colg)); }
#pragma unroll
                for (int rr = 0; rr < 8; ++rr) { const int rl = wid + 8 * (hb * 8 + rr); const f32x4 v = *(LAS const f32x4*)(T + rl * TP + 4 * lane);
                    const f32x4 o = bs[rr] + gg * v; ss[rr] = (o.x * o.x + o.y * o.y) + (o.z * o.z + o.w * o.w);
                    xk[ai * 16 + hb * 8 + rr] = o;
                    if (mode != 2) *(f32x4*)(out + (size_t)(u.pm * BM + ai * HALF + rl) * D + colg) = o; }
                if (mode != 0) {
                    const float tot = reduce8(ss, lane);
                    if (lane < 8) { const int rl = wid + 8 * (hb * 8 + lane);
                        __hip_atomic_store(slots + (size_t)(u.pm * BM + ai * HALF + rl) * 4 + u.pn, tot, __ATOMIC_RELAXED, __HIP_MEMORY_SCOPE_AGENT); }
                } }
            asm volatile("s_waitcnt lgkmcnt(0)" ::: "memory"); __builtin_amdgcn_s_barrier(); asm volatile("" ::: "memory");
        }
        if (mode == 0) return;
        asm volatile("s_waitcnt vmcnt(0)" ::: "memory");
        unsigned* pc = cnt + 64 * u.pm;
        if (lane == 0) __hip_atomic_fetch_add(pc, 1u, __ATOMIC_RELAXED, __HIP_MEMORY_SCOPE_AGENT);
        if (wid == 0) {
            unsigned sp = 0;
            while ((unsigned)__builtin_amdgcn_readfirstlane(__hip_atomic_load(pc, __ATOMIC_RELAXED, __HIP_MEMORY_SCOPE_AGENT)) < 32u) { __builtin_amdgcn_s_sleep(2); if (++sp > (1u << 18)) break; }
            __builtin_amdgcn_fence(__ATOMIC_ACQUIRE, "agent");
        }
        asm volatile("s_waitcnt vmcnt(0) lgkmcnt(0)" ::: "memory"); __builtin_amdgcn_s_barrier(); asm volatile("" ::: "memory");
        float rs;
        { const int k = lane & 31, rl = wid + 8 * (k & 15); const float* sl = slots + (size_t)(u.pm * BM + (k >> 4) * HALF + rl) * 4;
          const float t = (__hip_atomic_load(sl + 0, __ATOMIC_RELAXED, __HIP_MEMORY_SCOPE_AGENT) + __hip_atomic_load(sl + 1, __ATOMIC_RELAXED, __HIP_MEMORY_SCOPE_AGENT))
                        + (__hip_atomic_load(sl + 2, __ATOMIC_RELAXED, __HIP_MEMORY_SCOPE_AGENT) + __hip_atomic_load(sl + 3, __ATOMIC_RELAXED, __HIP_MEMORY_SCOPE_AGENT));
          rs = 1.0f / sqrtf(t * (1.0f / D) + EPS); }
        f32x4 am, sh;
        { const f32x4 gv = *(const f32x4*)(ng + colg);
          if (mode == 1) { am = gv * (1.0f + *(const f32x4*)(nscale + (size_t)b * 6144 + colg)); sh = *(const f32x4*)(nshift + (size_t)b * 6144 + colg); }
          else { am = gv; sh = (f32x4){0.f, 0.f, 0.f, 0.f}; } }
#pragma unroll
        for (int kb = 0; kb < 4; ++kb) {
#pragma unroll
            for (int rr = 0; rr < 8; ++rr) { const int k = kb * 8 + rr, rl = wid + 8 * (k & 15); const size_t ro = (size_t)(u.pm * BM + (k >> 4) * HALF + rl);
                const float rstd = __uint_as_float(__builtin_amdgcn_readlane(__float_as_uint(rs), k));
                const f32x4 hv = xk[k] * rstd * am + sh;
                if (mode == 1) { u32x2 w; w.x = cvt_pk_bf16(hv.x, hv.y); w.y = cvt_pk_bf16(hv.z, hv.w); *(u32x2*)(hn + ro * D + colg) = w; }
                else *(f32x4*)(out + ro * D + colg) = hv; } }
    }
    const float* base; float* out; const float* gmod;
    int mode; float* slots; unsigned* cnt; const float* ng; const float* nshift; const float* nscale; bf16_t* hn;
    __device__ __forceinline__ bool keep(const Unit&) const { return false; }
    __device__ __forceinline__ void operator()(f32x4 (&acc)[2][2][4][2], const Unit& u, int wr, int wc, int fr, int fq) const {
        const int b = u.pm >> 3;
        const int col0 = u.pn * BM + wc * 32 + 4 * fq;
        const float* gv = gmod + (size_t)b * 6144 + col0;
        f32x4 gg[2][2];
#pragma unroll
        for (int bj = 0; bj < 2; ++bj)
#pragma unroll
            for (int n = 0; n < 2; ++n) gg[bj][n] = *(const f32x4*)(gv + bj * HALF + n * 16);
#pragma unroll
        for (int ai = 0; ai < 2; ++ai)
#pragma unroll
            for (int m = 0; m < 4; ++m) { const size_t off = (size_t)(u.pm * BM + ai * HALF + wr * 64 + m * 16 + fr) * D + col0;
#pragma unroll
                for (int bj = 0; bj < 2; ++bj)
#pragma unroll
                    for (int n = 0; n < 2; ++n) { const f32x4 bs = *(const f32x4*)(base + off + bj * HALF + n * 16);
                        *(f32x4*)(out + off + bj * HALF + n * 16) = bs + gg[bj][n] * acc[ai][bj][m][n]; } }
    }
};
struct EpiSwiglu {
    static constexpr bool PERM = true, AFTER_DRAIN = false;
    bf16_t* O;
    __device__ __forceinline__ bool keep(const Unit&) const { return false; }
    __device__ __forceinline__ void operator()(f32x4 (&acc)[2][2][4][2], const Unit& u, int wr, int wc, int fr, int fq) const {
        const int row0 = u.pm * BM + wr * 64 + fr, col0 = u.pn * HALF + wc * 32 + 8 * fq;
#pragma unroll
        for (int ai = 0; ai < 2; ++ai)
#pragma unroll
            for (int m = 0; m < 4; ++m) { bf16_t* rowp = O + (size_t)(row0 + ai * HALF + m * 16) * FFH + col0;
                f32x4 r0, r1;
#pragma unroll
                for (int i = 0; i < 4; ++i) { const float g0 = acc[ai][0][m][0][i], g1 = acc[ai][0][m][1][i];
                    r0[i] = g0 * sigmoidf_(g0) * acc[ai][1][m][0][i]; r1[i] = g1 * sigmoidf_(g1) * acc[ai][1][m][1][i]; }
                u32x4 w; w.x = cvt_pk_bf16(r0[0], r0[1]); w.y = cvt_pk_bf16(r0[2], r0[3]); w.z = cvt_pk_bf16(r1[0], r1[1]); w.w = cvt_pk_bf16(r1[2], r1[3]);
                *(u32x4*)rowp = w; }
    }
};

template <class Epi, class Sched>
__device__ __forceinline__ void gemm_phase(LAS unsigned char* lds, const Gemm g, const Sched& S, const Epi& E) {
    const int tid = tid_opaque(), wid = __builtin_amdgcn_readfirstlane(tid >> 6), lane = tid & 63, wr = wid >> 2, wc = wid & 3, fr = lane & 15, fq = lane >> 4;
    const int K = g.K, nt = K / BK, lda = g.lda;
    unsigned voffA[2], voffB[2];
#pragma unroll
    for (int i = 0; i < 2; ++i) { int R, C; stage_rc(tid * 16 + i * 8192, R, C); const int Rb = Epi::PERM ? ((R & ~31) + perm32(R & 31)) : R;
        voffA[i] = (unsigned)(R * lda + C) * 2u; voffB[i] = (unsigned)(Rb * K + C) * 2u; }
    const size_t kstep = (size_t)(BK * 2);
    const size_t hstepA = (size_t)HALF * lda * 2, hstepB = (size_t)HALF * K * 2;
    const size_t tstepA = 2 * hstepA, tstepB = 2 * hstepB;
    const unsigned ldsw = (unsigned)wid * 1024u;
    const int aoff = lds_byte(wr * 64 + fr, fq * 8), boff = lds_byte(wc * 32 + fr, fq * 8);
#define PG8_SA(b, h) (((b) * 2 + (h)) * HTB)
#define PG8_SB(b, h) ((4 + (b) * 2 + (h)) * HTB)
#define PG8_STAGE(bufoff, gbase, voff) do { _Pragma("unroll") for (int _i = 0; _i < 2; ++_i) \
        __builtin_amdgcn_global_load_lds((const unsigned*)((const char*)(gbase) + (voff)[_i]), (LAS unsigned*)(lds + (bufoff) + ldsw + _i * 8192), 16, 0, 0); } while (0)
#define PG8_LDA(dst, b, h) do { _Pragma("unroll") for (int m = 0; m < 4; ++m) _Pragma("unroll") for (int k = 0; k < 2; ++k) dst[m][k] = *(const LAS bf16x8*)(lds + PG8_SA(b, h) + aoff + m * 2048 + k * 1024); } while (0)
#define PG8_LDB(dst, b, h) do { _Pragma("unroll") for (int n = 0; n < 2; ++n) _Pragma("unroll") for (int k = 0; k < 2; ++k) dst[n][k] = *(const LAS bf16x8*)(lds + PG8_SB(b, h) + boff + n * 2048 + k * 1024); } while (0)
#define PG8_MMA(ai, bj, At, Bt) do { __builtin_amdgcn_s_setprio(1); _Pragma("unroll") for (int m = 0; m < 4; ++m) _Pragma("unroll") for (int n = 0; n < 2; ++n) _Pragma("unroll") for (int k = 0; k < 2; ++k) \
        acc[ai][bj][m][n] = __builtin_amdgcn_mfma_f32_16x16x32_bf16(Bt[n][k], At[m][k], acc[ai][bj][m][n], 0, 0, 0); __builtin_amdgcn_s_setprio(0); } while (0)
#define PG8_WAIT_V(n) asm volatile("s_waitcnt vmcnt(" #n ")" ::: "memory")
#define PG8_WAIT_L(n) asm volatile("s_waitcnt lgkmcnt(" #n ")" ::: "memory")
#define PG8_BAR __builtin_amdgcn_s_barrier()
#define PG8_SCHED __builtin_amdgcn_sched_barrier(0)
    Unit cur, nxt; int ui = 0;
    if (!S.next(0, cur)) return;
    f32x4 acc[2][2][4][2];
#pragma unroll
    for (int a = 0; a < 2; ++a)
#pragma unroll
        for (int b = 0; b < 2; ++b)
#pragma unroll
            for (int m = 0; m < 4; ++m)
#pragma unroll
                for (int n = 0; n < 2; ++n) acc[a][b][m][n] = (f32x4){0.f, 0.f, 0.f, 0.f};
    bf16x8 At[4][2], B0[2][2], B1[2][2];
    const char* cA = (const char*)g.A + S.a_off(cur) + (size_t)cur.pm * tstepA; const char* cB = (const char*)g.Bt + (size_t)cur.pn * tstepB;
    PG8_STAGE(PG8_SB(0, 0), cB, voffB); PG8_STAGE(PG8_SB(0, 1), cB + hstepB, voffB); PG8_STAGE(PG8_SA(0, 0), cA, voffA); PG8_STAGE(PG8_SA(0, 1), cA + hstepA, voffA);
    if (wr == 1) PG8_BAR;
    PG8_WAIT_V(2); PG8_BAR;
    PG8_STAGE(PG8_SB(1, 0), cB + kstep, voffB); PG8_STAGE(PG8_SA(1, 0), cA + kstep, voffA); PG8_STAGE(PG8_SB(1, 1), cB + hstepB + kstep, voffB);
    PG8_WAIT_V(6); PG8_BAR;
    for (;;) {
        const bool has_next = S.next(ui + 1, nxt);
        const char* nA = has_next ? (const char*)g.A + S.a_off(nxt) + (size_t)nxt.pm * tstepA : cA; const char* nB = has_next ? (const char*)g.Bt + (size_t)nxt.pn * tstepB : cB;
        for (int t = 0; t < nt; t += 2) {
            const bool last = (t == nt - 2);
            const char* a1 = cA + (size_t)(t + 1) * kstep;
            const char* a2 = last ? nA : cA + (size_t)(t + 2) * kstep; const char* b2 = last ? nB : cB + (size_t)(t + 2) * kstep;
            const char* a3 = a2 + kstep; const char* b3 = b2 + kstep;
            PG8_LDB(B0, 0, 0); PG8_LDB(B1, 0, 1); PG8_SCHED; PG8_LDA(At, 0, 0); PG8_STAGE(PG8_SA(1, 1), a1 + hstepA, voffA);
            PG8_WAIT_V(8); PG8_WAIT_L(0); PG8_BAR; PG8_MMA(0, 0, At, B0); PG8_MMA(0, 1, At, B1); PG8_BAR; PG8_SCHED;
            PG8_LDA(At, 0, 1); PG8_STAGE(PG8_SB(0, 0), b2, voffB); PG8_STAGE(PG8_SB(0, 1), b2 + hstepB, voffB); PG8_STAGE(PG8_SA(0, 0), a2, voffA);
            PG8_WAIT_V(8); PG8_WAIT_L(0); PG8_BAR; PG8_MMA(1, 0, At, B0); PG8_MMA(1, 1, At, B1); PG8_BAR; PG8_SCHED;
            PG8_LDB(B0, 1, 0); PG8_LDB(B1, 1, 1); PG8_SCHED; PG8_LDA(At, 1, 0); PG8_STAGE(PG8_SA(0, 1), a2 + hstepA, voffA);
            PG8_WAIT_V(8); PG8_WAIT_L(0); PG8_BAR; PG8_MMA(0, 0, At, B0); PG8_MMA(0, 1, At, B1); PG8_BAR; PG8_SCHED;
            PG8_LDA(At, 1, 1); PG8_STAGE(PG8_SB(1, 0), b3, voffB); PG8_STAGE(PG8_SB(1, 1), b3 + hstepB, voffB); PG8_STAGE(PG8_SA(1, 0), a3, voffA);
            PG8_WAIT_V(8); PG8_WAIT_L(0); PG8_BAR; PG8_MMA(1, 0, At, B0); PG8_MMA(1, 1, At, B1); PG8_BAR; PG8_SCHED;
        }
        if (wr == 0) PG8_BAR;
        if (!(Epi::AFTER_DRAIN && !has_next)) E(acc, cur, wr, wc, fr, fq);
        if (!has_next) break;
        if (!E.keep(cur)) {
#pragma unroll
            for (int a = 0; a < 2; ++a)
#pragma unroll
                for (int b = 0; b < 2; ++b)
#pragma unroll
                    for (int m = 0; m < 4; ++m)
#pragma unroll
                        for (int n = 0; n < 2; ++n) acc[a][b][m][n] = (f32x4){0.f, 0.f, 0.f, 0.f};
        }
        cur = nxt; cA = nA; cB = nB; ++ui;
        if (wr == 1) PG8_BAR;
    }
    PG8_WAIT_V(0);
    PG8_BAR;
    if constexpr (Epi::AFTER_DRAIN) E.fused(acc, cur, wr, wc, fr, fq, lds, wid, lane);
#undef PG8_SA
#undef PG8_SB
#undef PG8_STAGE
#undef PG8_LDA
#undef PG8_LDB
#undef PG8_MMA
#undef PG8_WAIT_V
#undef PG8_WAIT_L
#undef PG8_BAR
#undef PG8_SCHED
}
}

namespace att {
typedef short v4i16_t __attribute__((ext_vector_type(4)));
__device__ __forceinline__ int crow(int r, int hi) { return (r & 3) + 8 * (r >> 2) + 4 * hi; }
__device__ __forceinline__ s16x4 vtr(LAS const unsigned char* p) { return __builtin_bit_cast(s16x4, __builtin_amdgcn_ds_read_tr16_b64_v4i16((LAS v4i16_t*)p)); }
constexpr float C2 = 0.125f * LOG2E;
constexpr float NEG = -1e30f;
constexpr int LDS_K = 0, LDS_V = 32768, LDS_REL = 65536, LDS_CUM = 69632;

__device__ __forceinline__ float max3f(float a, float b, float c) { return __builtin_fmaxf(__builtin_fmaxf(a, b), c); }
constexpr float THR = 8.0f;
template <int VAR>
__device__ __forceinline__ void tile(LAS unsigned char* lds, int cur, int kt, int dk, const bf16x8 (&qr)[4], float& mref, float& lrow, f32x16& o0, f32x16& o1, f32x16& negm, bool& first,
                                     LAS float* relX, LAS float* ckL, float slopeL, const f32x16& kf0, const int (&koff)[4], int qloc, int hi, int r32, int lane) {
            LAS const unsigned char* kp = lds + LDS_K + cur * 8192 + r32 * 128;
            f32x16 p0, p1;
            __builtin_amdgcn_s_setprio(1);
#pragma unroll
            for (int d0 = 0; d0 < 4; ++d0) {
                const bf16x8 k0 = *(LAS const bf16x8*)(kp + koff[d0]), k1 = *(LAS const bf16x8*)(kp + 4096 + koff[d0]);
                if (d0 == 0) { p0 = __builtin_amdgcn_mfma_f32_32x32x16_bf16(k0, qr[0], negm, 0, 0, 0); p1 = __builtin_amdgcn_mfma_f32_32x32x16_bf16(k1, qr[0], negm, 0, 0, 0); }
                else { p0 = __builtin_amdgcn_mfma_f32_32x32x16_bf16(k0, qr[d0], p0, 0, 0, 0); p1 = __builtin_amdgcn_mfma_f32_32x32x16_bf16(k1, qr[d0], p1, 0, 0, 0); }
            }
            __builtin_amdgcn_s_setprio(0);
            if (VAR == 0) {
                const float dqf = (float)(64 * dk + qloc);
                const f32x16 d0v = dqf - kf0, d1v = d0v - 32.0f;
#pragma unroll
                for (int r = 0; r < 16; ++r) { p0[r] = __builtin_fmaf(-slopeL, __builtin_fabsf(d0v[r]), p0[r]); p1[r] = __builtin_fmaf(-slopeL, __builtin_fabsf(d1v[r]), p1[r]); }
            } else if (VAR == 1) {
                LAS const float* ckp = ckL + kt * 64 + 4 * hi;
                f32x16 c0v, c1v;
#pragma unroll
                for (int g = 0; g < 4; ++g) { const f32x4 c0 = *(LAS const f32x4*)(ckp + 8 * g), c1 = *(LAS const f32x4*)(ckp + 32 + 8 * g);
#pragma unroll
                    for (int i = 0; i < 4; ++i) { c0v[4 * g + i] = c0[i]; c1v[4 * g + i] = c1[i]; } }
                p0 = p0 - c0v; p1 = p1 - c1v;
                if (dk == 0) {
#pragma unroll
                    for (int r = 0; r < 16; ++r) { const int key = crow(r, hi); if (key > qloc) p0[r] = NEG; if (key + 32 > qloc) p1[r] = NEG; }
                }
            } else {
                if (dk >= 3) { const float rf = relX[64];
                    p0 = p0 + rf; p1 = p1 + rf;
                } else {
                    LAS const float* rb = relX + 64 + (128 - 64 * dk - qloc) + 4 * hi;
                    f32x16 b0v, b1v;
#pragma unroll
                    for (int r = 0; r < 16; ++r) { b0v[r] = rb[(r & 3) + 8 * (r >> 2)]; b1v[r] = rb[32 + (r & 3) + 8 * (r >> 2)]; }
                    p0 = p0 + b0v; p1 = p1 + b1v;
                }
            }
            float ra = max3f(p0[0], p0[1], p0[2]), rb2 = max3f(p1[0], p1[1], p1[2]);
#pragma unroll
            for (int r = 3; r < 15; r += 2) { ra = max3f(ra, p0[r], p0[r + 1]); rb2 = max3f(rb2, p1[r], p1[r + 1]); }
            float rm = max3f(ra, rb2, __builtin_fmaxf(p0[15], p1[15]));
            rm = __builtin_fmaxf(rm, __shfl_xor(rm, 32));
            if (first || __any(rm > THR)) {
                const float dl = first ? rm : __builtin_fmaxf(rm, 0.f);
                mref += dl;
                p0 = p0 - dl; p1 = p1 - dl;
                const float f = first ? 1.0f : __builtin_amdgcn_exp2f(-dl);
                lrow *= f; o0 = o0 * f; o1 = o1 * f;
#pragma unroll
                for (int r = 0; r < 16; ++r) negm[r] = -mref;
                first = false;
            }
#pragma unroll
            for (int r = 0; r < 16; ++r) { p0[r] = __builtin_amdgcn_exp2f(p0[r]); p1[r] = __builtin_amdgcn_exp2f(p1[r]); }
            { const f32x16 sv = p0 + p1;
              float ls = 0.f;
#pragma unroll
              for (int r = 0; r < 16; r += 4) ls += (sv[r] + sv[r + 1]) + (sv[r + 2] + sv[r + 3]);
              lrow += ls; }
            u32x4 pw[4];
#pragma unroll
            for (int i = 0; i < 4; ++i) { pw[0][i] = cvt_pk_bf16(p0[2 * i], p0[2 * i + 1]); pw[1][i] = cvt_pk_bf16(p0[8 + 2 * i], p0[9 + 2 * i]);
                                          pw[2][i] = cvt_pk_bf16(p1[2 * i], p1[2 * i + 1]); pw[3][i] = cvt_pk_bf16(p1[8 + 2 * i], p1[9 + 2 * i]); }
            const unsigned vb = (unsigned)(uintptr_t)(lds + LDS_V + cur * 8192 + ((lane >> 4) & 1) * 32 + (lane & 3) * 8 + (4 * hi + ((lane & 15) >> 2)) * 64);
#pragma unroll
            for (int d0 = 0; d0 < 2; ++d0) {
                s16x4 lo[4], hh[4];
#pragma unroll
                for (int ks = 0; ks < 4; ++ks) {
                    asm volatile("ds_read_b64_tr_b16 %0, %1 offset:%c2" : "=&v"(lo[ks]) : "v"(vb), "i"(d0 * 4096 + ks * 1024) : "memory");
                    asm volatile("ds_read_b64_tr_b16 %0, %1 offset:%c2" : "=&v"(hh[ks]) : "v"(vb), "i"(d0 * 4096 + ks * 1024 + 512) : "memory"); }
                asm volatile("s_waitcnt lgkmcnt(0)" ::: "memory"); __builtin_amdgcn_sched_barrier(0);
#pragma unroll
                for (int ks = 0; ks < 4; ++ks) {
                    const bf16x8 pf = __builtin_bit_cast(bf16x8, pw[ks]);
                    const bf16x8 vf = (bf16x8){lo[ks][0], lo[ks][1], lo[ks][2], lo[ks][3], hh[ks][0], hh[ks][1], hh[ks][2], hh[ks][3]};
                    if (d0 == 0) o0 = __builtin_amdgcn_mfma_f32_32x32x16_bf16(vf, pf, o0, 0, 0, 0);
                    else o1 = __builtin_amdgcn_mfma_f32_32x32x16_bf16(vf, pf, o1, 0, 0, 0);
                }
            }
}
struct Src { const bf16_t* k; const bf16_t* v; const bf16_t* q; int nt; };
__device__ __forceinline__ Src make_src(int var, const bf16_t* proj, int b, int h, int qb, int lane, int wid) {
    const int qc = var == 0 ? QA : (var == 1 ? QB_ : QC_), kc = var == 0 ? KA : (var == 1 ? KB_ : KC_), vc = var == 0 ? VA : (var == 1 ? VB_ : VC_);
    const int kvh = var == 0 ? (h >> 2) : h, back = var == 0 ? 2 : (var == 1 ? 1000 : 8);
    const int kt_lo = var == 1 ? 0 : (4 * qb - back > 0 ? 4 * qb - back : 0), kt_hi = 4 * qb + 3;
    const size_t row0 = (size_t)b * SEQ + (size_t)kt_lo * 64;
    const int kkey = wid * 8 + (lane >> 3), kchunk = (lane & 7) ^ ((kkey >> 1) & 7);
    Src s;
    s.k = proj + (row0 + kkey) * PITCH + kc + kvh * 64 + kchunk * 8;
    s.v = proj + (row0 + 16 * (wid & 3) + (lane >> 2)) * PITCH + vc + kvh * 64 + (wid >> 2) * 32 + (lane & 3) * 8;
    s.q = proj + ((size_t)b * SEQ + qb * 256 + wid * 32 + (lane & 31)) * PITCH + qc + h * 64 + (lane >> 5) * 8;
    s.nt = kt_hi - kt_lo + 1;
    return s;
}
template <int VAR>
__device__ __forceinline__ void unit(LAS unsigned char* lds, bf16_t* proj, const float* sinks, int b, int h, int qb, int& cur, bool prefetched, bool has_next, const Src& nx, bf16x8 (&qr)[4]) {
    const int tid = tid_opaque(), lane = tid & 63, r32 = lane & 31, hi = lane >> 5; const int wid = __builtin_amdgcn_readfirstlane(tid >> 6);
    const Src me = make_src(VAR, proj, b, h, qb, lane, wid);
    const int nt = me.nt, kt_hi = 4 * qb + 3, kt_lo = kt_hi - nt + 1;
    const int c = 4 * qb + (wid >> 1);
    constexpr int BACK = VAR == 0 ? 2 : (VAR == 1 ? 1000 : 8);
    LAS float* relX = (LAS float*)(lds + LDS_REL);
    LAS float* ckL = (LAS float*)(lds + LDS_CUM);
#define ATT_DMA2(kp_, vp_, slot) do { \
        __builtin_amdgcn_global_load_lds((const unsigned*)(kp_), (LAS unsigned*)(lds + LDS_K + (slot) * 8192 + wid * 1024), 16, 0, 0); \
        __builtin_amdgcn_global_load_lds((const unsigned*)(vp_), (LAS unsigned*)(lds + LDS_V + (slot) * 8192 + wid * 1024), 16, 0, 0); } while (0)
    if (!prefetched) {
        ATT_DMA2(me.k, me.v, cur); ATT_DMA2(me.k + (size_t)64 * PITCH, me.v + (size_t)64 * PITCH, (cur + 1) & 3); ATT_DMA2(me.k + (size_t)128 * PITCH, me.v + (size_t)128 * PITCH, (cur + 2) & 3);
#pragma unroll
        for (int d0 = 0; d0 < 4; ++d0) qr[d0] = *(const bf16x8*)(me.q + d0 * 16);
    }
    const float sinkL = VAR == 0 ? sinks[h] * LOG2E : 0.f;
    float mref = 0.f, lrow = 0.f; bool first = true;
    f32x16 negm;
#pragma unroll
    for (int r = 0; r < 16; ++r) negm[r] = 0.f;
    int koff[4];
#pragma unroll
    for (int d0 = 0; d0 < 4; ++d0) koff[d0] = ((2 * d0 + hi) ^ ((r32 >> 1) & 7)) << 4;
    f32x16 o0, o1;
#pragma unroll
    for (int r = 0; r < 16; ++r) { o0[r] = 0.f; o1[r] = 0.f; }
    const float slopeL = VAR == 0 ? exp2f(-(float)(h + 1)) * LOG2E : 0.f;
    const int qloc = 32 * (wid & 1) + r32;
    f32x16 kf0;
#pragma unroll
    for (int r = 0; r < 16; ++r) kf0[r] = (float)crow(r, hi);
    bf16x8 qn[4];
#pragma unroll
    for (int d0 = 0; d0 < 4; ++d0) qn[d0] = qr[d0];
    for (int i = 0; i < nt; ++i) {
        const int kt = kt_lo + i;
        if (prefetched && i == 0) asm volatile("s_waitcnt vmcnt(8) lgkmcnt(0)" ::: "memory");
        else asm volatile("s_waitcnt vmcnt(4) lgkmcnt(0)" ::: "memory");
        __builtin_amdgcn_s_barrier(); asm volatile("" ::: "memory");
        { const int i3 = i + 3; const bf16_t* kp; const bf16_t* vp;
          if (i3 < nt) { kp = me.k + (size_t)i3 * 64 * PITCH; vp = me.v + (size_t)i3 * 64 * PITCH; }
          else if (has_next) { kp = nx.k + (size_t)(i3 - nt) * 64 * PITCH; vp = nx.v + (size_t)(i3 - nt) * 64 * PITCH; }
          else { kp = me.k + (size_t)(nt - 1) * 64 * PITCH; vp = me.v + (size_t)(nt - 1) * 64 * PITCH; }
          ATT_DMA2(kp, vp, (cur + 3) & 3); }
        if (has_next && i == nt - 1) {
#pragma unroll
            for (int d0 = 0; d0 < 4; ++d0) qn[d0] = *(const bf16x8*)(nx.q + d0 * 16);
        }
        { const int dk = c - kt; if (dk >= 0 && dk <= BACK) tile<VAR>(lds, cur, kt, dk, qr, mref, lrow, o0, o1, negm, first, relX, ckL, slopeL, kf0, koff, qloc, hi, r32, lane); }
        cur = (cur + 1) & 3;
    }
    if (!has_next) {
        asm volatile("s_waitcnt vmcnt(0) lgkmcnt(0)" ::: "memory");
        __builtin_amdgcn_s_barrier(); asm volatile("" ::: "memory");
    }
#undef ATT_DMA2
    lrow += __shfl_xor(lrow, 32);
    if (VAR == 0) lrow += exp2f(sinkL - mref);
    const float rl = 1.0f / lrow;
    bf16_t* orow = const_cast<bf16_t*>(me.q) - hi * 8 + 4 * hi;
#pragma unroll
    for (int g = 0; g < 4; ++g) {
        u32x2 w0, w1;
        w0.x = cvt_pk_bf16(o0[4 * g] * rl, o0[4 * g + 1] * rl); w0.y = cvt_pk_bf16(o0[4 * g + 2] * rl, o0[4 * g + 3] * rl);
        w1.x = cvt_pk_bf16(o1[4 * g] * rl, o1[4 * g + 1] * rl); w1.y = cvt_pk_bf16(o1[4 * g + 2] * rl, o1[4 * g + 3] * rl);
        *(u32x2*)(orow + 8 * g) = w0; *(u32x2*)(orow + 32 + 8 * g) = w1;
    }
#pragma unroll
    for (int d0 = 0; d0 < 4; ++d0) qr[d0] = qn[d0];
}
}

__device__ __forceinline__ void mod_phase(LAS unsigned char* lds, const float* cvec, const float* w_ada, const float* b_ada, float* mod) {
    const int tid = tid_opaque(), lane = tid & 63, wid = tid >> 6;
    LAS float* condL = (LAS float*)lds;
    LAS float* red = (LAS float*)(lds + 32768);
    for (int i = tid; i < BATCH * D; i += 512) { const float c = cvec[i]; condL[i] = c / (1.0f + __expf(-c)); }
    __syncthreads();
    for (int cb = blockIdx.x; cb < 192; cb += gridDim.x) {
        const int l = cb / 96, e0 = (cb % 96) * 64;
        float acc[8];
#pragma unroll
        for (int b = 0; b < 8; ++b) acc[b] = 0.f;
        const float* w = w_ada + ((size_t)l * D + wid * 128) * 6144 + e0 + lane;
#pragma unroll 4
        for (int d = 0; d < 128; ++d) { const float wv = __builtin_nontemporal_load(&w[(size_t)d * 6144]);
#pragma unroll
            for (int b = 0; b < 8; ++b) acc[b] += condL[b * D + wid * 128 + d] * wv; }
#pragma unroll
        for (int b = 0; b < 8; ++b) red[(wid * 8 + b) * 64 + lane] = acc[b];
        __syncthreads();
        { const int b = tid >> 6; float s = b_ada[l * 6144 + e0 + lane];
#pragma unroll
          for (int w8 = 0; w8 < 8; ++w8) s += red[(w8 * 8 + b) * 64 + lane];
          mod[(size_t)(l * 8 + b) * 6144 + e0 + lane] = s; }
        __syncthreads();
    }
}
__device__ __forceinline__ void transpose_item(const float* W, int Nsrc, int nsrc, int k0, bf16_t* WT, int K, int ndst, LAS float* scr, int lane) {
#pragma unroll 8
    for (int i = 0; i < 32; ++i) { const int kk = 2 * i + (lane >> 5); scr[kk * 33 + (lane & 31)] = __builtin_nontemporal_load(&W[(size_t)(k0 + kk) * Nsrc + nsrc + (lane & 31)]); }
    asm volatile("s_waitcnt lgkmcnt(0)" ::: "memory");
    const int c = lane & 7;
#pragma unroll
    for (int j = 0; j < 4; ++j) { const int n = (lane >> 3) + 8 * j; const LAS float* s = scr + (8 * c) * 33 + n;
        u32x4 o; o.x = cvt_pk_bf16(s[0 * 33], s[1 * 33]); o.y = cvt_pk_bf16(s[2 * 33], s[3 * 33]); o.z = cvt_pk_bf16(s[4 * 33], s[5 * 33]); o.w = cvt_pk_bf16(s[6 * 33], s[7 * 33]);
        *(u32x4*)(WT + (size_t)(ndst + n) * K + k0 + 8 * c) = o; }
    asm volatile("s_waitcnt lgkmcnt(0)" ::: "memory");
}
struct Ptrs {
    const float *x, *c, *norm_mix_g, *norm_ffn_g, *w_ada, *b_ada, *w_in, *b_forget, *sinks, *rel_bias, *w_branch, *w_out, *w_ffn_in, *w_ffn_out, *final_norm_g;
};
__device__ __forceinline__ void convert_phase(LAS unsigned char* lds, const Ptrs& P, unsigned char* ws) {
    const int tid = tid_opaque(), lane = tid & 63, wid = tid >> 6;
    LAS float* scr = (LAS float*)(lds + 65536 + wid * 8448);
    const int gw = blockIdx.x * 8 + wid, NGW = gridDim.x * 8;
    constexpr int I_QKV = 16 * (NQKV / 32), I_G = 16 * (NG / 32), I_BR = 3 * 8 * 32, I_OUT = 16 * 32, I_FI = 16 * (FF2 / 32), I_FO = (FFH / 64) * 32, I_FB = 64;
    constexpr int I_LAYER = I_QKV + I_G + I_BR + I_OUT + I_FI + I_FO + I_FB;
    for (int it = gw; it < 2 * I_LAYER; it += NGW) {
        const int l = it / I_LAYER; int r = it % I_LAYER;
        unsigned char* wl = ws + WS_W + (size_t)l * W_LAYER;
        if (r < I_QKV) { const int nb = r % (NQKV / 32), kb = r / (NQKV / 32), n0 = 32 * nb;
            transpose_item(P.w_in + (size_t)l * D * NIN, NIN, n0 < 2304 ? n0 : n0 + 8, 64 * kb, (bf16_t*)(wl + W_QKV), D, n0, scr, lane); continue; } r -= I_QKV;
        if (r < I_G) { const int nb = r % (NG / 32), kb = r / (NG / 32), n0 = 32 * nb;
            transpose_item(P.w_in + (size_t)l * D * NIN, NIN, G_SRC + n0, 64 * kb, (bf16_t*)(wl + W_G), D, n0, scr, lane); continue; } r -= I_G;
        if (r < I_BR) { const int k = r / 256, rr = r % 256, nb = rr % 32, kb = rr / 32;
            transpose_item(P.w_branch + ((size_t)l * 3 + k) * 512 * D, D, 32 * nb, 64 * kb, (bf16_t*)(wl + W_BR), 512, k * D + 32 * nb, scr, lane); continue; } r -= I_BR;
        if (r < I_OUT) { const int nb = r % 32, kb = r / 32;
            transpose_item(P.w_out + (size_t)l * D * D, D, 32 * nb, 64 * kb, (bf16_t*)(wl + W_OUT), D, 32 * nb, scr, lane); continue; } r -= I_OUT;
        if (r < I_FI) { const int nb = r % (FF2 / 32), kb = r / (FF2 / 32), n0 = 32 * nb, pn = n0 >> 8, w = n0 & 255;
            const int src = w < 128 ? 128 * pn + w : FFH + 128 * pn + (w - 128);
            transpose_item(P.w_ffn_in + (size_t)l * D * FF2, FF2, src, 64 * kb, (bf16_t*)(wl + W_FI), D, n0, scr, lane); continue; } r -= I_FI;
        if (r < I_FO) { const int nb = r % 32, kb = r / 32;
            transpose_item(P.w_ffn_out + (size_t)l * FFH * D, D, 32 * nb, 64 * kb, (bf16_t*)(wl + W_FO), FFH, 32 * nb, scr, lane); continue; } r -= I_FO;
        {
            const float* wsrc = P.w_in + (size_t)l * D * NIN + FB_SRC;
#pragma unroll
            for (int q = 0; q < 4; ++q) { const int n = 4 * r + q; u32x4 o0 = {0u, 0u, 0u, 0u}, o1 = {0u, 0u, 0u, 0u};
                if (n < 8) { float v[16];
#pragma unroll
                    for (int i = 0; i < 16; ++i) v[i] = wsrc[(size_t)(16 * lane + i) * NIN + n];
                    o0.x = cvt_pk_bf16(v[0], v[1]); o0.y = cvt_pk_bf16(v[2], v[3]); o0.z = cvt_pk_bf16(v[4], v[5]); o0.w = cvt_pk_bf16(v[6], v[7]);
                    o1.x = cvt_pk_bf16(v[8], v[9]); o1.y = cvt_pk_bf16(v[10], v[11]); o1.z = cvt_pk_bf16(v[12], v[13]); o1.w = cvt_pk_bf16(v[14], v[15]); }
                bf16_t* dst = (bf16_t*)(wl + W_QKV) + (size_t)(NQKV + n) * D + 16 * lane;
                *(u32x4*)dst = o0; *(u32x4*)(dst + 8) = o1; }
        }
    }
}
__device__ __forceinline__ float reduce8(const float (&a)[8], int lane) {
    float b[4], c[2];
    const bool b0 = lane & 1, b1 = lane & 2, b2 = lane & 4;
#pragma unroll
    for (int i = 0; i < 4; ++i) { const float keep = b0 ? a[2 * i + 1] : a[2 * i], send = b0 ? a[2 * i] : a[2 * i + 1]; b[i] = keep + __shfl_xor(send, 1); }
#pragma unroll
    for (int i = 0; i < 2; ++i) { const float keep = b1 ? b[2 * i + 1] : b[2 * i], send = b1 ? b[2 * i] : b[2 * i + 1]; c[i] = keep + __shfl_xor(send, 2); }
    float d = (b2 ? c[1] : c[0]) + __shfl_xor(b2 ? c[0] : c[1], 4);
    d += __shfl_xor(d, 8); d += __shfl_xor(d, 16); d += __shfl_xor(d, 32);
    return d;
}
template <bool FB>
__device__ __forceinline__ void norm_phase(LAS unsigned char* lds, const float* xin, const float* g, const float* shift0, const float* scale0, bf16_t* hout,
                                           const float* w_in_l, const float* b_forget_l, float* flog) {
    const int tid = tid_opaque(), lane = tid & 63, wid = tid >> 6;
    LAS float* wfb = (LAS float*)lds;
    if (FB) { for (int i = tid; i < 8 * D; i += 512) { const int d = i >> 3, e = i & 7; wfb[e * D + d] = w_in_l[(size_t)d * NIN + FB_SRC + e]; } __syncthreads(); }
    const int gw = blockIdx.x * 8 + wid, NGW = gridDim.x * 8;
    for (int rc = gw; rc < M / 4; rc += NGW) {
        const int row0 = rc * 4, b = row0 / SEQ;
        f32x4 v[4][4];
#pragma unroll
        for (int r = 0; r < 4; ++r) { const f32x4* xr = (const f32x4*)(xin + (size_t)(row0 + r) * D) + lane;
#pragma unroll
            for (int j = 0; j < 4; ++j) v[r][j] = __builtin_nontemporal_load(xr + 64 * j); }
        f32x4 am[4], sh[4];
#pragma unroll
        for (int j = 0; j < 4; ++j) { const int d = 4 * lane + 256 * j; const f32x4 gv = *(const f32x4*)(g + d), sc = *(const f32x4*)(scale0 + (size_t)b * 6144 + d);
            am[j] = gv * (1.0f + sc); sh[j] = *(const f32x4*)(shift0 + (size_t)b * 6144 + d); }
        float ss[8];
#pragma unroll
        for (int r = 0; r < 4; ++r) { float s = 0.f;
#pragma unroll
            for (int j = 0; j < 4; ++j) s += (v[r][j].x * v[r][j].x + v[r][j].y * v[r][j].y) + (v[r][j].z * v[r][j].z + v[r][j].w * v[r][j].w);
            ss[r] = s; ss[r + 4] = 0.f; }
        const float tot = reduce8(ss, lane);
        const float rs = 1.0f / sqrtf(tot * (1.0f / D) + EPS);
#pragma unroll
        for (int r = 0; r < 4; ++r) { const float rstd = __uint_as_float(__builtin_amdgcn_readlane(__float_as_uint(rs), r));
            u32x2* o8 = (u32x2*)(hout + (size_t)(row0 + r) * D) + lane;
#pragma unroll
            for (int j = 0; j < 4; ++j) { v[r][j] = v[r][j] * rstd * am[j] + sh[j]; u32x2 w; w.x = cvt_pk_bf16(v[r][j].x, v[r][j].y); w.y = cvt_pk_bf16(v[r][j].z, v[r][j].w); o8[64 * j] = w; } }
        if (FB) {
            float pe[4][8];
#pragma unroll
            for (int e = 0; e < 8; ++e) { f32x4 wv[4];
#pragma unroll
                for (int j = 0; j < 4; ++j) wv[j] = *(LAS const f32x4*)(wfb + e * D + 4 * lane + 256 * j);
#pragma unroll
                for (int r = 0; r < 4; ++r) { float a = 0.f;
#pragma unroll
                    for (int j = 0; j < 4; ++j) a += (v[r][j].x * wv[j].x + v[r][j].y * wv[j].y) + (v[r][j].z * wv[j].z + v[r][j].w * wv[j].w);
                    pe[r][e] = a; } }
            const float bfv = b_forget_l[lane & 7];
#pragma unroll
            for (int r = 0; r < 4; ++r) { const float f = reduce8(pe[r], lane) + bfv; if (lane < 8) flog[(size_t)(row0 + r) * 8 + lane] = f; }
        }
    }
}
__device__ __forceinline__ void cumsum_lds(LAS unsigned char* lds, const float* flog, int b, int h) {
    const int tid = tid_opaque(), lane = tid & 63, wid = tid >> 6;
    LAS float* wt = (LAS float*)(lds + att::LDS_REL);
    LAS float* ckL = (LAS float*)(lds + att::LDS_CUM);
    float v[4]; float run = 0.f;
#pragma unroll
    for (int i = 0; i < 4; ++i) { const float f = flog[((size_t)b * SEQ + 4 * tid + i) * 8 + h];
        const float ls = fminf(f, 0.f) - log1pf(expf(-fabsf(f))); run += ls; v[i] = run; }
    float inc = run;
#pragma unroll
    for (int o = 1; o < 64; o <<= 1) { const float t = __shfl_up(inc, o); if (lane >= o) inc += t; }
    if (lane == 63) wt[wid] = inc;
    __syncthreads();
    float base = inc - run;
    for (int w8 = 0; w8 < wid; ++w8) base += wt[w8];
    f32x4 o4 = {(v[0] + base) * LOG2E, (v[1] + base) * LOG2E, (v[2] + base) * LOG2E, (v[3] + base) * LOG2E};
    *(LAS f32x4*)(ckL + 4 * tid) = o4;
    __syncthreads();
}
__device__ __forceinline__ void final_norm_phase(float* x, const float* g) {
    const int tid = tid_opaque(), lane = tid & 63, wid = tid >> 6;
    const int gw = blockIdx.x * 8 + wid, NGW = gridDim.x * 8;
    f32x4 gv[4];
#pragma unroll
    for (int j = 0; j < 4; ++j) gv[j] = *(const f32x4*)(g + 4 * lane + 256 * j);
    for (int row = gw; row < M; row += NGW) {
        f32x4* xr = (f32x4*)(x + (size_t)row * D) + lane;
        f32x4 v[4]; float s = 0.f;
#pragma unroll
        for (int j = 0; j < 4; ++j) { v[j] = xr[64 * j]; s += (v[j].x * v[j].x + v[j].y * v[j].y) + (v[j].z * v[j].z + v[j].w * v[j].w); }
        const float rstd = 1.0f / sqrtf(wave_sum(s) * (1.0f / D) + EPS);
#pragma unroll
        for (int j = 0; j < 4; ++j) xr[64 * j] = v[j] * rstd * gv[j];
    }
}


#define XB_TMO      128
#define XB_XCNT(j)  (256  + 64 * (j))
#define XB_XSUB(j)  (1280 + 64 * (j))
#define XB_XGEN(j)  (2304 + 64 * (j))
#define XB_TOP      3328
#define XB_TOPGEN   3392
#define XCD_BAR_WORDS 3456
#define XB_SPIN_CAP (1u << 18)
__device__ __forceinline__ unsigned xb_ld(unsigned* p)              { return __hip_atomic_load(p, __ATOMIC_RELAXED, __HIP_MEMORY_SCOPE_AGENT); }
__device__ __forceinline__ unsigned xb_add(unsigned* p, unsigned v) { return __hip_atomic_fetch_add(p, v, __ATOMIC_RELAXED, __HIP_MEMORY_SCOPE_AGENT); }
__device__ __forceinline__ unsigned xb_xcc_id() { return (unsigned)__builtin_amdgcn_s_getreg((3 << 11) | 20) & 0xFu; }
#define XB_SPIN(cond, bar) do { unsigned _sp = 0; while (cond) { __builtin_amdgcn_s_sleep(1); \
    if ((++_sp & 255u) == 0u) { if (xb_ld(&(bar)[XB_TMO])) break; if (_sp > XB_SPIN_CAP) { atomicAdd(&(bar)[XB_TMO], 1u); break; } } } } while (0)
__device__ __forceinline__ void xcd_barrier_complete(unsigned* bar, unsigned x, unsigned& nloc, unsigned& nx) {
    const unsigned G = gridDim.x * gridDim.y * gridDim.z;
    unsigned sum, cnt, mine, sp = 0u;
    for (;;) {
        sum = 0u; cnt = 0u; mine = 0u;
#pragma unroll
        for (unsigned j = 0; j < 16; ++j) { const unsigned c = xb_ld(&bar[XB_XCNT(j)]); sum += c; cnt += (c > 0u) ? 1u : 0u; mine = (j == x) ? c : mine; }
        if (sum == G) break;
        __builtin_amdgcn_s_sleep(1);
        if ((++sp & 255u) == 0u) { if (xb_ld(&bar[XB_TMO])) break; if (sp > XB_SPIN_CAP) { atomicAdd(&bar[XB_TMO], 1u); break; } }
    }
    nloc = mine > 0u ? mine : 1u; nx = cnt > 0u ? cnt : 1u;
}
__device__ __forceinline__ void xcd_barrier(unsigned* bar, volatile LAS unsigned* st) {
    asm volatile("s_waitcnt vmcnt(0)" ::: "memory");
    __syncthreads();
    if (threadIdx.x == 0) {
        const unsigned x = xb_xcc_id();
        __builtin_amdgcn_s_waitcnt(0);
        unsigned nloc = st[0], nx = st[1];
        if (nloc == 0u) { xcd_barrier_complete(bar, x, nloc, nx); st[0] = nloc; st[1] = nx; }
        const unsigned old = xb_add(&bar[XB_XSUB(x)], 1u);
        const unsigned gen = old / nloc;
        if (old + 1u == (gen + 1u) * nloc) {
            __builtin_amdgcn_fence(__ATOMIC_RELEASE, "agent");
            asm volatile("s_waitcnt vmcnt(0)" ::: "memory");
            const unsigned og = xb_add(&bar[XB_TOP], 1u);
            const unsigned tg = og / nx;
            if (og + 1u == (tg + 1u) * nx) xb_add(&bar[XB_TOPGEN], 1u);
            else XB_SPIN(xb_ld(&bar[XB_TOPGEN]) == tg, bar);
            __builtin_amdgcn_fence(__ATOMIC_ACQUIRE, "agent");
            xb_add(&bar[XB_XGEN(x)], 1u);
            asm volatile("s_waitcnt vmcnt(0)" ::: "memory");
        } else {
            XB_SPIN(xb_ld(&bar[XB_XGEN(x)]) == gen, bar);
            __builtin_amdgcn_fence(__ATOMIC_ACQUIRE, "agent");
            asm volatile("s_waitcnt vmcnt(0)" ::: "memory");
        }
    }
    __syncthreads();
}

constexpr int LDS_BYTES = 147456;
constexpr int N_PHASES = 20;
#ifndef PH_MASK
#define PH_MASK 0xFFFF
#endif
#define PHON(k) ((PH_MASK >> (k)) & 1)
struct Args { Ptrs p; float* out; unsigned char* ws; int ph_lo, ph_hi; };

__global__ void __launch_bounds__(512, 2) fwd_kernel(Args a) {
    extern __shared__ __attribute__((aligned(16))) unsigned char lds_raw[];
    LAS unsigned char* lds = (LAS unsigned char*)lds_raw;
    cg::grid_group grid = cg::this_grid();
    volatile LAS unsigned* bst = (volatile LAS unsigned*)(lds + LDS_BYTES - 128);
    if (threadIdx.x == 0) { bst[0] = 0u; bst[1] = 0u; }
    __syncthreads();
    const Ptrs& P = a.p;
#ifdef PROBE_MASK
    #define pst ((LAS unsigned long long*)(unsigned)(LDS_BYTES - 64))
    if (threadIdx.x == 0) { pst[0] = __builtin_amdgcn_s_memrealtime(); pst[1] = 0; pst[2] = 0; }
#define PROBE_KIND(p) ((p) == 0 ? 0 : ((p) == N_PHASES - 1 ? 10 : ((((p) - 1) % 9) == 0 ? 1 : ((((p) - 1) % 9) + 1))))
#define PROBE_STEP(p) do { if (threadIdx.x == 0) { const unsigned long long t_now = __builtin_amdgcn_s_memrealtime(); \
        if ((PROBE_MASK >> PROBE_KIND(p)) & 1) pst[1] += ((PROBE_MASK >> 16) & 1) ? (t_now - pst[2]) : (((PROBE_MASK >> 17) & 1) ? (pst[2] - pst[0]) : (t_now - pst[0])); pst[0] = t_now; } } while (0)
#endif
    if (a.ph_hi - a.ph_lo > 1) {
        if (blockIdx.x == 0) { unsigned* z = (unsigned*)(a.ws + WS_BAR); for (int i = threadIdx.x; i < (int)(WS_ZERO_BYTES / 4); i += 512) z[i] = 0u; }
        grid.sync();
        if (threadIdx.x == 0) xb_add(&((unsigned*)(a.ws + WS_BAR))[XB_XCNT(xb_xcc_id())], 1u);
    }
    const bool fuse_norm = (gridDim.x == 256) && (a.ph_hi - a.ph_lo > 1);
    for (int ph = a.ph_lo; ph < a.ph_hi; ++ph) {
        if (fuse_norm && (ph == N_PHASES - 1 || (ph >= 1 && (ph - 1) % 9 == 6) || ph == 10)) continue;
#ifdef PROBE_MASK
        if (ph > a.ph_lo && threadIdx.x == 0) pst[2] = __builtin_amdgcn_s_memrealtime();
#endif
        if (ph > a.ph_lo) xcd_barrier((unsigned*)(a.ws + WS_BAR), bst);
#ifdef PROBE_MASK
        if (ph > a.ph_lo) PROBE_STEP(ph - 1);
#endif
        unsigned char* ws = a.ws; float* outp = a.out; int G = gridDim.x, bx = blockIdx.x;
        asm volatile("" : "+s"(ws), "+s"(outp), "+s"(G), "+s"(bx));
        float* mod = (float*)(ws + WS_MOD); float* flog = (float*)(ws + WS_FLOG); const float* cumL = nullptr;
        bf16_t* hbuf = (bf16_t*)(ws + WS_H); bf16_t* proj = (bf16_t*)(ws + WS_PROJ); bf16_t* act = (bf16_t*)(ws + WS_PROJ);
        if (ph == 0) {
            if (PHON(9)) mod_phase(lds, P.c, P.w_ada, P.b_ada, mod); if (PHON(10)) convert_phase(lds, P, ws); continue; }
        if (ph == N_PHASES - 1) { if (PHON(11)) final_norm_phase(outp, P.final_norm_g); continue; }
        const int l = (ph - 1) / 9, sp = (ph - 1) % 9;
        const unsigned char* wl = ws + WS_W + (size_t)l * W_LAYER;
        const float* modl = mod + (size_t)l * 8 * 6144;
        const float* xin = l == 0 ? P.x : outp;
        switch (sp) {
        case 0: if (PHON(0)) norm_phase<false>(lds, xin, P.norm_mix_g + l * D, modl + 0 * D, modl + 1 * D, hbuf, nullptr, nullptr, nullptr); break;
        case 1: if (PHON(1)) {
            pg8::Gemm g{hbuf, (const bf16_t*)(wl + W_QKV), M, NQKVF, D, D}; pg8::StaticOrder S; S.init(M, NQKVF, G, bx);
            pg8::EpiQKV E{proj, flog, P.b_forget + l * 8}; pg8::gemm_phase(lds, g, S, E); } break;
        case 2: if (PHON(2)) {
            for (int v0 = bx; v0 < 256; v0 += G) {
                const int v = (G == 256) ? ((v0 & 7) * 32 + (v0 >> 3)) : v0;
                const int bh = v >> 2, j = v & 3, b = bh >> 3, h = bh & 7;
                cumsum_lds(lds, flog, b, h);
                {
                    LAS float* relX = (LAS float*)(lds + att::LDS_REL); const float* relh = P.rel_bias + l * 8 * 257 + h * 257;
                    for (int i = tid_opaque(); i < 321; i += 512) { const int jj = i - 64; relX[i] = relh[256 - (jj > 0 ? jj : 0)] * LOG2E; }
                    __syncthreads(); }
                const int tid_ = tid_opaque(), lane_ = tid_ & 63, wid_ = __builtin_amdgcn_readfirstlane(tid_ >> 6);
                const att::Src s1 = att::make_src(1, proj, b, h, j, lane_, wid_), s2 = att::make_src(2, proj, b, h, 2 * j, lane_, wid_), s3 = att::make_src(2, proj, b, h, 2 * j + 1, lane_, wid_),
                               s4 = att::make_src(0, proj, b, h, 2 * j, lane_, wid_), s5 = att::make_src(0, proj, b, h, 2 * j + 1, lane_, wid_);
                int cur = 0; bf16x8 qr[4];
                const float* sk = P.sinks + l * 8;
                att::unit<1>(lds, proj, sk, b, h, 7 - j, cur, false, true, s1, qr);
                att::unit<1>(lds, proj, sk, b, h, j, cur, true, true, s2, qr);
                att::unit<2>(lds, proj, sk, b, h, 2 * j, cur, true, true, s3, qr);
                att::unit<2>(lds, proj, sk, b, h, 2 * j + 1, cur, true, true, s4, qr);
                att::unit<0>(lds, proj, sk, b, h, 2 * j, cur, true, true, s5, qr);
                att::unit<0>(lds, proj, sk, b, h, 2 * j + 1, cur, true, false, s5, qr);
            } } break;
        case 3: if (PHON(3)) { pg8::Gemm g{hbuf, (const bf16_t*)(wl + W_G), M, NG, D, D}; pg8::StaticOrder S; S.init(M, NG, G, bx);
            pg8::EpiGate E{proj}; pg8::gemm_phase(lds, g, S, E); } break;
        case 4: if (PHON(4)) { pg8::Gemm g{proj, (const bf16_t*)(wl + W_BR), M, 3 * D, 512, PITCH}; pg8::BranchOrder S; S.so.init(M, D, G, bx);
            pg8::EpiBranch E{proj, hbuf}; pg8::gemm_phase(lds, g, S, E); } break;
        case 5: if (PHON(5)) { pg8::Gemm g{hbuf, (const bf16_t*)(wl + W_OUT), M, D, D, D}; pg8::StaticOrder S; S.init(M, D, G, bx);
            pg8::EpiRes E{xin, outp, modl + 2 * D, fuse_norm ? 1 : 0, (float*)(ws + WS_SLOT), (unsigned*)(ws + WS_CNT) + l * 4096, P.norm_ffn_g + l * D, modl + 3 * D, modl + 4 * D, hbuf};
            pg8::gemm_phase(lds, g, S, E); } break;
        case 6: if (PHON(6)) norm_phase<false>(lds, outp, P.norm_ffn_g + l * D, modl + 3 * D, modl + 4 * D, hbuf, nullptr, nullptr, nullptr); break;
        case 7: if (PHON(7)) { pg8::Gemm g{hbuf, (const bf16_t*)(wl + W_FI), M, FF2, D, D}; pg8::StaticOrder S; S.init(M, FF2, G, bx);
            pg8::EpiSwiglu E{act}; pg8::gemm_phase(lds, g, S, E); } break;
        case 8: if (PHON(8)) { pg8::Gemm g{act, (const bf16_t*)(wl + W_FO), M, D, FFH, FFH}; pg8::StaticOrder S; S.init(M, D, G, bx);
            const float* modn = mod + (size_t)(l + 1 < DEPTH ? l + 1 : l) * 8 * 6144;
            pg8::EpiRes E{outp, outp, modl + 5 * D, fuse_norm ? (l == DEPTH - 1 ? 2 : 1) : 0, (float*)(ws + WS_SLOT) + (size_t)M * 4, (unsigned*)(ws + WS_CNT) + (2 + l) * 4096,
                          l == DEPTH - 1 ? P.final_norm_g : P.norm_mix_g + (l + 1) * D, modn + 0 * D, modn + 1 * D, hbuf};
            pg8::gemm_phase(lds, g, S, E); } break;
        }
    }
#ifdef PROBE_MASK
    if (threadIdx.x == 0) pst[2] = __builtin_amdgcn_s_memrealtime();
    grid.sync();
    PROBE_STEP(N_PHASES - 1);
    __syncthreads();
    if (blockIdx.x == 0) { const int n = (int)((float)(unsigned)pst[1] * 0.15f); for (int i = threadIdx.x; i < n; i += 512) a.out[i] += 0.1f; }
#endif
}

extern "C" void kernel_launch(void* const* d_in, const int* in_sizes, int n_in, void* d_out, int out_size, void* d_ws, size_t ws_size, hipStream_t stream) {
    static int grid = 0;
    if (grid == 0) {
        if (n_in != 15 || out_size != M * D || ws_size < WS_END) { fprintf(stderr, "kernel_launch: unexpected shapes (n_in %d out %d ws %zu)\n", n_in, out_size, ws_size); grid = -1; return; }
        int dev = 0, cus = 0, per_cu = 0;
        hipGetDevice(&dev); hipDeviceGetAttribute(&cus, hipDeviceAttributeMultiprocessorCount, dev);
        if (hipFuncSetAttribute((const void*)fwd_kernel, hipFuncAttributeMaxDynamicSharedMemorySize, LDS_BYTES) != hipSuccess) { fprintf(stderr, "kernel_launch: hipFuncSetAttribute failed\n"); grid = -1; return; }
        if (hipOccupancyMaxActiveBlocksPerMultiprocessor(&per_cu, (const void*)fwd_kernel, 512, LDS_BYTES) != hipSuccess || per_cu < 1) { fprintf(stderr, "kernel_launch: occupancy query gave %d\n", per_cu); per_cu = 1; }
        (void)hipGetLastError();
        grid = cus * (per_cu > 1 ? 1 : per_cu);
        if (grid > 256) grid = 256;
    }
    if (grid < 0) return;
    Args a{};
    const float** pp = (const float**)&a.p;
    for (int i = 0; i < 15; ++i) pp[i] = (const float*)d_in[i];
    a.out = (float*)d_out; a.ws = (unsigned char*)d_ws;
#if N_LAUNCH_MODE
    for (int ph = 0; ph < N_PHASES; ++ph) { a.ph_lo = ph; a.ph_hi = ph + 1; hipLaunchKernelGGL(fwd_kernel, dim3(grid), dim3(512), LDS_BYTES, stream, a); }
#else
    a.ph_lo = 0; a.ph_hi = N_PHASES;
    void* args[] = {&a};
    hipError_t e = hipLaunchCooperativeKernel((const void*)fwd_kernel, dim3(grid), dim3(512), args, LDS_BYTES, stream);
    if (e != hipSuccess) fprintf(stderr, "cooperative launch failed: %s (grid %d)\n", hipGetErrorString(e), grid);
#endif
}
```
